# Optimizing an MI355X kernel written in HIP

```python
import math
import jax
import jax.numpy as jnp
from jax import lax
import numpy as np

D_MODEL = 1024
BATCH = 8
SEQ = 2048
DEPTH = 4

MEM_LEN = 256
N_BRANCHES = 4
MIX_WIDTH = D_MODEL // N_BRANCHES
HEAD_DIM = 64
MIX_HEADS = MIX_WIDTH // HEAD_DIM

NSA_CMP_LEN = 32
NSA_CMP_STRIDE = 16
NSA_SLC_LEN = 64
NSA_TOP_N = 8
NSA_WINDOW = 512
Q_BLOCK = 128
FORCE_BONUS = 1e4
N_BUCKETS = 32
MAX_DISTANCE = 128

RET_CHUNK = 128
ROPE_BASE = 10000.0
RET_NORM_EPS = 1e-5

RWKV_DECAY_LORA = 32
RWKV_AAA_LORA = 32
RWKV_GATE_LORA = 64
RWKV_GN_EPS = 64e-5
RWKV_SIZES = (MIX_WIDTH, MIX_WIDTH, MIX_WIDTH, RWKV_DECAY_LORA, RWKV_AAA_LORA, RWKV_GATE_LORA)
RWKV_COLS = sum(RWKV_SIZES)

CONV_WIDTH = 3

XA_HEADS = 4
XA_HEAD_DIM = D_MODEL // XA_HEADS
D_FF = 4 * D_MODEL

IN_SIZES = (MIX_WIDTH, 6 * HEAD_DIM, 3 * MIX_HEADS, 4 * MIX_WIDTH, RWKV_COLS, 3 * MIX_WIDTH, N_BRANCHES * D_MODEL)
IN_COLS = sum(IN_SIZES)

RMS_EPS = 1e-6
NEG_INF = -1e30

kernel_name = 'hybrid_nsa_retention_rwkv7_shortconv_block'


def split_cols(z, sizes):
    return jnp.split(z, np.cumsum(sizes)[:-1].tolist(), axis=-1)


def rms_norm(x, g):
    xf = x.astype(jnp.float32)
    y = xf * lax.rsqrt(jnp.mean(xf * xf, axis=-1, keepdims=True) + RMS_EPS)
    return (y * g.astype(jnp.float32)).astype(x.dtype)


def head_norm(u, eps):
    mu = jnp.mean(u, axis=-1, keepdims=True)
    var = jnp.mean(jnp.square(u - mu), axis=-1, keepdims=True)
    return (u - mu) * lax.rsqrt(var + eps)


def t5_bucket(dist):
    n = jnp.maximum(dist, 0)
    max_exact = N_BUCKETS // 2
    nf = jnp.maximum(n, 1).astype(jnp.float32)
    large = max_exact + (jnp.log(nf / max_exact) / math.log(MAX_DISTANCE / max_exact)
                         * (N_BUCKETS - max_exact)).astype(jnp.int32)
    large = jnp.minimum(large, N_BUCKETS - 1)
    return jnp.where(n < max_exact, n, large)


def masked_softmax(s, valid):
    return jax.nn.softmax(jnp.where(valid, s, NEG_INF), axis=-1)


def nsa_mixer(q, kv, gate_logits, cmp_w, cmp_pe, rel_bias):
    B, S, H, Dh = q.shape
    dt = q.dtype
    f32 = jnp.float32
    scale = Dh ** -0.5
    k_c, v_c, k_s, v_s, k_w, v_w = jnp.split(kv, 6, axis=-1)

    n_cmp = (S - NSA_CMP_LEN) // NSA_CMP_STRIDE + 1
    cmp_start = jnp.arange(n_cmp) * NSA_CMP_STRIDE
    cmp_idx = cmp_start[:, None] + jnp.arange(NSA_CMP_LEN)[None, :]
    k_cmp = jnp.einsum('bnld,lde->bne', k_c[:, cmp_idx] + cmp_pe, cmp_w[0])
    v_cmp = jnp.einsum('bnld,lde->bne', v_c[:, cmp_idx] + cmp_pe, cmp_w[1])
    cmp_end = cmp_start + NSA_CMP_LEN - 1

    n_slc = S // NSA_SLC_LEN
    top_n = min(NSA_TOP_N, n_slc)
    slc_start = jnp.arange(n_slc) * NSA_SLC_LEN
    overlap = jnp.clip(jnp.minimum(cmp_start[:, None] + NSA_CMP_LEN, slc_start[None, :] + NSA_SLC_LEN)
                       - jnp.maximum(cmp_start[:, None], slc_start[None, :]), 0).astype(f32) / NSA_CMP_LEN
    k_blk = k_s.reshape(B, n_slc, NSA_SLC_LEN, Dh)
    v_blk = v_s.reshape(B, n_slc, NSA_SLC_LEN, Dh)
    b_idx = jnp.arange(B)[:, None, None]

    k_wp = jnp.pad(k_w, ((0, 0), (NSA_WINDOW, 0), (0, 0)))
    v_wp = jnp.pad(v_w, ((0, 0), (NSA_WINDOW, 0), (0, 0)))

    gates = jax.nn.sigmoid(gate_logits.astype(f32)).reshape(B, S, H, 3)
    n_qb = S // Q_BLOCK
    q_b = q.reshape(B, n_qb, Q_BLOCK, H, Dh).swapaxes(0, 1)
    g_b = gates.reshape(B, n_qb, Q_BLOCK, H, 3).swapaxes(0, 1)
    bias_f = rel_bias.astype(f32)

    def block_fn(args):
        qb, gb, bi = args
        t = bi * Q_BLOCK + jnp.arange(Q_BLOCK)

        d_c = t[:, None] - cmp_end[None, :]
        s_c = (jnp.einsum('bqhd,bnd->bhqn', qb, k_cmp).astype(f32) * scale
               + bias_f[t5_bucket(d_c)].transpose(2, 0, 1))
        p_c = masked_softmax(s_c, d_c >= 0) * (t >= NSA_CMP_LEN - 1)[:, None].astype(f32)
        o_c = jnp.einsum('bhqn,bnd->bqhd', p_c.astype(dt), v_cmp)

        imp = jnp.einsum('bhqn,nm->bqm', p_c, overlap)
        blk = jnp.arange(n_slc)
        cur = t // NSA_SLC_LEN
        forced = (blk[None, :] == 0) | (blk[None, :] == cur[:, None]) | (blk[None, :] == cur[:, None] - 1)
        imp = jnp.where(forced, imp + FORCE_BONUS, imp)
        imp = jnp.where(blk[None, :] <= cur[:, None], imp, NEG_INF)
        _, sel = lax.top_k(imp, top_n)

        k_g = k_blk[b_idx, sel].reshape(B, Q_BLOCK, top_n * NSA_SLC_LEN, Dh)
        v_g = v_blk[b_idx, sel].reshape(B, Q_BLOCK, top_n * NSA_SLC_LEN, Dh)
        pos_s = (sel[..., None] * NSA_SLC_LEN + jnp.arange(NSA_SLC_LEN)).reshape(B, Q_BLOCK, -1)
        d_s = t[None, :, None] - pos_s
        s_s = (jnp.einsum('bqhd,bqkd->bhqk', qb, k_g).astype(f32) * scale
               + bias_f[t5_bucket(d_s)].transpose(0, 3, 1, 2))
        p_s = masked_softmax(s_s, (d_s >= 0)[:, None])
        o_s = jnp.einsum('bhqk,bqkd->bqhd', p_s.astype(dt), v_g)

        k_wb = lax.dynamic_slice_in_dim(k_wp, bi * Q_BLOCK, NSA_WINDOW + Q_BLOCK, axis=1)
        v_wb = lax.dynamic_slice_in_dim(v_wp, bi * Q_BLOCK, NSA_WINDOW + Q_BLOCK, axis=1)
        pos_w = bi * Q_BLOCK - NSA_WINDOW + jnp.arange(NSA_WINDOW + Q_BLOCK)
        d_w = t[:, None] - pos_w[None, :]
        valid_w = (d_w >= 0) & (d_w < NSA_WINDOW) & (pos_w[None, :] >= 0)
        s_w = (jnp.einsum('bqhd,bkd->bhqk', qb, k_wb).astype(f32) * scale
               + bias_f[t5_bucket(d_w)].transpose(2, 0, 1))
        p_w = masked_softmax(s_w, valid_w)
        o_w = jnp.einsum('bhqk,bkd->bqhd', p_w.astype(dt), v_wb)

        out = gb[..., 0:1] * o_c + gb[..., 1:2] * o_s + gb[..., 2:3] * o_w
        return out.astype(dt)

    out = lax.map(block_fn, (q_b, g_b, jnp.arange(n_qb)))
    return out.swapaxes(0, 1).reshape(B, S, H * Dh)


def rotary(u, pos):
    half = u.shape[-1] // 2
    inv_freq = ROPE_BASE ** (-jnp.arange(half, dtype=jnp.float32) / half)
    ang = pos.astype(jnp.float32)[:, None] * inv_freq[None, :]
    cos = jnp.cos(ang)[None, :, None, :]
    sin = jnp.sin(ang)[None, :, None, :]
    u1, u2 = u[..., :half], u[..., half:]
    return jnp.concatenate([u1 * cos - u2 * sin, u2 * cos + u1 * sin], axis=-1)


def retention_mixer(q, k, v, g, norm_g):
    B, S, C = q.shape
    H = C // HEAD_DIM
    f32 = jnp.float32
    pos = jnp.arange(S)
    qh = rotary(q.reshape(B, S, H, HEAD_DIM).astype(f32), pos) * HEAD_DIM ** -0.5
    kh = rotary(k.reshape(B, S, H, HEAD_DIM).astype(f32), pos)
    vh = v.reshape(B, S, H, HEAD_DIM).astype(f32)
    L = min(RET_CHUNK, S)
    nc = S // L
    lg = jnp.log(1.0 - 2.0 ** (-5.0 - jnp.arange(H, dtype=f32)))
    n = jnp.arange(L, dtype=f32)
    diff = n[:, None] - n[None, :]
    inner_decay = jnp.where(diff >= 0, jnp.exp(jnp.maximum(diff, 0.0)[None] * lg[:, None, None]), 0.0)
    q_decay = jnp.exp((n + 1.0)[None, :] * lg[:, None])
    k_decay = jnp.exp((L - 1.0 - n)[None, :] * lg[:, None])
    chunk_decay = jnp.exp(L * lg)

    def to_chunks(u):
        return u.reshape(B, nc, L, H, HEAD_DIM).transpose(1, 0, 3, 2, 4)

    def step(state, inp):
        qc, kc, vc = inp
        att = jnp.einsum('bhld,bhmd->bhlm', qc, kc) * inner_decay
        o = (jnp.einsum('bhlm,bhmd->bhld', att, vc)
             + jnp.einsum('bhld,bhde->bhle', qc, state) * q_decay[None, :, :, None])
        state = (state * chunk_decay[None, :, None, None]
                 + jnp.einsum('bhmd,bhme->bhde', kc * k_decay[None, :, :, None], vc))
        return state, o

    state0 = jnp.zeros((B, H, HEAD_DIM, HEAD_DIM), f32)
    _, o = lax.scan(step, state0, (to_chunks(qh), to_chunks(kh), to_chunks(vh)))
    o = o.transpose(1, 0, 3, 2, 4).reshape(B, S, H, HEAD_DIM)
    o = head_norm(o, RET_NORM_EPS) * norm_g.astype(f32).reshape(H, HEAD_DIM)
    return (jax.nn.silu(g.astype(f32)) * o.reshape(B, S, C)).astype(q.dtype)


def rwkv7_mixer(z, mu, w0, w2, a0, a2, g2, k_k, k_a, r_k, ln_g, ln_b):
    B, S, _ = z.shape
    C = MIX_WIDTH
    H = C // HEAD_DIM
    N = HEAD_DIM
    dt = z.dtype
    f32 = jnp.float32
    zf = z.astype(f32)
    zf = zf + (jnp.pad(zf, ((0, 0), (1, 0), (0, 0)))[:, :-1] - zf) * mu
    r, k, v, wl, al, gl = split_cols(zf, RWKV_SIZES)
    w_log = -jax.nn.softplus(-(w0 + jnp.tanh(wl) @ w2)) - 0.5
    decay = jnp.exp(-jnp.exp(w_log))
    a = jax.nn.sigmoid(a0 + al @ a2)
    g = jax.nn.sigmoid(gl) @ g2
    kk = (k * k_k).reshape(B, S, H, N)
    kk = kk / jnp.maximum(jnp.sqrt(jnp.sum(kk * kk, axis=-1, keepdims=True)), 1e-12)
    k = k * (1.0 + (a - 1.0) * k_a)

    def heads(u):
        return u.reshape(B, S, H, N)

    rh, wh, kh, vh, ah = heads(r), heads(decay), heads(k), heads(v), heads(a)

    def seq_first(u):
        return u.transpose(1, 0, 2, 3)

    def step(state, inp):
        r_t, w_t, k_t, v_t, kk_t, a_t = inp
        sa = jnp.einsum('bhvk,bhk->bhv', state, -kk_t)
        state = (state * w_t[:, :, None, :]
                 + sa[..., None] * (kk_t * a_t)[:, :, None, :]
                 + v_t[..., None] * k_t[:, :, None, :])
        return state, jnp.einsum('bhvk,bhk->bhv', state, r_t)

    state0 = jnp.zeros((B, H, N, N), f32)
    xs = (seq_first(rh), seq_first(wh), seq_first(kh), seq_first(vh), seq_first(kk), seq_first(ah))
    _, y = lax.scan(step, state0, xs)
    y = y.transpose(1, 0, 2, 3)
    y = head_norm(y, RWKV_GN_EPS) * ln_g.astype(f32).reshape(H, N) + ln_b.astype(f32).reshape(H, N)
    y = y + jnp.sum(rh * kh * r_k.astype(f32).reshape(H, N), axis=-1, keepdims=True) * vh
    return (y.reshape(B, S, C) * g).astype(dt)


def short_conv_mixer(z, conv_w):
    b_g, c_g, xt = jnp.split(z, 3, axis=-1)
    u = c_g * xt
    C = u.shape[-1]
    y = lax.conv_general_dilated(u, conv_w[:, None, :].astype(u.dtype), window_strides=(1,),
                                 padding=[(CONV_WIDTH - 1, 0)],
                                 dimension_numbers=('NWC', 'WIO', 'NWC'),
                                 feature_group_count=C)
    return b_g * y


def cross_attention(h, m, wq, wkv, wo):
    B, S, D = h.shape
    M = m.shape[1]
    q = (h @ wq).reshape(B, S, XA_HEADS, XA_HEAD_DIM)
    k, v = jnp.split(m @ wkv, 2, axis=-1)
    k = k.reshape(B, M, XA_HEADS, XA_HEAD_DIM)
    v = v.reshape(B, M, XA_HEADS, XA_HEAD_DIM)
    s = jnp.einsum('bshd,bmhd->bhsm', q, k).astype(jnp.float32) * XA_HEAD_DIM ** -0.5
    p = jax.nn.softmax(s, axis=-1).astype(h.dtype)
    o = jnp.einsum('bhsm,bmhd->bshd', p, v).reshape(B, S, D)
    return o @ wo


def setup_inputs(seed: int = 0) -> dict:
    key = jax.random.key(seed)
    ks = iter(jax.random.split(key, 48))
    f32 = jnp.float32

    def nrm(shape, scale):
        return scale * jax.random.normal(next(ks), shape, f32)

    def gain(shape):
        return 1.0 + 0.02 * jax.random.normal(next(ks), shape, f32)

    def unif(shape, lo, hi):
        return jax.random.uniform(next(ks), shape, f32, lo, hi)

    return {
        'x': nrm((BATCH, SEQ, D_MODEL), 1.0),
        'mem': nrm((BATCH, MEM_LEN, D_MODEL), 1.0),
        'ln_mix_pre': gain((DEPTH, D_MODEL)),
        'w_in': nrm((DEPTH, D_MODEL, IN_COLS), D_MODEL ** -0.5),
        'nsa_cmp_w': nrm((DEPTH, 2, NSA_CMP_LEN, HEAD_DIM, HEAD_DIM), (NSA_CMP_LEN * HEAD_DIM) ** -0.5),
        'nsa_cmp_pe': nrm((DEPTH, NSA_CMP_LEN, HEAD_DIM), 0.02),
        'rel_bias': nrm((N_BUCKETS, MIX_HEADS), 0.5),
        'ret_norm_g': gain((DEPTH, MIX_WIDTH)),
        'rwkv_mu': unif((DEPTH, RWKV_COLS), 0.0, 1.0),
        'rwkv_w0': unif((DEPTH, MIX_WIDTH), -6.0, 1.0),
        'rwkv_w2': nrm((DEPTH, RWKV_DECAY_LORA, MIX_WIDTH), 0.1),
        'rwkv_a0': nrm((DEPTH, MIX_WIDTH), 0.1),
        'rwkv_a2': nrm((DEPTH, RWKV_AAA_LORA, MIX_WIDTH), 0.1),
        'rwkv_g2': nrm((DEPTH, RWKV_GATE_LORA, MIX_WIDTH), RWKV_GATE_LORA ** -0.5),
        'rwkv_k_k': 0.85 + 0.02 * jax.random.normal(next(ks), (DEPTH, MIX_WIDTH), f32),
        'rwkv_k_a': gain((DEPTH, MIX_WIDTH)),
        'rwkv_r_k': nrm((DEPTH, MIX_WIDTH), 0.1),
        'rwkv_ln_g': gain((DEPTH, MIX_WIDTH)),
        'rwkv_ln_b': nrm((DEPTH, MIX_WIDTH), 0.02),
        'conv_w': nrm((DEPTH, CONV_WIDTH, MIX_WIDTH), CONV_WIDTH ** -0.5),
        'w_branch': nrm((DEPTH, N_BRANCHES, MIX_WIDTH, D_MODEL), MIX_WIDTH ** -0.5),
        'w_mix_out': nrm((DEPTH, D_MODEL, D_MODEL), D_MODEL ** -0.5),
        'ln_mix_post': gain((DEPTH, D_MODEL)),
        'ln_xa_pre': gain((DEPTH, D_MODEL)),
        'ln_mem': gain((DEPTH, D_MODEL)),
        'xa_wq': nrm((DEPTH, D_MODEL, D_MODEL), D_MODEL ** -0.5),
        'xa_wkv': nrm((DEPTH, D_MODEL, 2 * D_MODEL), D_MODEL ** -0.5),
        'xa_wo': nrm((DEPTH, D_MODEL, D_MODEL), D_MODEL ** -0.5),
        'ln_xa_post': gain((DEPTH, D_MODEL)),
        'ln_mlp_pre': gain((DEPTH, D_MODEL)),
        'mlp_w1': nrm((DEPTH, D_MODEL, D_FF), D_MODEL ** -0.5),
        'mlp_w2': nrm((DEPTH, D_FF, D_MODEL), D_FF ** -0.5),
        'ln_mlp_post': gain((DEPTH, D_MODEL)),
    }


def reference(x, mem, ln_mix_pre, w_in, nsa_cmp_w, nsa_cmp_pe, rel_bias, ret_norm_g,
              rwkv_mu, rwkv_w0, rwkv_w2, rwkv_a0, rwkv_a2, rwkv_g2, rwkv_k_k, rwkv_k_a, rwkv_r_k,
              rwkv_ln_g, rwkv_ln_b, conv_w, w_branch, w_mix_out, ln_mix_post,
              ln_xa_pre, ln_mem, xa_wq, xa_wkv, xa_wo, ln_xa_post,
              ln_mlp_pre, mlp_w1, mlp_w2, ln_mlp_post):
    B, S, _ = x.shape
    for l in range(DEPTH):
        h = rms_norm(x, ln_mix_pre[l])
        z = h @ w_in[l]
        z_q, z_kv, z_g, z_ret, z_rwkv, z_conv, z_gate = split_cols(z, IN_SIZES)
        o_nsa = nsa_mixer(z_q.reshape(B, S, MIX_HEADS, HEAD_DIM), z_kv, z_g,
                          nsa_cmp_w[l], nsa_cmp_pe[l], rel_bias)
        r_q, r_k, r_v, r_g = jnp.split(z_ret, 4, axis=-1)
        o_ret = retention_mixer(r_q, r_k, r_v, r_g, ret_norm_g[l])
        o_rwkv = rwkv7_mixer(z_rwkv, rwkv_mu[l], rwkv_w0[l], rwkv_w2[l], rwkv_a0[l], rwkv_a2[l],
                             rwkv_g2[l], rwkv_k_k[l], rwkv_k_a[l], rwkv_r_k[l],
                             rwkv_ln_g[l], rwkv_ln_b[l])
        o_conv = short_conv_mixer(z_conv, conv_w[l])
        gates = jax.nn.sigmoid(z_gate).reshape(B, S, N_BRANCHES, D_MODEL)
        branches = (o_nsa, o_ret, o_rwkv, o_conv)
        merged = gates[:, :, 0] * (branches[0] @ w_branch[l, 0])
        for m in range(1, N_BRANCHES):
            merged = merged + gates[:, :, m] * (branches[m] @ w_branch[l, m])
        x = x + rms_norm(merged @ w_mix_out[l], ln_mix_post[l])

        h = rms_norm(x, ln_xa_pre[l])
        mn = rms_norm(mem, ln_mem[l])
        x = x + rms_norm(cross_attention(h, mn, xa_wq[l], xa_wkv[l], xa_wo[l]), ln_xa_post[l])

        h = rms_norm(x, ln_mlp_pre[l])
        x = x + rms_norm(jnp.square(jax.nn.relu(h @ mlp_w1[l])) @ mlp_w2[l], ln_mlp_post[l])
    return x
```

```cpp
#include <hip/hip_runtime.h>
#include <cstdio>
#include <cstdint>

#ifndef MK_PER_PHASE
#define MK_PER_PHASE 1
#endif


#ifdef DIS_SCAN
#define U_SCAN(x)
#else
#define U_SCAN(x) x
#endif
#ifdef DIS_NSA
#define U_NSA(x)
#else
#define U_NSA(x) x
#endif
#ifdef DIS_RET
#define U_RET(x)
#else
#define U_RET(x) x
#endif
#ifdef DIS_XA
#define U_XA(x)
#else
#define U_XA(x) x
#endif
#ifdef DIS_MRG
#define U_MRG(x)
#else
#define U_MRG(x) x
#endif
#define LAS __attribute__((address_space(3)))
typedef float f4 __attribute__((ext_vector_type(4)));

constexpr int NWAVES = 8, NT = 512;
constexpr int BATCH = 8, SEQ = 2048, DM = 1024, DEPTH = 4, MTOK = BATCH * SEQ;
constexpr int MEMLEN = 256, MW = 256, HD = 64, MH = 4, DFF = 4096;
constexpr int IN_COLS = 7436, ZM = 3340, GATE_OFF = 3340;
constexpr int NCMP = 127, NSLC = 32;
constexpr int C_Q = 0, C_KC = 256, C_VC = 320, C_KS = 384, C_VS = 448, C_KW = 512, C_VW = 576, C_NG = 640;
constexpr int C_RQ = 652, C_RK = 908, C_RV = 1164, C_RG = 1420, C_RW = 1676, C_CB = 2572, C_CC = 2828, C_CX = 3084;
constexpr int RWKV_COLS = 896;

constexpr size_t MiB = 1u << 20;
constexpr size_t WS_CTL = 0;
constexpr size_t WS_TAB = 1 * MiB;
constexpr size_t WS_CMP = 2 * MiB;
constexpr size_t WS_H = 4 * MiB;
constexpr size_t WS_ZM = 68 * MiB;
constexpr size_t WS_RW = 277 * MiB;
constexpr size_t WS_BR = 389 * MiB;
constexpr size_t WS_MERGED = 68 * MiB, WS_Y = 132 * MiB, WS_Q = 196 * MiB, WS_O = 260 * MiB;
constexpr size_t WS_MN = 389 * MiB, WS_KV = 397 * MiB, WS_HID = 196 * MiB;
constexpr size_t WS_END = 453 * MiB;
constexpr int LDS_BYTES = 147456;

__device__ const unsigned char T5B[128] = {0, 1, 2, 3, 4, 5, 6, 7, 8, 9, 10, 11, 12, 13, 14, 15, 16, 16, 16, 17, 17, 18, 18, 18, 19, 19, 19, 20, 20, 20, 20, 21, 21, 21, 21, 22, 22, 22, 22, 22, 23, 23, 23, 23, 23, 23, 24, 24, 24, 24, 24, 24, 25, 25, 25, 25, 25, 25, 25, 26, 26, 26, 26, 26, 26, 26, 26, 27, 27, 27, 27, 27, 27, 27, 27, 27, 27, 28, 28, 28, 28, 28, 28, 28, 28, 28, 28, 29, 29, 29, 29, 29, 29, 29, 29, 29, 29, 29, 29, 30, 30, 30, 30, 30, 30, 30, 30, 30, 30, 30, 30, 30, 30, 31, 31, 31, 31, 31, 31, 31, 31, 31, 31, 31, 31, 31, 31, 31};

__device__ const double INVF_REV[32] = {0.15915494309189535, 0.11934937021124885, 0.08949940160889101, 0.06711508300522726, 0.05032921210448703, 0.037741584717419764, 0.028302195830623395, 0.02122365276477766, 0.01591549430918953, 0.011934937021124881, 0.008949940160889099, 0.0067115083005227245, 0.005032921210448702, 0.003774158471741975, 0.0028302195830623394, 0.0021223652764777645, 0.0015915494309189527, 0.0011934937021124885, 0.0008949940160889096, 0.0006711508300522724, 0.0005032921210448699, 0.00037741584717419747, 0.00028302195830623385, 0.00021223652764777642, 0.00015915494309189524, 0.00011934937021124881, 8.949940160889094e-05, 6.711508300522721e-05, 5.032921210448702e-05, 3.7741584717419736e-05, 2.830219583062336e-05, 2.1223652764777656e-05};

struct Args { const float* in[33]; float* out; unsigned char* ws; int ph_lo, ph_hi; };

__device__ __forceinline__ int tid_now() { int t = threadIdx.x; asm volatile("" : "+v"(t)); return t; }
__device__ __forceinline__ float wsum(float v) {
#pragma unroll
    for (int o = 32; o >= 1; o >>= 1) v += __shfl_xor(v, o);
    return v;
}
__device__ __forceinline__ float gsum16(float v) {
#pragma unroll
    for (int o = 8; o >= 1; o >>= 1) v += __shfl_xor(v, o);
    return v;
}
__device__ __forceinline__ float sigmoidf_(float x) { return 1.f / (1.f + __expf(-x)); }
__device__ __forceinline__ float dot64(const float (&q)[64], const LAS f4* k) {
    float a0 = 0.f, a1 = 0.f, a2 = 0.f, a3 = 0.f;
#pragma unroll
    for (int i = 0; i < 16; ++i) { const f4 kv = k[i]; a0 += q[4 * i] * kv.x; a1 += q[4 * i + 1] * kv.y; a2 += q[4 * i + 2] * kv.z; a3 += q[4 * i + 3] * kv.w; }
    return (a0 + a1) + (a2 + a3);
}
__device__ __forceinline__ void osm_update(float s, const LAS f4* v, float& m, float& l, float (&o)[64]) {
    const float mn = fmaxf(m, s), sc = __expf(m - mn), p = __expf(s - mn);
    l = l * sc + p; m = mn;
#pragma unroll
    for (int i = 0; i < 16; ++i) { const f4 vv = v[i];
        o[4 * i] = o[4 * i] * sc + p * vv.x; o[4 * i + 1] = o[4 * i + 1] * sc + p * vv.y; o[4 * i + 2] = o[4 * i + 2] * sc + p * vv.z; o[4 * i + 3] = o[4 * i + 3] * sc + p * vv.w; }
}

__device__ __forceinline__ void rms_rows(const float* x, const float* g, float* out, int nrows, int gw, int NGW, int lane) {
    for (int m = gw; m < nrows; m += NGW) {
        const f4* xr = (const f4*)(x + (size_t)m * DM) + lane; f4 v[4]; float s = 0.f;
#pragma unroll
        for (int j = 0; j < 4; ++j) { v[j] = xr[64 * j]; s += v[j].x * v[j].x + v[j].y * v[j].y + v[j].z * v[j].z + v[j].w * v[j].w; }
        const float r = 1.f / sqrtf(wsum(s) * (1.f / DM) + 1e-6f);
        f4* o = (f4*)(out + (size_t)m * DM) + lane;
#pragma unroll
        for (int j = 0; j < 4; ++j) { const f4 gg = ((const f4*)g)[lane + 64 * j]; o[64 * j] = v[j] * r * gg; }
    }
}
__device__ __forceinline__ void rowop(const float* xin, const float* y, const float* g1, const float* g2, float* xout, float* h, int gw, int NGW, int lane) {
    for (int m = gw; m < MTOK; m += NGW) {
        const f4* yr = (const f4*)(y + (size_t)m * DM) + lane; const f4* xr = (const f4*)(xin + (size_t)m * DM) + lane; f4 v[4]; float s = 0.f;
#pragma unroll
        for (int j = 0; j < 4; ++j) { v[j] = yr[64 * j]; s += v[j].x * v[j].x + v[j].y * v[j].y + v[j].z * v[j].z + v[j].w * v[j].w; }
        const float r = 1.f / sqrtf(wsum(s) * (1.f / DM) + 1e-6f);
        float s2 = 0.f; f4* xo = (f4*)(xout + (size_t)m * DM) + lane;
#pragma unroll
        for (int j = 0; j < 4; ++j) { const f4 gg = ((const f4*)g1)[lane + 64 * j]; v[j] = xr[64 * j] + v[j] * r * gg; xo[64 * j] = v[j];
            s2 += v[j].x * v[j].x + v[j].y * v[j].y + v[j].z * v[j].z + v[j].w * v[j].w; }
        if (g2) { const float r2 = 1.f / sqrtf(wsum(s2) * (1.f / DM) + 1e-6f); f4* ho = (f4*)(h + (size_t)m * DM) + lane;
#pragma unroll
            for (int j = 0; j < 4; ++j) { const f4 gg = ((const f4*)g2)[lane + 64 * j]; ho[64 * j] = v[j] * r2 * gg; } }
    }
}

__device__ __forceinline__ void sgemm_tile(LAS float* As, LAS float* Bs, const float* A, int lda, const float* B, int ldb, int K, int row0, int col0, int N, float (&acc)[8][4]) {
    const int tid = tid_now(), tx = tid & 31, ty = tid >> 5;
#pragma unroll
    for (int i = 0; i < 8; ++i)
#pragma unroll
        for (int j = 0; j < 4; ++j) acc[i][j] = 0.f;
    const int ar = tid >> 2, akq = (tid & 3) * 4, bk = tid >> 5, bn = (tid & 31) * 4;
    const bool bok = (col0 + bn) < N;
    for (int k0 = 0; k0 < K; k0 += 16) {
        const f4 a = *(const f4*)(A + (size_t)(row0 + ar) * lda + k0 + akq);
        f4 b = (f4){0.f, 0.f, 0.f, 0.f}; if (bok) b = *(const f4*)(B + (size_t)(k0 + bk) * ldb + col0 + bn);
        __syncthreads();
        As[(akq + 0) * 132 + ar] = a.x; As[(akq + 1) * 132 + ar] = a.y; As[(akq + 2) * 132 + ar] = a.z; As[(akq + 3) * 132 + ar] = a.w;
        *(LAS f4*)(Bs + bk * 128 + bn) = b;
        __syncthreads();
#pragma unroll
        for (int kk = 0; kk < 16; ++kk) {
            const f4 a0 = *(const LAS f4*)(As + kk * 132 + ty * 8), a1 = *(const LAS f4*)(As + kk * 132 + ty * 8 + 4), bb = *(const LAS f4*)(Bs + kk * 128 + tx * 4);
            const float av[8] = {a0.x, a0.y, a0.z, a0.w, a1.x, a1.y, a1.z, a1.w};
#pragma unroll
            for (int i = 0; i < 8; ++i) { acc[i][0] += av[i] * bb.x; acc[i][1] += av[i] * bb.y; acc[i][2] += av[i] * bb.z; acc[i][3] += av[i] * bb.w; }
        }
    }
}
template <int EPI>
__device__ __forceinline__ void sgemm_phase(LAS unsigned char* lds, const float* A, int lda, const float* B, int ldb, float* C, int ldc, int M, int N, int K) {
    LAS float* As = (LAS float*)lds; LAS float* Bs = As + 16 * 132;
    const int tilesN = (N + 127) / 128, tiles = (M / 128) * tilesN, tid_ = tid_now(), tx = tid_ & 31, ty = tid_ >> 5;
    for (int t = blockIdx.x; t < tiles; t += gridDim.x) {
        const int tm = t / tilesN, tn = t % tilesN; float acc[8][4];
        sgemm_tile(As, Bs, A, lda, B, ldb, K, tm * 128, tn * 128, N, acc);
        const int c = tn * 128 + tx * 4;
        if (c < N) {
#pragma unroll
            for (int i = 0; i < 8; ++i) { f4 v = (f4){acc[i][0], acc[i][1], acc[i][2], acc[i][3]};
                if (EPI == 1) { v.x = fmaxf(v.x, 0.f); v.y = fmaxf(v.y, 0.f); v.z = fmaxf(v.z, 0.f); v.w = fmaxf(v.w, 0.f); v = v * v; }
                *(f4*)(C + (size_t)(tm * 128 + ty * 8 + i) * ldc + c) = v; }
        }
    }
}
__device__ __forceinline__ void merge_phase(LAS unsigned char* lds, const float* h, const float* w_in_l, const float* br, const float* w_branch_l, float* merged) {
    LAS float* As = (LAS float*)lds; LAS float* Bs = As + 16 * 132;
    const int tiles = (MTOK / 128) * 8, tid_ = tid_now(), tx = tid_ & 31, ty = tid_ >> 5;
    for (int t = blockIdx.x; t < tiles; t += gridDim.x) {
        const int tm = t / 8, tn = t % 8; float res[8][4];
#pragma unroll
        for (int i = 0; i < 8; ++i)
#pragma unroll
            for (int j = 0; j < 4; ++j) res[i][j] = 0.f;
        for (int m = 0; m < 4; ++m) {
            float a1[8][4], a2[8][4];
            sgemm_tile(As, Bs, h, DM, w_in_l + GATE_OFF + m * DM, IN_COLS, DM, tm * 128, tn * 128, DM, a1);
            sgemm_tile(As, Bs, br + (size_t)m * MTOK * MW, MW, w_branch_l + (size_t)m * MW * DM, DM, MW, tm * 128, tn * 128, DM, a2);
#pragma unroll
            for (int i = 0; i < 8; ++i)
#pragma unroll
                for (int j = 0; j < 4; ++j) res[i][j] += sigmoidf_(a1[i][j]) * a2[i][j];
        }
#pragma unroll
        for (int i = 0; i < 8; ++i) *(f4*)(merged + (size_t)(tm * 128 + ty * 8 + i) * DM + tn * 128 + tx * 4) = (f4){res[i][0], res[i][1], res[i][2], res[i][3]};
    }
}

__device__ __forceinline__ void nsa_compress_unit(const float* zm, const float* cmp_w_l, const float* pe_l, float* cmp_out, int u, int lane) {
    const int which = u & 1, bn = u >> 1, b = bn / NCMP, n = bn % NCMP;
    const float* W = cmp_w_l + (size_t)which * 32 * 64 * 64; const int col = which ? C_VC : C_KC;
    float acc = 0.f;
    for (int l = 0; l < 32; ++l) {
        const float* zr = zm + (size_t)(b * SEQ + 16 * n + l) * ZM + col;
#pragma unroll 8
        for (int d = 0; d < 64; ++d) acc += (zr[d] + pe_l[l * 64 + d]) * W[(l * 64 + d) * 64 + lane];
    }
    cmp_out[(size_t)which * BATCH * NCMP * 64 + (size_t)(b * NCMP + n) * 64 + lane] = acc;
}
__device__ __forceinline__ void rwkv_prep_token(const float* zm, float* rw, const float* const* P, int l, int tok, int lane, LAS float* scr) {
    const float* mu = P[8] + l * RWKV_COLS; const float* w0 = P[9] + l * MW; const float* w2 = P[10] + (size_t)l * 32 * MW; const float* a0 = P[11] + l * MW;
    const float* a2 = P[12] + (size_t)l * 32 * MW; const float* g2 = P[13] + (size_t)l * 64 * MW; const float* k_k = P[14] + l * MW; const float* k_a = P[15] + l * MW;
    const int t = tok % SEQ; const float* z = zm + (size_t)tok * ZM + C_RW; const float* zp = z - ZM;
    f4 rkv[3];
#pragma unroll
    for (int j = 0; j < 3; ++j) { const f4 c = *(const f4*)(z + j * 256 + 4 * lane); const f4 p = t ? *(const f4*)(zp + j * 256 + 4 * lane) : (f4){0.f, 0.f, 0.f, 0.f};
        const f4 m = *(const f4*)(mu + j * 256 + 4 * lane); rkv[j] = c + (p - c) * m; }
    if (lane < 32) { const f4 c = *(const f4*)(z + 768 + 4 * lane); const f4 p = t ? *(const f4*)(zp + 768 + 4 * lane) : (f4){0.f, 0.f, 0.f, 0.f};
        const f4 m = *(const f4*)(mu + 768 + 4 * lane); f4 v = c + (p - c) * m;
        if (lane < 8) { v.x = tanhf(v.x); v.y = tanhf(v.y); v.z = tanhf(v.z); v.w = tanhf(v.w); }
        else if (lane >= 16) { v.x = sigmoidf_(v.x); v.y = sigmoidf_(v.y); v.z = sigmoidf_(v.z); v.w = sigmoidf_(v.w); }
        *(LAS f4*)(scr + 4 * lane) = v; }
    asm volatile("s_waitcnt lgkmcnt(0)" ::: "memory");
    f4 aw = (f4){0.f, 0.f, 0.f, 0.f}, aa = aw, ag = aw;
#pragma unroll 4
    for (int j = 0; j < 32; ++j) { aw += scr[j] * *(const f4*)(w2 + j * MW + 4 * lane); aa += scr[32 + j] * *(const f4*)(a2 + j * MW + 4 * lane); }
#pragma unroll 4
    for (int j = 0; j < 64; ++j) ag += scr[64 + j] * *(const f4*)(g2 + j * MW + 4 * lane);
    asm volatile("s_waitcnt lgkmcnt(0)" ::: "memory");
    const f4 w0v = *(const f4*)(w0 + 4 * lane), a0v = *(const f4*)(a0 + 4 * lane), kkv = *(const f4*)(k_k + 4 * lane), kav = *(const f4*)(k_a + 4 * lane);
    float dec[4], av[4], kk[4], k2[4]; float ss = 0.f;
#pragma unroll
    for (int i = 0; i < 4; ++i) { const float y = -(w0v[i] + aw[i]); const float sp = (y > 20.f) ? y : log1pf(expf(y)); const float wl = -sp - 0.5f; dec[i] = expf(-expf(wl));
        av[i] = 1.f / (1.f + expf(-(a0v[i] + aa[i]))); kk[i] = rkv[1][i] * kkv[i]; ss += kk[i] * kk[i]; k2[i] = rkv[1][i] * (1.f + (av[i] - 1.f) * kav[i]); }
    ss = gsum16(ss); const float inv = 1.f / fmaxf(sqrtf(ss), 1e-12f);
    float* o = rw + (size_t)tok * 7 * MW + 4 * lane;
    *(f4*)(o) = rkv[0]; *(f4*)(o + MW) = (f4){dec[0], dec[1], dec[2], dec[3]}; *(f4*)(o + 2 * MW) = (f4){k2[0], k2[1], k2[2], k2[3]}; *(f4*)(o + 3 * MW) = rkv[2];
    *(f4*)(o + 4 * MW) = (f4){kk[0] * inv, kk[1] * inv, kk[2] * inv, kk[3] * inv}; *(f4*)(o + 5 * MW) = (f4){kk[0] * inv * av[0], kk[1] * inv * av[1], kk[2] * inv * av[2], kk[3] * inv * av[3]};
    *(f4*)(o + 6 * MW) = ag;
}

__device__ __forceinline__ void rwkv_scan_unit(LAS unsigned char* lds, float* rw, int b, int h) {
    const int tid = tid_now(), row = tid >> 3, cg = tid & 7;
    LAS f4* buf = (LAS f4*)lds;
    LAS float* yb = (LAS float*)(lds + 98304);
    float s[8];
#pragma unroll
    for (int j = 0; j < 8; ++j) s[j] = 0.f;
    f4 pre[6];
#define GSRC(c, k) ((const f4*)(rw + ((size_t)(b * SEQ + (c) * 32 + (tid + 512 * (k)) / 96) * 7 + (((tid + 512 * (k)) % 96) >> 4)) * MW + h * 64 + (((tid + 512 * (k)) % 96) & 15) * 4))
#pragma unroll
    for (int k = 0; k < 6; ++k) pre[k] = *GSRC(0, k);
    __syncthreads();
#pragma unroll
    for (int k = 0; k < 6; ++k) buf[tid + 512 * k] = pre[k];
    __syncthreads();
    for (int c = 0; c < SEQ / 32; ++c) {
        if (c + 1 < SEQ / 32) {
#pragma unroll
            for (int k = 0; k < 6; ++k) pre[k] = *GSRC(c + 1, k);
        }
        const LAS f4* cb = buf + (c & 1) * 3072; LAS float* ybc = yb + (c & 1) * 2048;
        for (int i = 0; i < 32; ++i) {
            const LAS f4* S = cb + i * 96;
            const f4 k0 = S[64 + cg * 2], k1 = S[64 + cg * 2 + 1];
            float d = s[0] * k0.x + s[1] * k0.y + s[2] * k0.z + s[3] * k0.w + s[4] * k1.x + s[5] * k1.y + s[6] * k1.z + s[7] * k1.w;
            d += __shfl_xor(d, 1); d += __shfl_xor(d, 2); d += __shfl_xor(d, 4);
            const float sa = -d, vv = ((const LAS float*)(S + 48))[row];
            const f4 w0 = S[16 + cg * 2], w1 = S[16 + cg * 2 + 1], q0 = S[80 + cg * 2], q1 = S[80 + cg * 2 + 1], kk0 = S[32 + cg * 2], kk1 = S[32 + cg * 2 + 1];
            s[0] = s[0] * w0.x + sa * q0.x + vv * kk0.x; s[1] = s[1] * w0.y + sa * q0.y + vv * kk0.y; s[2] = s[2] * w0.z + sa * q0.z + vv * kk0.z; s[3] = s[3] * w0.w + sa * q0.w + vv * kk0.w;
            s[4] = s[4] * w1.x + sa * q1.x + vv * kk1.x; s[5] = s[5] * w1.y + sa * q1.y + vv * kk1.y; s[6] = s[6] * w1.z + sa * q1.z + vv * kk1.z; s[7] = s[7] * w1.w + sa * q1.w + vv * kk1.w;
            const f4 r0 = S[cg * 2], r1 = S[cg * 2 + 1];
            float y = s[0] * r0.x + s[1] * r0.y + s[2] * r0.z + s[3] * r0.w + s[4] * r1.x + s[5] * r1.y + s[6] * r1.z + s[7] * r1.w;
            y += __shfl_xor(y, 1); y += __shfl_xor(y, 2); y += __shfl_xor(y, 4);
            if (cg == 0) ybc[i * 64 + row] = y;
        }
        if (c + 1 < SEQ / 32) {
#pragma unroll
            for (int k = 0; k < 6; ++k) buf[((c + 1) & 1) * 3072 + tid + 512 * k] = pre[k];
        }
        __syncthreads();
        { const int i = tid >> 4, q = tid & 15; *(f4*)(rw + ((size_t)(b * SEQ + c * 32 + i) * 7 + 5) * MW + h * 64 + q * 4) = *(const LAS f4*)(ybc + i * 64 + q * 4); }
    }
    __syncthreads();
}
__device__ __forceinline__ void rwkv_fin_token(const float* rw, float* o_rwkv, const float* r_k, const float* ln_g, const float* ln_b, int tok, int lane) {
    const float* p = rw + (size_t)tok * 7 * MW + 4 * lane;
    const f4 r = *(const f4*)p, k2 = *(const f4*)(p + 2 * MW), v = *(const f4*)(p + 3 * MW), y = *(const f4*)(p + 5 * MW), g = *(const f4*)(p + 6 * MW);
    const f4 rk = *(const f4*)(r_k + 4 * lane), lg = *(const f4*)(ln_g + 4 * lane), lb = *(const f4*)(ln_b + 4 * lane);
    const float mu = gsum16(y.x + y.y + y.z + y.w) * (1.f / 64.f); const f4 yc = y - mu;
    const float var = gsum16(yc.x * yc.x + yc.y * yc.y + yc.z * yc.z + yc.w * yc.w) * (1.f / 64.f); const float rs = 1.f / sqrtf(var + 64e-5f);
    const float bonus = gsum16(r.x * k2.x * rk.x + r.y * k2.y * rk.y + r.z * k2.z * rk.z + r.w * k2.w * rk.w);
    *(f4*)(o_rwkv + (size_t)tok * MW + 4 * lane) = (yc * rs * lg + lb + bonus * v) * g;
}

__device__ __forceinline__ void stage_tile64(LAS f4* KT, LAS f4* VT, const float* ksrc, const float* vsrc, int ld) {
    const int tid = tid_now();
#pragma unroll
    for (int k = 0; k < 2; ++k) { const int idx = tid + 512 * k, r = idx >> 4, q = idx & 15; KT[idx] = *(const f4*)(ksrc + (size_t)r * ld + q * 4); VT[idx] = *(const f4*)(vsrc + (size_t)r * ld + q * 4); }
}
__device__ __forceinline__ void nsa_unit(LAS unsigned char* lds, const float* zm, const float* kcmp, const float* vcmp, const float* biasd_g, float* o_nsa, int b, int qt) {
    const int tid = tid_now(), wave = __builtin_amdgcn_readfirstlane(tid >> 6), lane = tid & 63, h = wave & 3; const bool act = wave < 4;
    LAS f4* KC = (LAS f4*)lds; LAS f4* VC = (LAS f4*)(lds + 32768); LAS float* IMP = (LAS float*)(lds + 65536);
    LAS f4* KT = (LAS f4*)(lds + 98304); LAS f4* VT = (LAS f4*)(lds + 114688); LAS float* BD = (LAS float*)(lds + 131072); LAS unsigned* UNI = (LAS unsigned*)(lds + 133120);
    LAS float* OUTL = (LAS float*)lds;
    const int t = qt * 64 + lane; const size_t row = (size_t)b * SEQ + t;
    __syncthreads();
    for (int i = tid; i < 2048; i += NT) { f4 z = (f4){0.f, 0.f, 0.f, 0.f}; KC[i] = (i < NCMP * 16) ? ((const f4*)(kcmp + (size_t)b * NCMP * 64))[i] : z; VC[i] = (i < NCMP * 16) ? ((const f4*)(vcmp + (size_t)b * NCMP * 64))[i] : z; }
    BD[tid] = biasd_g[tid];
    float q[64], o[64]; float g0 = 0.f, g1 = 0.f, g2 = 0.f;
    if (act) {
        const float* zr = zm + row * ZM;
#pragma unroll
        for (int i = 0; i < 16; ++i) { const f4 v = *(const f4*)(zr + C_Q + h * 64 + 4 * i); q[4 * i] = v.x * 0.125f; q[4 * i + 1] = v.y * 0.125f; q[4 * i + 2] = v.z * 0.125f; q[4 * i + 3] = v.w * 0.125f; }
        g0 = sigmoidf_(zr[C_NG + h * 3]); g1 = sigmoidf_(zr[C_NG + h * 3 + 1]); g2 = sigmoidf_(zr[C_NG + h * 3 + 2]);
    }
    __syncthreads();
    const LAS float* bd = BD + h * 128;
    const int nv = (t >= 31) ? ((t - 31) >> 4) + 1 : 0;
    const int tmax = qt * 64 + 63, nvmax = ((tmax - 31) >> 4) + 1;
    if (act) {
        float m = -3e38f, l = 0.f;
        for (int n = 0; n < nvmax; ++n) if (n < nv) { const int dd = t - (16 * n + 31); const float s = dot64(q, KC + n * 16) + bd[dd < 127 ? dd : 127];
            const float mn = fmaxf(m, s); l = l * __expf(m - mn) + __expf(s - mn); m = mn; }
        const float inv = (nv > 0) ? 1.f / l : 0.f;
#pragma unroll
        for (int i = 0; i < 64; ++i) o[i] = 0.f;
        float accb = 0.f;
        for (int mb = 0; mb < 32; ++mb) {
#pragma unroll
            for (int j = 0; j < 4; ++j) { const int n = 4 * mb + j; float p = 0.f;
                if (n < nvmax) { if (n < nv) { const int dd = t - (16 * n + 31); const float s = dot64(q, KC + n * 16) + bd[dd < 127 ? dd : 127]; p = __expf(s - m) * inv;
#pragma unroll
                    for (int i = 0; i < 16; ++i) { const f4 vv = VC[n * 16 + i]; o[4 * i] += p * vv.x; o[4 * i + 1] += p * vv.y; o[4 * i + 2] += p * vv.z; o[4 * i + 3] += p * vv.w; } } }
                if (j < 3) accb += p; else { IMP[(h * 32 + mb) * 64 + lane] = accb + 0.5f * p; accb = 0.5f * p; } }
        }
    }
    __syncthreads();
    unsigned sel = 0u;
    if (act) {
        for (int r = 0; r < 8; ++r) { float best = -3e38f; int bi = -1;
            for (int mb = 0; mb <= qt; ++mb) if (!((sel >> mb) & 1u)) { float v = ((IMP[(0 * 32 + mb) * 64 + lane] + IMP[(1 * 32 + mb) * 64 + lane]) + IMP[(2 * 32 + mb) * 64 + lane]) + IMP[(3 * 32 + mb) * 64 + lane];
                if (mb == 0 || mb == qt || mb == qt - 1) v += 1e4f; if (v > best) { best = v; bi = mb; } }
            if (bi >= 0) sel |= 1u << bi; }
        unsigned uni = 0u;
        for (int mb = 0; mb <= qt; ++mb) if (__ballot((sel >> mb) & 1u) != 0ull) uni |= 1u << mb;
        if (wave == 0 && lane == 0) *UNI = uni;
    }
    __syncthreads();
    const unsigned uni = *UNI;
    if (act) {
#pragma unroll
        for (int i = 0; i < 64; ++i) OUTL[(h * 64 + i) * 64 + lane] = g0 * o[i];
    }
    float m = -3e38f, l = 0.f;
#pragma unroll
    for (int i = 0; i < 64; ++i) o[i] = 0.f;
    for (int blk = 0; blk <= qt; ++blk) {
        if (!((uni >> blk) & 1u)) continue;
        __syncthreads();
        stage_tile64(KT, VT, zm + (size_t)(b * SEQ + blk * 64) * ZM + C_KS, zm + (size_t)(b * SEQ + blk * 64) * ZM + C_VS, ZM);
        __syncthreads();
        if (act && ((sel >> blk) & 1u)) {
            for (int r = 0; r < 64; ++r) { const int dd = t - (blk * 64 + r); if (dd >= 0) { const float s = dot64(q, KT + r * 16) + bd[dd < 127 ? dd : 127]; osm_update(s, VT + r * 16, m, l, o); } }
        }
    }
    if (act) { const float sc = g1 / l;
#pragma unroll
        for (int i = 0; i < 64; ++i) OUTL[(h * 64 + i) * 64 + lane] += sc * o[i]; }
    m = -3e38f; l = 0.f;
#pragma unroll
    for (int i = 0; i < 64; ++i) o[i] = 0.f;
    for (int tb = (qt >= 8 ? qt - 8 : 0); tb <= qt; ++tb) {
        __syncthreads();
        stage_tile64(KT, VT, zm + (size_t)(b * SEQ + tb * 64) * ZM + C_KW, zm + (size_t)(b * SEQ + tb * 64) * ZM + C_VW, ZM);
        __syncthreads();
        if (act) {
            for (int r = 0; r < 64; ++r) { const int dd = t - (tb * 64 + r); if (dd >= 0 && dd < 512) { const float s = dot64(q, KT + r * 16) + bd[dd < 127 ? dd : 127]; osm_update(s, VT + r * 16, m, l, o); } }
        }
    }
    if (act) { const float sc = g2 / l; float* op = o_nsa + row * MW + h * 64;
#pragma unroll
        for (int i = 0; i < 16; ++i) { f4 v; v.x = OUTL[(h * 64 + 4 * i) * 64 + lane] + sc * o[4 * i]; v.y = OUTL[(h * 64 + 4 * i + 1) * 64 + lane] + sc * o[4 * i + 1];
            v.z = OUTL[(h * 64 + 4 * i + 2) * 64 + lane] + sc * o[4 * i + 2]; v.w = OUTL[(h * 64 + 4 * i + 3) * 64 + lane] + sc * o[4 * i + 3]; *(f4*)(op + 4 * i) = v; } }
    __syncthreads();
}

__device__ __forceinline__ void ret_unit(LAS unsigned char* lds, const float* zm, const float* norm_g, float* o_ret, int b, int qt) {
    const int tid = tid_now(), wave = __builtin_amdgcn_readfirstlane(tid >> 6), lane = tid & 63, h = wave & 3; const bool act = wave < 4;
    LAS f4* KT = (LAS f4*)lds;
    LAS f4* VT = (LAS f4*)(lds + 65536);
    const int t = qt * 64 + lane; const size_t row = (size_t)b * SEQ + t;
    float q[64], o[64];
    if (act) { const float* zr = zm + row * ZM + C_RQ + h * 64;
#pragma unroll
        for (int i = 0; i < 16; ++i) { const f4 v = *(const f4*)(zr + 4 * i); q[4 * i] = v.x; q[4 * i + 1] = v.y; q[4 * i + 2] = v.z; q[4 * i + 3] = v.w; } }
#pragma unroll
    for (int i = 0; i < 64; ++i) o[i] = 0.f;
    const float lg2 = log2f(1.f - exp2f(-5.f - (float)h));
    for (int kb = 0; kb <= qt; ++kb) {
        __syncthreads();
#pragma unroll
        for (int k = 0; k < 8; ++k) { const int idx = tid + 512 * k, r = idx >> 6, c = idx & 63, hh = c >> 4, qq = c & 15;
            const float* src = zm + (size_t)(b * SEQ + kb * 64 + r) * ZM;
            KT[(hh * 64 + r) * 16 + qq] = *(const f4*)(src + C_RK + c * 4); VT[(hh * 64 + r) * 16 + qq] = *(const f4*)(src + C_RV + c * 4); }
        __syncthreads();
        if (act) {
            for (int r = 0; r < 64; ++r) { const int dd = t - (kb * 64 + r); if (dd >= 0) { const float w = dot64(q, KT + (h * 64 + r) * 16) * exp2f((float)dd * lg2);
#pragma unroll
                for (int i = 0; i < 16; ++i) { const f4 vv = VT[(h * 64 + r) * 16 + i]; o[4 * i] += w * vv.x; o[4 * i + 1] += w * vv.y; o[4 * i + 2] += w * vv.z; o[4 * i + 3] += w * vv.w; } } }
        }
    }
    if (act) {
        float mu = 0.f;
#pragma unroll
        for (int i = 0; i < 64; ++i) mu += o[i];
        mu *= (1.f / 64.f); float var = 0.f;
#pragma unroll
        for (int i = 0; i < 64; ++i) { o[i] -= mu; var += o[i] * o[i]; }
        const float rs = 1.f / sqrtf(var * (1.f / 64.f) + 1e-5f);
        const float* gr = zm + row * ZM + C_RG + h * 64; float* op = o_ret + row * MW + h * 64;
#pragma unroll
        for (int i = 0; i < 16; ++i) { const f4 g = *(const f4*)(gr + 4 * i), ng = *(const f4*)(norm_g + h * 64 + 4 * i); f4 v;
            v.x = g.x * sigmoidf_(g.x) * o[4 * i] * rs * ng.x; v.y = g.y * sigmoidf_(g.y) * o[4 * i + 1] * rs * ng.y; v.z = g.z * sigmoidf_(g.z) * o[4 * i + 2] * rs * ng.z; v.w = g.w * sigmoidf_(g.w) * o[4 * i + 3] * rs * ng.w;
            *(f4*)(op + 4 * i) = v; }
    }
    __syncthreads();
}

__device__ __forceinline__ void xattn_unit(LAS unsigned char* lds, const float* Q, const float* KV, float* O, int b, int hh, int qt) {
    const int tid = tid_now(), ql = tid >> 2, sl = tid & 3;
    LAS f4* KT = (LAS f4*)lds;
    LAS f4* VT = (LAS f4*)(lds + 32768);
    const size_t row = (size_t)b * SEQ + qt * 128 + ql;
    float q[64], o[64];
    { const float* qr = Q + row * DM + hh * 256 + sl * 64;
#pragma unroll
        for (int i = 0; i < 16; ++i) { const f4 v = *(const f4*)(qr + 4 * i); q[4 * i] = v.x * 0.0625f; q[4 * i + 1] = v.y * 0.0625f; q[4 * i + 2] = v.z * 0.0625f; q[4 * i + 3] = v.w * 0.0625f; } }
#pragma unroll
    for (int i = 0; i < 64; ++i) o[i] = 0.f;
    float m = -3e38f, l = 0.f;
    for (int kb = 0; kb < 8; ++kb) {
        __syncthreads();
#pragma unroll
        for (int k = 0; k < 4; ++k) { const int idx = tid + 512 * k, r = idx >> 6, c = idx & 63; const float* src = KV + (size_t)(b * MEMLEN + kb * 32 + r) * 2048 + hh * 256 + c * 4;
            KT[idx] = *(const f4*)src; VT[idx] = *(const f4*)(src + 1024); }
        __syncthreads();
        for (int r = 0; r < 32; ++r) { float s = dot64(q, KT + r * 64 + sl * 16); s += __shfl_xor(s, 1); s += __shfl_xor(s, 2); osm_update(s, VT + r * 64 + sl * 16, m, l, o); }
    }
    const float inv = 1.f / l; float* op = O + row * DM + hh * 256 + sl * 64;
#pragma unroll
    for (int i = 0; i < 16; ++i) *(f4*)(op + 4 * i) = (f4){o[4 * i] * inv, o[4 * i + 1] * inv, o[4 * i + 2] * inv, o[4 * i + 3] * inv};
    __syncthreads();
}

constexpr int NPL = 14, NPHASES = 1 + DEPTH * NPL;
__global__ void __launch_bounds__(NT, 2) mk_fwd(Args args) {
    extern __shared__ __attribute__((aligned(16))) unsigned char lds_raw[];
    LAS unsigned char* lds = (LAS unsigned char*)lds_raw;
    const int G = gridDim.x, NGW = G * NWAVES, NGT = G * NT;
#define PH_IDS const int tid = tid_now(), lane = tid & 63, wave = __builtin_amdgcn_readfirstlane(tid >> 6), gw = blockIdx.x * NWAVES + wave, gt = blockIdx.x * NT + tid; (void)lane; (void)gw; (void)gt;
    unsigned char* ws = args.ws;
    float* TABC = (float*)(ws + WS_TAB); float* TABS = TABC + 65536; float* BIASD = TABC + 131072;
    float* KCMP = (float*)(ws + WS_CMP); float* VCMP = KCMP + BATCH * NCMP * 64;
    float* H = (float*)(ws + WS_H); float* ZMB = (float*)(ws + WS_ZM); float* RW = (float*)(ws + WS_RW); float* BR = (float*)(ws + WS_BR);
    float* MERGED = (float*)(ws + WS_MERGED); float* Y = (float*)(ws + WS_Y); float* Qb = (float*)(ws + WS_Q); float* Ob = (float*)(ws + WS_O);
    float* MN = (float*)(ws + WS_MN); float* KV = (float*)(ws + WS_KV); float* HID = (float*)(ws + WS_HID);
    const float* const* P = args.in; float* OUT = args.out;
    const int lo = args.ph_lo, hi = args.ph_hi;
#define IN(k) (lo <= (k) && (k) < hi)
#define SEAM() do { } while (0)

    if (IN(0)) {
        PH_IDS
        for (int i = gt; i < SEQ * 32; i += NGT) { const int t = i >> 5, j = i & 31; const double rev = (double)t * INVF_REV[j]; const float fr = (float)(rev - floor(rev)); TABC[i] = __builtin_amdgcn_cosf(fr); TABS[i] = __builtin_amdgcn_sinf(fr); }
        for (int i = gt; i < 512; i += NGT) { const int h = i >> 7, d = i & 127; BIASD[i] = P[6][T5B[d] * MH + h]; }
        rms_rows(P[0], P[2], H, MTOK, gw, NGW, lane);
        SEAM();
    }
    for (int l = 0; l < DEPTH; ++l) {
        const int pb = 1 + l * NPL;
        const float* xin = (l == 0) ? P[0] : OUT;
        const float* w_in_l = P[3] + (size_t)l * DM * IN_COLS;
        if (IN(pb + 0)) { sgemm_phase<0>(lds, H, DM, w_in_l, IN_COLS, ZMB, ZM, MTOK, ZM, DM); SEAM(); }
        if (IN(pb + 1)) {
            PH_IDS
            for (int u = gw; u < BATCH * NCMP * 2; u += NGW) nsa_compress_unit(ZMB, P[4] + (size_t)l * 2 * 32 * 64 * 64, P[5] + (size_t)l * 32 * 64, KCMP, u, lane);
            { LAS float* scr = (LAS float*)lds + wave * 128; for (int tok = gw; tok < MTOK; tok += NGW) rwkv_prep_token(ZMB, RW, P, l, tok, lane, scr); }
            { const float* cw = P[19] + (size_t)l * 3 * MW; float* oc = BR + (size_t)3 * MTOK * MW;
                for (int i = gt; i < MTOK * 64; i += NGT) { const int tok = i >> 6, c4 = (i & 63) * 4, t = tok % SEQ; const float* z = ZMB + (size_t)tok * ZM;
                    const f4 bg = *(const f4*)(z + C_CB + c4); f4 u2 = *(const f4*)(z + C_CC + c4) * *(const f4*)(z + C_CX + c4);
                    f4 u1 = (f4){0.f, 0.f, 0.f, 0.f}, u0 = u1; if (t >= 1) u1 = *(const f4*)(z - ZM + C_CC + c4) * *(const f4*)(z - ZM + C_CX + c4); if (t >= 2) u0 = *(const f4*)(z - 2 * ZM + C_CC + c4) * *(const f4*)(z - 2 * ZM + C_CX + c4);
                    *(f4*)(oc + (size_t)tok * MW + c4) = bg * (*(const f4*)(cw + c4) * u0 + *(const f4*)(cw + MW + c4) * u1 + *(const f4*)(cw + 2 * MW + c4) * u2); } }
            for (int i = gt; i < MTOK * 2 * 4 * 32; i += NGT) { const int j = i & 31, h = (i >> 5) & 3, qk = (i >> 7) & 1, tok = i >> 8, t = tok % SEQ;
                float* p = ZMB + (size_t)tok * ZM + (qk ? C_RK : C_RQ) + h * 64 + j; const float c = TABC[t * 32 + j], s = TABS[t * 32 + j], u1 = p[0], u2 = p[32], sc = qk ? 1.f : 0.125f;
                p[0] = (u1 * c - u2 * s) * sc; p[32] = (u2 * c + u1 * s) * sc; }
            SEAM();
        }
        if (IN(pb + 2)) {
            for (int u = blockIdx.x; u < 32 + 256 + 256; u += G) {
                if (u < 32) { U_SCAN(rwkv_scan_unit(lds, RW, u >> 2, u & 3)); }
                else if (u < 288) { U_NSA(nsa_unit(lds, ZMB, KCMP, VCMP, BIASD, BR, (u - 32) >> 5, (u - 32) & 31)); }
                else { U_RET(ret_unit(lds, ZMB, P[7] + l * MW, BR + (size_t)MTOK * MW, (u - 288) >> 5, (u - 288) & 31)); }
            }
            SEAM();
        }
        if (IN(pb + 3)) { PH_IDS for (int tok = gw; tok < MTOK; tok += NGW) rwkv_fin_token(RW, BR + (size_t)2 * MTOK * MW, P[16] + l * MW, P[17] + l * MW, P[18] + l * MW, tok, lane); SEAM(); }
        if (IN(pb + 4)) { U_MRG(merge_phase(lds, H, w_in_l, BR, P[20] + (size_t)l * 4 * MW * DM, MERGED)); SEAM(); }
        if (IN(pb + 5)) { sgemm_phase<0>(lds, MERGED, DM, P[21] + (size_t)l * DM * DM, DM, Y, DM, MTOK, DM, DM); SEAM(); }
        if (IN(pb + 6)) { PH_IDS rowop(xin, Y, P[22] + l * DM, P[23] + l * DM, OUT, H, gw, NGW, lane); rms_rows(P[1], P[24] + l * DM, MN, BATCH * MEMLEN, gw, NGW, lane); SEAM(); }
        if (IN(pb + 7)) { sgemm_phase<0>(lds, H, DM, P[25] + (size_t)l * DM * DM, DM, Qb, DM, MTOK, DM, DM);
            sgemm_phase<0>(lds, MN, DM, P[26] + (size_t)l * DM * 2 * DM, 2 * DM, KV, 2 * DM, BATCH * MEMLEN, 2 * DM, DM); SEAM(); }
        if (IN(pb + 8)) { for (int u = blockIdx.x; u < BATCH * 4 * 16; u += G) { U_XA(xattn_unit(lds, Qb, KV, Ob, u >> 6, (u >> 4) & 3, u & 15)); } SEAM(); }
        if (IN(pb + 9)) { sgemm_phase<0>(lds, Ob, DM, P[27] + (size_t)l * DM * DM, DM, Y, DM, MTOK, DM, DM); SEAM(); }
        if (IN(pb + 10)) { PH_IDS rowop(OUT, Y, P[28] + l * DM, P[29] + l * DM, OUT, H, gw, NGW, lane); SEAM(); }
        if (IN(pb + 11)) { sgemm_phase<1>(lds, H, DM, P[30] + (size_t)l * DM * DFF, DFF, HID, DFF, MTOK, DFF, DM); SEAM(); }
        if (IN(pb + 12)) { sgemm_phase<0>(lds, HID, DFF, P[31] + (size_t)l * DFF * DM, DM, Y, DM, MTOK, DM, DFF); SEAM(); }
        if (IN(pb + 13)) { PH_IDS rowop(OUT, Y, P[32] + l * DM, (l + 1 < DEPTH) ? P[2] + (l + 1) * DM : nullptr, OUT, H, gw, NGW, lane); SEAM(); }
    }
#undef IN
}

extern "C" void kernel_launch(void* const* d_in, const int* in_sizes, int n_in, void* d_out, int out_size, void* d_ws, size_t ws_size, hipStream_t stream) {
    static int grid = 0;
    if (grid == 0) {
        if (n_in != 33 || out_size != MTOK * DM || ws_size < WS_END) { fprintf(stderr, "kernel_launch: unexpected shapes (n_in %d out %d ws %zu)\n", n_in, out_size, ws_size); grid = -1; return; }
        int dev = 0, cus = 0;
        if (hipGetDevice(&dev) != hipSuccess || hipDeviceGetAttribute(&cus, hipDeviceAttributeMultiprocessorCount, dev) != hipSuccess) { grid = -1; return; }
        if (hipFuncSetAttribute((const void*)mk_fwd, hipFuncAttributeMaxDynamicSharedMemorySize, LDS_BYTES) != hipSuccess) { fprintf(stderr, "kernel_launch: hipFuncSetAttribute failed\n"); grid = -1; return; }
        grid = cus;
    }
    if (grid < 0) return;
    (void)hipMemsetAsync((char*)d_ws + WS_CTL, 0, 1 * MiB, stream);
    Args a{};
    for (int i = 0; i < 33; ++i) a.in[i] = (const float*)d_in[i];
    a.out = (float*)d_out; a.ws = (unsigned char*)d_ws;
#if MK_PER_PHASE
    for (int p = 0; p < NPHASES; ++p) { a.ph_lo = p; a.ph_hi = p + 1; hipLaunchKernelGGL(mk_fwd, dim3(grid), dim3(NT), LDS_BYTES, stream, a); }
#else
    a.ph_lo = 0; a.ph_hi = NPHASES; hipLaunchKernelGGL(mk_fwd, dim3(grid), dim3(NT), LDS_BYTES, stream, a);
#endif
}
```

```cpp
#include <hip/hip_runtime.h>
#include <cstdio>
#include <cstdint>

#ifndef MK_PER_PHASE
#define MK_PER_PHASE 0
#endif


#ifdef DIS_SCAN
#define U_SCAN(x)
#else
#define U_SCAN(x) x
#endif
#ifdef DIS_NSA
#define U_NSA(x)
#else
#define U_NSA(x) x
#endif
#ifdef DIS_RET
#define U_RET(x)
#else
#define U_RET(x) x
#endif
#ifdef DIS_XA
#define U_XA(x)
#else
#define U_XA(x) x
#endif
#ifdef DIS_MRG
#define U_MRG(x)
#else
#define U_MRG(x) x
#endif
#define LAS __attribute__((address_space(3)))
typedef float f4 __attribute__((ext_vector_type(4)));

constexpr int NWAVES = 8, NT = 512;
constexpr int BATCH = 8, SEQ = 2048, DM = 1024, DEPTH = 4, MTOK = BATCH * SEQ;
constexpr int MEMLEN = 256, MW = 256, HD = 64, MH = 4, DFF = 4096;
constexpr int IN_COLS = 7436, ZM = 3340, GATE_OFF = 3340;
constexpr int NCMP = 127, NSLC = 32;
constexpr int C_Q = 0, C_KC = 256, C_VC = 320, C_KS = 384, C_VS = 448, C_KW = 512, C_VW = 576, C_NG = 640;
constexpr int C_RQ = 652, C_RK = 908, C_RV = 1164, C_RG = 1420, C_RW = 1676, C_CB = 2572, C_CC = 2828, C_CX = 3084;
constexpr int RWKV_COLS = 896;

constexpr size_t MiB = 1u << 20;
constexpr size_t WS_CTL = 0;
constexpr size_t WS_TAB = 1 * MiB;
constexpr size_t WS_CMP = 2 * MiB;
constexpr size_t WS_H = 4 * MiB;
constexpr size_t WS_ZM = 68 * MiB;
constexpr size_t WS_RW = 277 * MiB;
constexpr size_t WS_BR = 389 * MiB;
constexpr size_t WS_MERGED = 68 * MiB, WS_Y = 132 * MiB, WS_Q = 196 * MiB, WS_O = 260 * MiB;
constexpr size_t WS_MN = 389 * MiB, WS_KV = 397 * MiB, WS_HID = 196 * MiB;
constexpr size_t WS_END = 453 * MiB;
constexpr int LDS_BYTES = 147456, XB_LDS_OFF = 147440;
constexpr int CW_BAR = 4096;

__device__ const unsigned char T5B[128] = {0, 1, 2, 3, 4, 5, 6, 7, 8, 9, 10, 11, 12, 13, 14, 15, 16, 16, 16, 17, 17, 18, 18, 18, 19, 19, 19, 20, 20, 20, 20, 21, 21, 21, 21, 22, 22, 22, 22, 22, 23, 23, 23, 23, 23, 23, 24, 24, 24, 24, 24, 24, 25, 25, 25, 25, 25, 25, 25, 26, 26, 26, 26, 26, 26, 26, 26, 27, 27, 27, 27, 27, 27, 27, 27, 27, 27, 28, 28, 28, 28, 28, 28, 28, 28, 28, 28, 29, 29, 29, 29, 29, 29, 29, 29, 29, 29, 29, 29, 30, 30, 30, 30, 30, 30, 30, 30, 30, 30, 30, 30, 30, 30, 31, 31, 31, 31, 31, 31, 31, 31, 31, 31, 31, 31, 31, 31, 31};

__device__ const double INVF_REV[32] = {0.15915494309189535, 0.11934937021124885, 0.08949940160889101, 0.06711508300522726, 0.05032921210448703, 0.037741584717419764, 0.028302195830623395, 0.02122365276477766, 0.01591549430918953, 0.011934937021124881, 0.008949940160889099, 0.0067115083005227245, 0.005032921210448702, 0.003774158471741975, 0.0028302195830623394, 0.0021223652764777645, 0.0015915494309189527, 0.0011934937021124885, 0.0008949940160889096, 0.0006711508300522724, 0.0005032921210448699, 0.00037741584717419747, 0.00028302195830623385, 0.00021223652764777642, 0.00015915494309189524, 0.00011934937021124881, 8.949940160889094e-05, 6.711508300522721e-05, 5.032921210448702e-05, 3.7741584717419736e-05, 2.830219583062336e-05, 2.1223652764777656e-05};

struct Args { const float* in[33]; float* out; unsigned char* ws; int ph_lo, ph_hi; };


#define XB_TMO      128
#define XB_XCNT(j)  (256  + 64 * (j))
#define XB_XSUB(j)  (1280 + 64 * (j))
#define XB_XGEN(j)  (2304 + 64 * (j))
#define XB_TOP      3328
#define XB_TOPGEN   3392
#define XCD_BAR_WORDS 3456
#define XB_SPIN_CAP (1u << 18)

__device__ __forceinline__ unsigned xb_ld(unsigned* p)              { return __hip_atomic_load(p, __ATOMIC_RELAXED, __HIP_MEMORY_SCOPE_AGENT); }
__device__ __forceinline__ unsigned xb_add(unsigned* p, unsigned v) { return __hip_atomic_fetch_add(p, v, __ATOMIC_RELAXED, __HIP_MEMORY_SCOPE_AGENT); }
__device__ __forceinline__ unsigned xb_xcc_id() { return (unsigned)__builtin_amdgcn_s_getreg((3 << 11) | 20) & 0xFu; }
#define XB_SPIN(cond, bar) do { unsigned _sp = 0; while (cond) { __builtin_amdgcn_s_sleep(1); \
    if ((++_sp & 255u) == 0u) { if (xb_ld(&(bar)[XB_TMO])) break; if (_sp > XB_SPIN_CAP) { atomicAdd(&(bar)[XB_TMO], 1u); break; } } } } while (0)

struct XcdBarrier {
    unsigned* bar; unsigned x;
    volatile LAS unsigned* st;
};

__device__ __forceinline__ XcdBarrier xcd_barrier_post(unsigned* bar, volatile LAS unsigned* st) {
    XcdBarrier b; b.bar = bar; b.x = xb_xcc_id(); b.st = st;
    if (threadIdx.x == 0) (void)xb_add(&bar[XB_XCNT(b.x)], 1u);
    return b;
}
__device__ __forceinline__ void xcd_barrier_complete(unsigned* bar, unsigned x, unsigned& nloc, unsigned& nx) {
    const unsigned G = gridDim.x * gridDim.y * gridDim.z;
    unsigned sum, cnt, mine, sp = 0u;
    for (;;) {
        sum = 0u; cnt = 0u; mine = 0u;
#pragma unroll
        for (unsigned j = 0; j < 16; ++j) { const unsigned c = xb_ld(&bar[XB_XCNT(j)]); sum += c; cnt += (c > 0u) ? 1u : 0u; mine = (j == x) ? c : mine; }
        if (sum == G) break;
        __builtin_amdgcn_s_sleep(1);
        if ((++sp & 255u) == 0u) { if (xb_ld(&bar[XB_TMO])) break; if (sp > XB_SPIN_CAP) { atomicAdd(&bar[XB_TMO], 1u); break; } }
    }
    nloc = mine > 0u ? mine : 1u; nx = cnt > 0u ? cnt : 1u;
}

__device__ __forceinline__ void xcd_barrier(const XcdBarrier& b) {
    asm volatile("s_waitcnt vmcnt(0)" ::: "memory");
    __syncthreads();
    if (threadIdx.x == 0) {
        unsigned* bar = b.bar;
        __builtin_amdgcn_s_waitcnt(0);
        unsigned nloc = b.st[0], nx = b.st[1];
        if (nloc == 0u) { xcd_barrier_complete(bar, b.x, nloc, nx); b.st[0] = nloc; b.st[1] = nx; }
        const unsigned old = xb_add(&bar[XB_XSUB(b.x)], 1u);
        const unsigned gen = old / nloc;
        if (old + 1u == (gen + 1u) * nloc) {
            __builtin_amdgcn_fence(__ATOMIC_RELEASE, "agent");
            asm volatile("s_waitcnt vmcnt(0)" ::: "memory");
            const unsigned og = xb_add(&bar[XB_TOP], 1u);
            const unsigned tg = og / nx;
            if (og + 1u == (tg + 1u) * nx) xb_add(&bar[XB_TOPGEN], 1u);
            else XB_SPIN(xb_ld(&bar[XB_TOPGEN]) == tg, bar);
            __builtin_amdgcn_fence(__ATOMIC_ACQUIRE, "agent");
            xb_add(&bar[XB_XGEN(b.x)], 1u);
            asm volatile("s_waitcnt vmcnt(0)" ::: "memory");
        } else {
            XB_SPIN(xb_ld(&bar[XB_XGEN(b.x)]) == gen, bar);
            __builtin_amdgcn_fence(__ATOMIC_ACQUIRE, "agent");
            asm volatile("s_waitcnt vmcnt(0)" ::: "memory");
        }
    }
    __syncthreads();
}

__device__ __forceinline__ int tid_now() { int t = threadIdx.x; asm volatile("" : "+v"(t)); return t; }
__device__ __forceinline__ float wsum(float v) {
#pragma unroll
    for (int o = 32; o >= 1; o >>= 1) v += __shfl_xor(v, o);
    return v;
}
__device__ __forceinline__ float gsum16(float v) {
#pragma unroll
    for (int o = 8; o >= 1; o >>= 1) v += __shfl_xor(v, o);
    return v;
}
__device__ __forceinline__ float sigmoidf_(float x) { return 1.f / (1.f + __expf(-x)); }
__device__ __forceinline__ float dot64(const float (&q)[64], const LAS f4* k) {
    float a0 = 0.f, a1 = 0.f, a2 = 0.f, a3 = 0.f;
#pragma unroll
    for (int i = 0; i < 16; ++i) { const f4 kv = k[i]; a0 += q[4 * i] * kv.x; a1 += q[4 * i + 1] * kv.y; a2 += q[4 * i + 2] * kv.z; a3 += q[4 * i + 3] * kv.w; }
    return (a0 + a1) + (a2 + a3);
}
__device__ __forceinline__ void osm_update(float s, const LAS f4* v, float& m, float& l, float (&o)[64]) {
    const float mn = fmaxf(m, s), sc = __expf(m - mn), p = __expf(s - mn);
    l = l * sc + p; m = mn;
#pragma unroll
    for (int i = 0; i < 16; ++i) { const f4 vv = v[i];
        o[4 * i] = o[4 * i] * sc + p * vv.x; o[4 * i + 1] = o[4 * i + 1] * sc + p * vv.y; o[4 * i + 2] = o[4 * i + 2] * sc + p * vv.z; o[4 * i + 3] = o[4 * i + 3] * sc + p * vv.w; }
}

__device__ __forceinline__ void rms_rows(const float* x, const float* g, float* out, int nrows, int gw, int NGW, int lane) {
    for (int m = gw; m < nrows; m += NGW) {
        const f4* xr = (const f4*)(x + (size_t)m * DM) + lane; f4 v[4]; float s = 0.f;
#pragma unroll
        for (int j = 0; j < 4; ++j) { v[j] = xr[64 * j]; s += v[j].x * v[j].x + v[j].y * v[j].y + v[j].z * v[j].z + v[j].w * v[j].w; }
        const float r = 1.f / sqrtf(wsum(s) * (1.f / DM) + 1e-6f);
        f4* o = (f4*)(out + (size_t)m * DM) + lane;
#pragma unroll
        for (int j = 0; j < 4; ++j) { const f4 gg = ((const f4*)g)[lane + 64 * j]; o[64 * j] = v[j] * r * gg; }
    }
}
__device__ __forceinline__ void rowop(const float* xin, const float* y, const float* g1, const float* g2, float* xout, float* h, int gw, int NGW, int lane) {
    for (int m = gw; m < MTOK; m += NGW) {
        const f4* yr = (const f4*)(y + (size_t)m * DM) + lane; const f4* xr = (const f4*)(xin + (size_t)m * DM) + lane; f4 v[4]; float s = 0.f;
#pragma unroll
        for (int j = 0; j < 4; ++j) { v[j] = yr[64 * j]; s += v[j].x * v[j].x + v[j].y * v[j].y + v[j].z * v[j].z + v[j].w * v[j].w; }
        const float r = 1.f / sqrtf(wsum(s) * (1.f / DM) + 1e-6f);
        float s2 = 0.f; f4* xo = (f4*)(xout + (size_t)m * DM) + lane;
#pragma unroll
        for (int j = 0; j < 4; ++j) { const f4 gg = ((const f4*)g1)[lane + 64 * j]; v[j] = xr[64 * j] + v[j] * r * gg; xo[64 * j] = v[j];
            s2 += v[j].x * v[j].x + v[j].y * v[j].y + v[j].z * v[j].z + v[j].w * v[j].w; }
        if (g2) { const float r2 = 1.f / sqrtf(wsum(s2) * (1.f / DM) + 1e-6f); f4* ho = (f4*)(h + (size_t)m * DM) + lane;
#pragma unroll
            for (int j = 0; j < 4; ++j) { const f4 gg = ((const f4*)g2)[lane + 64 * j]; ho[64 * j] = v[j] * r2 * gg; } }
    }
}

__device__ __forceinline__ void sgemm_tile(LAS float* As, LAS float* Bs, const float* A, int lda, const float* B, int ldb, int K, int row0, int col0, int N, float (&acc)[8][4]) {
    const int tid = tid_now(), tx = tid & 31, ty = tid >> 5;
#pragma unroll
    for (int i = 0; i < 8; ++i)
#pragma unroll
        for (int j = 0; j < 4; ++j) acc[i][j] = 0.f;
    const int ar = tid >> 2, akq = (tid & 3) * 4, bk = tid >> 5, bn = (tid & 31) * 4;
    const bool bok = (col0 + bn) < N;
    for (int k0 = 0; k0 < K; k0 += 16) {
        const f4 a = *(const f4*)(A + (size_t)(row0 + ar) * lda + k0 + akq);
        f4 b = (f4){0.f, 0.f, 0.f, 0.f}; if (bok) b = *(const f4*)(B + (size_t)(k0 + bk) * ldb + col0 + bn);
        __syncthreads();
        As[(akq + 0) * 132 + ar] = a.x; As[(akq + 1) * 132 + ar] = a.y; As[(akq + 2) * 132 + ar] = a.z; As[(akq + 3) * 132 + ar] = a.w;
        *(LAS f4*)(Bs + bk * 128 + bn) = b;
        __syncthreads();
#pragma unroll
        for (int kk = 0; kk < 16; ++kk) {
            const f4 a0 = *(const LAS f4*)(As + kk * 132 + ty * 8), a1 = *(const LAS f4*)(As + kk * 132 + ty * 8 + 4), bb = *(const LAS f4*)(Bs + kk * 128 + tx * 4);
            const float av[8] = {a0.x, a0.y, a0.z, a0.w, a1.x, a1.y, a1.z, a1.w};
#pragma unroll
            for (int i = 0; i < 8; ++i) { acc[i][0] += av[i] * bb.x; acc[i][1] += av[i] * bb.y; acc[i][2] += av[i] * bb.z; acc[i][3] += av[i] * bb.w; }
        }
    }
}
template <int EPI>
__device__ __forceinline__ void sgemm_phase(LAS unsigned char* lds, const float* A, int lda, const float* B, int ldb, float* C, int ldc, int M, int N, int K) {
    LAS float* As = (LAS float*)lds; LAS float* Bs = As + 16 * 132;
    const int tilesN = (N + 127) / 128, tiles = (M / 128) * tilesN, tid_ = tid_now(), tx = tid_ & 31, ty = tid_ >> 5;
    for (int t = blockIdx.x; t < tiles; t += gridDim.x) {
        const int tm = t / tilesN, tn = t % tilesN; float acc[8][4];
        sgemm_tile(As, Bs, A, lda, B, ldb, K, tm * 128, tn * 128, N, acc);
        const int c = tn * 128 + tx * 4;
        if (c < N) {
#pragma unroll
            for (int i = 0; i < 8; ++i) { f4 v = (f4){acc[i][0], acc[i][1], acc[i][2], acc[i][3]};
                if (EPI == 1) { v.x = fmaxf(v.x, 0.f); v.y = fmaxf(v.y, 0.f); v.z = fmaxf(v.z, 0.f); v.w = fmaxf(v.w, 0.f); v = v * v; }
                *(f4*)(C + (size_t)(tm * 128 + ty * 8 + i) * ldc + c) = v; }
        }
    }
}
__device__ __forceinline__ void merge_phase(LAS unsigned char* lds, const float* h, const float* w_in_l, const float* br, const float* w_branch_l, float* merged) {
    LAS float* As = (LAS float*)lds; LAS float* Bs = As + 16 * 132;
    const int tiles = (MTOK / 128) * 8, tid_ = tid_now(), tx = tid_ & 31, ty = tid_ >> 5;
    for (int t = blockIdx.x; t < tiles; t += gridDim.x) {
        const int tm = t / 8, tn = t % 8; float res[8][4];
#pragma unroll
        for (int i = 0; i < 8; ++i)
#pragma unroll
            for (int j = 0; j < 4; ++j) res[i][j] = 0.f;
        for (int m = 0; m < 4; ++m) {
            float a1[8][4], a2[8][4];
            sgemm_tile(As, Bs, h, DM, w_in_l + GATE_OFF + m * DM, IN_COLS, DM, tm * 128, tn * 128, DM, a1);
            sgemm_tile(As, Bs, br + (size_t)m * MTOK * MW, MW, w_branch_l + (size_t)m * MW * DM, DM, MW, tm * 128, tn * 128, DM, a2);
#pragma unroll
            for (int i = 0; i < 8; ++i)
#pragma unroll
                for (int j = 0; j < 4; ++j) res[i][j] += sigmoidf_(a1[i][j]) * a2[i][j];
        }
#pragma unroll
        for (int i = 0; i < 8; ++i) *(f4*)(merged + (size_t)(tm * 128 + ty * 8 + i) * DM + tn * 128 + tx * 4) = (f4){res[i][0], res[i][1], res[i][2], res[i][3]};
    }
}

__device__ __forceinline__ void nsa_compress_unit(const float* zm, const float* cmp_w_l, const float* pe_l, float* cmp_out, int u, int lane) {
    const int which = u & 1, bn = u >> 1, b = bn / NCMP, n = bn % NCMP;
    const float* W = cmp_w_l + (size_t)which * 32 * 64 * 64; const int col = which ? C_VC : C_KC;
    float acc = 0.f;
    for (int l = 0; l < 32; ++l) {
        const float* zr = zm + (size_t)(b * SEQ + 16 * n + l) * ZM + col;
#pragma unroll 8
        for (int d = 0; d < 64; ++d) acc += (zr[d] + pe_l[l * 64 + d]) * W[(l * 64 + d) * 64 + lane];
    }
    cmp_out[(size_t)which * BATCH * NCMP * 64 + (size_t)(b * NCMP + n) * 64 + lane] = acc;
}
__device__ __forceinline__ void rwkv_prep_token(const float* zm, float* rw, const float* const* P, int l, int tok, int lane, LAS float* scr) {
    const float* mu = P[8] + l * RWKV_COLS; const float* w0 = P[9] + l * MW; const float* w2 = P[10] + (size_t)l * 32 * MW; const float* a0 = P[11] + l * MW;
    const float* a2 = P[12] + (size_t)l * 32 * MW; const float* g2 = P[13] + (size_t)l * 64 * MW; const float* k_k = P[14] + l * MW; const float* k_a = P[15] + l * MW;
    const int t = tok % SEQ; const float* z = zm + (size_t)tok * ZM + C_RW; const float* zp = z - ZM;
    f4 rkv[3];
#pragma unroll
    for (int j = 0; j < 3; ++j) { const f4 c = *(const f4*)(z + j * 256 + 4 * lane); const f4 p = t ? *(const f4*)(zp + j * 256 + 4 * lane) : (f4){0.f, 0.f, 0.f, 0.f};
        const f4 m = *(const f4*)(mu + j * 256 + 4 * lane); rkv[j] = c + (p - c) * m; }
    if (lane < 32) { const f4 c = *(const f4*)(z + 768 + 4 * lane); const f4 p = t ? *(const f4*)(zp + 768 + 4 * lane) : (f4){0.f, 0.f, 0.f, 0.f};
        const f4 m = *(const f4*)(mu + 768 + 4 * lane); f4 v = c + (p - c) * m;
        if (lane < 8) { v.x = tanhf(v.x); v.y = tanhf(v.y); v.z = tanhf(v.z); v.w = tanhf(v.w); }
        else if (lane >= 16) { v.x = sigmoidf_(v.x); v.y = sigmoidf_(v.y); v.z = sigmoidf_(v.z); v.w = sigmoidf_(v.w); }
        *(LAS f4*)(scr + 4 * lane) = v; }
    asm volatile("s_waitcnt lgkmcnt(0)" ::: "memory");
    f4 aw = (f4){0.f, 0.f, 0.f, 0.f}, aa = aw, ag = aw;
#pragma unroll 4
    for (int j = 0; j < 32; ++j) { aw += scr[j] * *(const f4*)(w2 + j * MW + 4 * lane); aa += scr[32 + j] * *(const f4*)(a2 + j * MW + 4 * lane); }
#pragma unroll 4
    for (int j = 0; j < 64; ++j) ag += scr[64 + j] * *(const f4*)(g2 + j * MW + 4 * lane);
    asm volatile("s_waitcnt lgkmcnt(0)" ::: "memory");
    const f4 w0v = *(const f4*)(w0 + 4 * lane), a0v = *(const f4*)(a0 + 4 * lane), kkv = *(const f4*)(k_k + 4 * lane), kav = *(const f4*)(k_a + 4 * lane);
    float dec[4], av[4], kk[4], k2[4]; float ss = 0.f;
#pragma unroll
    for (int i = 0; i < 4; ++i) { const float y = -(w0v[i] + aw[i]); const float sp = (y > 20.f) ? y : log1pf(expf(y)); const float wl = -sp - 0.5f; dec[i] = expf(-expf(wl));
        av[i] = 1.f / (1.f + expf(-(a0v[i] + aa[i]))); kk[i] = rkv[1][i] * kkv[i]; ss += kk[i] * kk[i]; k2[i] = rkv[1][i] * (1.f + (av[i] - 1.f) * kav[i]); }
    ss = gsum16(ss); const float inv = 1.f / fmaxf(sqrtf(ss), 1e-12f);
    float* o = rw + (size_t)tok * 7 * MW + 4 * lane;
    *(f4*)(o) = rkv[0]; *(f4*)(o + MW) = (f4){dec[0], dec[1], dec[2], dec[3]}; *(f4*)(o + 2 * MW) = (f4){k2[0], k2[1], k2[2], k2[3]}; *(f4*)(o + 3 * MW) = rkv[2];
    *(f4*)(o + 4 * MW) = (f4){kk[0] * inv, kk[1] * inv, kk[2] * inv, kk[3] * inv}; *(f4*)(o + 5 * MW) = (f4){kk[0] * inv * av[0], kk[1] * inv * av[1], kk[2] * inv * av[2], kk[3] * inv * av[3]};
    *(f4*)(o + 6 * MW) = ag;
}

__device__ __forceinline__ void rwkv_scan_unit(LAS unsigned char* lds, float* rw, int b, int h) {
    const int tid = tid_now(), row = tid >> 3, cg = tid & 7;
    LAS f4* buf = (LAS f4*)lds;
    LAS float* yb = (LAS float*)(lds + 98304);
    float s[8];
#pragma unroll
    for (int j = 0; j < 8; ++j) s[j] = 0.f;
    f4 pre[6];
#define GSRC(c, k) ((const f4*)(rw + ((size_t)(b * SEQ + (c) * 32 + (tid + 512 * (k)) / 96) * 7 + (((tid + 512 * (k)) % 96) >> 4)) * MW + h * 64 + (((tid + 512 * (k)) % 96) & 15) * 4))
#pragma unroll
    for (int k = 0; k < 6; ++k) pre[k] = *GSRC(0, k);
    __syncthreads();
#pragma unroll
    for (int k = 0; k < 6; ++k) buf[tid + 512 * k] = pre[k];
    __syncthreads();
    for (int c = 0; c < SEQ / 32; ++c) {
        if (c + 1 < SEQ / 32) {
#pragma unroll
            for (int k = 0; k < 6; ++k) pre[k] = *GSRC(c + 1, k);
        }
        const LAS f4* cb = buf + (c & 1) * 3072; LAS float* ybc = yb + (c & 1) * 2048;
        for (int i = 0; i < 32; ++i) {
            const LAS f4* S = cb + i * 96;
            const f4 k0 = S[64 + cg * 2], k1 = S[64 + cg * 2 + 1];
            float d = s[0] * k0.x + s[1] * k0.y + s[2] * k0.z + s[3] * k0.w + s[4] * k1.x + s[5] * k1.y + s[6] * k1.z + s[7] * k1.w;
            d += __shfl_xor(d, 1); d += __shfl_xor(d, 2); d += __shfl_xor(d, 4);
            const float sa = -d, vv = ((const LAS float*)(S + 48))[row];
            const f4 w0 = S[16 + cg * 2], w1 = S[16 + cg * 2 + 1], q0 = S[80 + cg * 2], q1 = S[80 + cg * 2 + 1], kk0 = S[32 + cg * 2], kk1 = S[32 + cg * 2 + 1];
            s[0] = s[0] * w0.x + sa * q0.x + vv * kk0.x; s[1] = s[1] * w0.y + sa * q0.y + vv * kk0.y; s[2] = s[2] * w0.z + sa * q0.z + vv * kk0.z; s[3] = s[3] * w0.w + sa * q0.w + vv * kk0.w;
            s[4] = s[4] * w1.x + sa * q1.x + vv * kk1.x; s[5] = s[5] * w1.y + sa * q1.y + vv * kk1.y; s[6] = s[6] * w1.z + sa * q1.z + vv * kk1.z; s[7] = s[7] * w1.w + sa * q1.w + vv * kk1.w;
            const f4 r0 = S[cg * 2], r1 = S[cg * 2 + 1];
            float y = s[0] * r0.x + s[1] * r0.y + s[2] * r0.z + s[3] * r0.w + s[4] * r1.x + s[5] * r1.y + s[6] * r1.z + s[7] * r1.w;
            y += __shfl_xor(y, 1); y += __shfl_xor(y, 2); y += __shfl_xor(y, 4);
            if (cg == 0) ybc[i * 64 + row] = y;
        }
        if (c + 1 < SEQ / 32) {
#pragma unroll
            for (int k = 0; k < 6; ++k) buf[((c + 1) & 1) * 3072 + tid + 512 * k] = pre[k];
        }
        __syncthreads();
        { const int i = tid >> 4, q = tid & 15; *(f4*)(rw + ((size_t)(b * SEQ + c * 32 + i) * 7 + 5) * MW + h * 64 + q * 4) = *(const LAS f4*)(ybc + i * 64 + q * 4); }
    }
    __syncthreads();
}
__device__ __forceinline__ void rwkv_fin_token(const float* rw, float* o_rwkv, const float* r_k, const float* ln_g, const float* ln_b, int tok, int lane) {
    const float* p = rw + (size_t)tok * 7 * MW + 4 * lane;
    const f4 r = *(const f4*)p, k2 = *(const f4*)(p + 2 * MW), v = *(const f4*)(p + 3 * MW), y = *(const f4*)(p + 5 * MW), g = *(const f4*)(p + 6 * MW);
    const f4 rk = *(const f4*)(r_k + 4 * lane), lg = *(const f4*)(ln_g + 4 * lane), lb = *(const f4*)(ln_b + 4 * lane);
    const float mu = gsum16(y.x + y.y + y.z + y.w) * (1.f / 64.f); const f4 yc = y - mu;
    const float var = gsum16(yc.x * yc.x + yc.y * yc.y + yc.z * yc.z + yc.w * yc.w) * (1.f / 64.f); const float rs = 1.f / sqrtf(var + 64e-5f);
    const float bonus = gsum16(r.x * k2.x * rk.x + r.y * k2.y * rk.y + r.z * k2.z * rk.z + r.w * k2.w * rk.w);
    *(f4*)(o_rwkv + (size_t)tok * MW + 4 * lane) = (yc * rs * lg + lb + bonus * v) * g;
}

__device__ __forceinline__ void stage_tile64(LAS f4* KT, LAS f4* VT, const float* ksrc, const float* vsrc, int ld) {
    const int tid = tid_now();
#pragma unroll
    for (int k = 0; k < 2; ++k) { const int idx = tid + 512 * k, r = idx >> 4, q = idx & 15; KT[idx] = *(const f4*)(ksrc + (size_t)r * ld + q * 4); VT[idx] = *(const f4*)(vsrc + (size_t)r * ld + q * 4); }
}
__device__ __forceinline__ void nsa_unit(LAS unsigned char* lds, const float* zm, const float* kcmp, const float* vcmp, const float* biasd_g, float* o_nsa, int b, int qt) {
    const int tid = tid_now(), wave = __builtin_amdgcn_readfirstlane(tid >> 6), lane = tid & 63, h = wave & 3; const bool act = wave < 4;
    LAS f4* KC = (LAS f4*)lds; LAS f4* VC = (LAS f4*)(lds + 32768); LAS float* IMP = (LAS float*)(lds + 65536);
    LAS f4* KT = (LAS f4*)(lds + 98304); LAS f4* VT = (LAS f4*)(lds + 114688); LAS float* BD = (LAS float*)(lds + 131072); LAS unsigned* UNI = (LAS unsigned*)(lds + 133120);
    LAS float* OUTL = (LAS float*)lds;
    const int t = qt * 64 + lane; const size_t row = (size_t)b * SEQ + t;
    __syncthreads();
    for (int i = tid; i < 2048; i += NT) { f4 z = (f4){0.f, 0.f, 0.f, 0.f}; KC[i] = (i < NCMP * 16) ? ((const f4*)(kcmp + (size_t)b * NCMP * 64))[i] : z; VC[i] = (i < NCMP * 16) ? ((const f4*)(vcmp + (size_t)b * NCMP * 64))[i] : z; }
    BD[tid] = biasd_g[tid];
    float q[64], o[64]; float g0 = 0.f, g1 = 0.f, g2 = 0.f;
    if (act) {
        const float* zr = zm + row * ZM;
#pragma unroll
        for (int i = 0; i < 16; ++i) { const f4 v = *(const f4*)(zr + C_Q + h * 64 + 4 * i); q[4 * i] = v.x * 0.125f; q[4 * i + 1] = v.y * 0.125f; q[4 * i + 2] = v.z * 0.125f; q[4 * i + 3] = v.w * 0.125f; }
        g0 = sigmoidf_(zr[C_NG + h * 3]); g1 = sigmoidf_(zr[C_NG + h * 3 + 1]); g2 = sigmoidf_(zr[C_NG + h * 3 + 2]);
    }
    __syncthreads();
    const LAS float* bd = BD + h * 128;
    const int nv = (t >= 31) ? ((t - 31) >> 4) + 1 : 0;
    const int tmax = qt * 64 + 63, nvmax = ((tmax - 31) >> 4) + 1;
    if (act) {
        float m = -3e38f, l = 0.f;
        for (int n = 0; n < nvmax; ++n) if (n < nv) { const int dd = t - (16 * n + 31); const float s = dot64(q, KC + n * 16) + bd[dd < 127 ? dd : 127];
            const float mn = fmaxf(m, s); l = l * __expf(m - mn) + __expf(s - mn); m = mn; }
        const float inv = (nv > 0) ? 1.f / l : 0.f;
#pragma unroll
        for (int i = 0; i < 64; ++i) o[i] = 0.f;
        float accb = 0.f;
        for (int mb = 0; mb < 32; ++mb) {
#pragma unroll
            for (int j = 0; j < 4; ++j) { const int n = 4 * mb + j; float p = 0.f;
                if (n < nvmax) { if (n < nv) { const int dd = t - (16 * n + 31); const float s = dot64(q, KC + n * 16) + bd[dd < 127 ? dd : 127]; p = __expf(s - m) * inv;
#pragma unroll
                    for (int i = 0; i < 16; ++i) { const f4 vv = VC[n * 16 + i]; o[4 * i] += p * vv.x; o[4 * i + 1] += p * vv.y; o[4 * i + 2] += p * vv.z; o[4 * i + 3] += p * vv.w; } } }
                if (j < 3) accb += p; else { IMP[(h * 32 + mb) * 64 + lane] = accb + 0.5f * p; accb = 0.5f * p; } }
        }
    }
    __syncthreads();
    unsigned sel = 0u;
    if (act) {
        for (int r = 0; r < 8; ++r) { float best = -3e38f; int bi = -1;
            for (int mb = 0; mb <= qt; ++mb) if (!((sel >> mb) & 1u)) { float v = ((IMP[(0 * 32 + mb) * 64 + lane] + IMP[(1 * 32 + mb) * 64 + lane]) + IMP[(2 * 32 + mb) * 64 + lane]) + IMP[(3 * 32 + mb) * 64 + lane];
                if (mb == 0 || mb == qt || mb == qt - 1) v += 1e4f; if (v > best) { best = v; bi = mb; } }
            if (bi >= 0) sel |= 1u << bi; }
        unsigned uni = 0u;
        for (int mb = 0; mb <= qt; ++mb) if (__ballot((sel >> mb) & 1u) != 0ull) uni |= 1u << mb;
        if (wave == 0 && lane == 0) *UNI = uni;
    }
    __syncthreads();
    const unsigned uni = *UNI;
    if (act) {
#pragma unroll
        for (int i = 0; i < 64; ++i) OUTL[(h * 64 + i) * 64 + lane] = g0 * o[i];
    }
    float m = -3e38f, l = 0.f;
#pragma unroll
    for (int i = 0; i < 64; ++i) o[i] = 0.f;
    for (int blk = 0; blk <= qt; ++blk) {
        if (!((uni >> blk) & 1u)) continue;
        __syncthreads();
        stage_tile64(KT, VT, zm + (size_t)(b * SEQ + blk * 64) * ZM + C_KS, zm + (size_t)(b * SEQ + blk * 64) * ZM + C_VS, ZM);
        __syncthreads();
        if (act && ((sel >> blk) & 1u)) {
            for (int r = 0; r < 64; ++r) { const int dd = t - (blk * 64 + r); if (dd >= 0) { const float s = dot64(q, KT + r * 16) + bd[dd < 127 ? dd : 127]; osm_update(s, VT + r * 16, m, l, o); } }
        }
    }
    if (act) { const float sc = g1 / l;
#pragma unroll
        for (int i = 0; i < 64; ++i) OUTL[(h * 64 + i) * 64 + lane] += sc * o[i]; }
    m = -3e38f; l = 0.f;
#pragma unroll
    for (int i = 0; i < 64; ++i) o[i] = 0.f;
    for (int tb = (qt >= 8 ? qt - 8 : 0); tb <= qt; ++tb) {
        __syncthreads();
        stage_tile64(KT, VT, zm + (size_t)(b * SEQ + tb * 64) * ZM + C_KW, zm + (size_t)(b * SEQ + tb * 64) * ZM + C_VW, ZM);
        __syncthreads();
        if (act) {
            for (int r = 0; r < 64; ++r) { const int dd = t - (tb * 64 + r); if (dd >= 0 && dd < 512) { const float s = dot64(q, KT + r * 16) + bd[dd < 127 ? dd : 127]; osm_update(s, VT + r * 16, m, l, o); } }
        }
    }
    if (act) { const float sc = g2 / l; float* op = o_nsa + row * MW + h * 64;
#pragma unroll
        for (int i = 0; i < 16; ++i) { f4 v; v.x = OUTL[(h * 64 + 4 * i) * 64 + lane] + sc * o[4 * i]; v.y = OUTL[(h * 64 + 4 * i + 1) * 64 + lane] + sc * o[4 * i + 1];
            v.z = OUTL[(h * 64 + 4 * i + 2) * 64 + lane] + sc * o[4 * i + 2]; v.w = OUTL[(h * 64 + 4 * i + 3) * 64 + lane] + sc * o[4 * i + 3]; *(f4*)(op + 4 * i) = v; } }
    __syncthreads();
}

__device__ __forceinline__ void ret_unit(LAS unsigned char* lds, const float* zm, const float* norm_g, float* o_ret, int b, int qt) {
    const int tid = tid_now(), wave = __builtin_amdgcn_readfirstlane(tid >> 6), lane = tid & 63, h = wave & 3; const bool act = wave < 4;
    LAS f4* KT = (LAS f4*)lds;
    LAS f4* VT = (LAS f4*)(lds + 65536);
    const int t = qt * 64 + lane; const size_t row = (size_t)b * SEQ + t;
    float q[64], o[64];
    if (act) { const float* zr = zm + row * ZM + C_RQ + h * 64;
#pragma unroll
        for (int i = 0; i < 16; ++i) { const f4 v = *(const f4*)(zr + 4 * i); q[4 * i] = v.x; q[4 * i + 1] = v.y; q[4 * i + 2] = v.z; q[4 * i + 3] = v.w; } }
#pragma unroll
    for (int i = 0; i < 64; ++i) o[i] = 0.f;
    const float lg2 = log2f(1.f - exp2f(-5.f - (float)h));
    for (int kb = 0; kb <= qt; ++kb) {
        __syncthreads();
#pragma unroll
        for (int k = 0; k < 8; ++k) { const int idx = tid + 512 * k, r = idx >> 6, c = idx & 63, hh = c >> 4, qq = c & 15;
            const float* src = zm + (size_t)(b * SEQ + kb * 64 + r) * ZM;
            KT[(hh * 64 + r) * 16 + qq] = *(const f4*)(src + C_RK + c * 4); VT[(hh * 64 + r) * 16 + qq] = *(const f4*)(src + C_RV + c * 4); }
        __syncthreads();
        if (act) {
            for (int r = 0; r < 64; ++r) { const int dd = t - (kb * 64 + r); if (dd >= 0) { const float w = dot64(q, KT + (h * 64 + r) * 16) * exp2f((float)dd * lg2);
#pragma unroll
                for (int i = 0; i < 16; ++i) { const f4 vv = VT[(h * 64 + r) * 16 + i]; o[4 * i] += w * vv.x; o[4 * i + 1] += w * vv.y; o[4 * i + 2] += w * vv.z; o[4 * i + 3] += w * vv.w; } } }
        }
    }
    if (act) {
        float mu = 0.f;
#pragma unroll
        for (int i = 0; i < 64; ++i) mu += o[i];
        mu *= (1.f / 64.f); float var = 0.f;
#pragma unroll
        for (int i = 0; i < 64; ++i) { o[i] -= mu; var += o[i] * o[i]; }
        const float rs = 1.f / sqrtf(var * (1.f / 64.f) + 1e-5f);
        const float* gr = zm + row * ZM + C_RG + h * 64; float* op = o_ret + row * MW + h * 64;
#pragma unroll
        for (int i = 0; i < 16; ++i) { const f4 g = *(const f4*)(gr + 4 * i), ng = *(const f4*)(norm_g + h * 64 + 4 * i); f4 v;
            v.x = g.x * sigmoidf_(g.x) * o[4 * i] * rs * ng.x; v.y = g.y * sigmoidf_(g.y) * o[4 * i + 1] * rs * ng.y; v.z = g.z * sigmoidf_(g.z) * o[4 * i + 2] * rs * ng.z; v.w = g.w * sigmoidf_(g.w) * o[4 * i + 3] * rs * ng.w;
            *(f4*)(op + 4 * i) = v; }
    }
    __syncthreads();
}

__device__ __forceinline__ void xattn_unit(LAS unsigned char* lds, const float* Q, const float* KV, float* O, int b, int hh, int qt) {
    const int tid = tid_now(), ql = tid >> 2, sl = tid & 3;
    LAS f4* KT = (LAS f4*)lds;
    LAS f4* VT = (LAS f4*)(lds + 32768);
    const size_t row = (size_t)b * SEQ + qt * 128 + ql;
    float q[64], o[64];
    { const float* qr = Q + row * DM + hh * 256 + sl * 64;
#pragma unroll
        for (int i = 0; i < 16; ++i) { const f4 v = *(const f4*)(qr + 4 * i); q[4 * i] = v.x * 0.0625f; q[4 * i + 1] = v.y * 0.0625f; q[4 * i + 2] = v.z * 0.0625f; q[4 * i + 3] = v.w * 0.0625f; } }
#pragma unroll
    for (int i = 0; i < 64; ++i) o[i] = 0.f;
    float m = -3e38f, l = 0.f;
    for (int kb = 0; kb < 8; ++kb) {
        __syncthreads();
#pragma unroll
        for (int k = 0; k < 4; ++k) { const int idx = tid + 512 * k, r = idx >> 6, c = idx & 63; const float* src = KV + (size_t)(b * MEMLEN + kb * 32 + r) * 2048 + hh * 256 + c * 4;
            KT[idx] = *(const f4*)src; VT[idx] = *(const f4*)(src + 1024); }
        __syncthreads();
        for (int r = 0; r < 32; ++r) { float s = dot64(q, KT + r * 64 + sl * 16); s += __shfl_xor(s, 1); s += __shfl_xor(s, 2); osm_update(s, VT + r * 64 + sl * 16, m, l, o); }
    }
    const float inv = 1.f / l; float* op = O + row * DM + hh * 256 + sl * 64;
#pragma unroll
    for (int i = 0; i < 16; ++i) *(f4*)(op + 4 * i) = (f4){o[4 * i] * inv, o[4 * i + 1] * inv, o[4 * i + 2] * inv, o[4 * i + 3] * inv};
    __syncthreads();
}

constexpr int NPL = 14, NPHASES = 1 + DEPTH * NPL;
__global__ void __launch_bounds__(NT, 2) mk_fwd(Args args) {
    extern __shared__ __attribute__((aligned(16))) unsigned char lds_raw[];
    LAS unsigned char* lds = (LAS unsigned char*)lds_raw;
    const int G = gridDim.x, NGW = G * NWAVES, NGT = G * NT;
#define PH_IDS const int tid = tid_now(), lane = tid & 63, wave = __builtin_amdgcn_readfirstlane(tid >> 6), gw = blockIdx.x * NWAVES + wave, gt = blockIdx.x * NT + tid; (void)lane; (void)gw; (void)gt;
    unsigned char* ws = args.ws;
    float* TABC = (float*)(ws + WS_TAB); float* TABS = TABC + 65536; float* BIASD = TABC + 131072;
    float* KCMP = (float*)(ws + WS_CMP); float* VCMP = KCMP + BATCH * NCMP * 64;
    float* H = (float*)(ws + WS_H); float* ZMB = (float*)(ws + WS_ZM); float* RW = (float*)(ws + WS_RW); float* BR = (float*)(ws + WS_BR);
    float* MERGED = (float*)(ws + WS_MERGED); float* Y = (float*)(ws + WS_Y); float* Qb = (float*)(ws + WS_Q); float* Ob = (float*)(ws + WS_O);
    float* MN = (float*)(ws + WS_MN); float* KV = (float*)(ws + WS_KV); float* HID = (float*)(ws + WS_HID);
    const float* const* P = args.in; float* OUT = args.out;
    const int lo = args.ph_lo, hi = args.ph_hi;
#define IN(k) (lo <= (k) && (k) < hi)
#if MK_PER_PHASE
#define SEAM() do { } while (0)
#else
    if (threadIdx.x < 4) ((LAS unsigned*)(lds + XB_LDS_OFF))[threadIdx.x] = 0u;
    __syncthreads();
    const XcdBarrier bar = xcd_barrier_post((unsigned*)(ws + WS_CTL) + CW_BAR, (volatile LAS unsigned*)(lds + XB_LDS_OFF));
#define SEAM() xcd_barrier(bar)
#endif

    if (IN(0)) {
        PH_IDS
        for (int i = gt; i < SEQ * 32; i += NGT) { const int t = i >> 5, j = i & 31; const double rev = (double)t * INVF_REV[j]; const float fr = (float)(rev - floor(rev)); TABC[i] = __builtin_amdgcn_cosf(fr); TABS[i] = __builtin_amdgcn_sinf(fr); }
        for (int i = gt; i < 512; i += NGT) { const int h = i >> 7, d = i & 127; BIASD[i] = P[6][T5B[d] * MH + h]; }
        rms_rows(P[0], P[2], H, MTOK, gw, NGW, lane);
        SEAM();
    }
    for (int l = 0; l < DEPTH; ++l) {
        const int pb = 1 + l * NPL;
        const float* xin = (l == 0) ? P[0] : OUT;
        const float* w_in_l = P[3] + (size_t)l * DM * IN_COLS;
        if (IN(pb + 0)) { sgemm_phase<0>(lds, H, DM, w_in_l, IN_COLS, ZMB, ZM, MTOK, ZM, DM); SEAM(); }
        if (IN(pb + 1)) {
            PH_IDS
            for (int u = gw; u < BATCH * NCMP * 2; u += NGW) nsa_compress_unit(ZMB, P[4] + (size_t)l * 2 * 32 * 64 * 64, P[5] + (size_t)l * 32 * 64, KCMP, u, lane);
            { LAS float* scr = (LAS float*)lds + wave * 128; for (int tok = gw; tok < MTOK; tok += NGW) rwkv_prep_token(ZMB, RW, P, l, tok, lane, scr); }
            { const float* cw = P[19] + (size_t)l * 3 * MW; float* oc = BR + (size_t)3 * MTOK * MW;
                for (int i = gt; i < MTOK * 64; i += NGT) { const int tok = i >> 6, c4 = (i & 63) * 4, t = tok % SEQ; const float* z = ZMB + (size_t)tok * ZM;
                    const f4 bg = *(const f4*)(z + C_CB + c4); f4 u2 = *(const f4*)(z + C_CC + c4) * *(const f4*)(z + C_CX + c4);
                    f4 u1 = (f4){0.f, 0.f, 0.f, 0.f}, u0 = u1; if (t >= 1) u1 = *(const f4*)(z - ZM + C_CC + c4) * *(const f4*)(z - ZM + C_CX + c4); if (t >= 2) u0 = *(const f4*)(z - 2 * ZM + C_CC + c4) * *(const f4*)(z - 2 * ZM + C_CX + c4);
                    *(f4*)(oc + (size_t)tok * MW + c4) = bg * (*(const f4*)(cw + c4) * u0 + *(const f4*)(cw + MW + c4) * u1 + *(const f4*)(cw + 2 * MW + c4) * u2); } }
            for (int i = gt; i < MTOK * 2 * 4 * 32; i += NGT) { const int j = i & 31, h = (i >> 5) & 3, qk = (i >> 7) & 1, tok = i >> 8, t = tok % SEQ;
                float* p = ZMB + (size_t)tok * ZM + (qk ? C_RK : C_RQ) + h * 64 + j; const float c = TABC[t * 32 + j], s = TABS[t * 32 + j], u1 = p[0], u2 = p[32], sc = qk ? 1.f : 0.125f;
                p[0] = (u1 * c - u2 * s) * sc; p[32] = (u2 * c + u1 * s) * sc; }
            SEAM();
        }
        if (IN(pb + 2)) {
            for (int u = blockIdx.x; u < 32 + 256 + 256; u += G) {
                if (u < 32) { U_SCAN(rwkv_scan_unit(lds, RW, u >> 2, u & 3)); }
                else if (u < 288) { U_NSA(nsa_unit(lds, ZMB, KCMP, VCMP, BIASD, BR, (u - 32) >> 5, (u - 32) & 31)); }
                else { U_RET(ret_unit(lds, ZMB, P[7] + l * MW, BR + (size_t)MTOK * MW, (u - 288) >> 5, (u - 288) & 31)); }
            }
            SEAM();
        }
        if (IN(pb + 3)) { PH_IDS for (int tok = gw; tok < MTOK; tok += NGW) rwkv_fin_token(RW, BR + (size_t)2 * MTOK * MW, P[16] + l * MW, P[17] + l * MW, P[18] + l * MW, tok, lane); SEAM(); }
        if (IN(pb + 4)) { U_MRG(merge_phase(lds, H, w_in_l, BR, P[20] + (size_t)l * 4 * MW * DM, MERGED)); SEAM(); }
        if (IN(pb + 5)) { sgemm_phase<0>(lds, MERGED, DM, P[21] + (size_t)l * DM * DM, DM, Y, DM, MTOK, DM, DM); SEAM(); }
        if (IN(pb + 6)) { PH_IDS rowop(xin, Y, P[22] + l * DM, P[23] + l * DM, OUT, H, gw, NGW, lane); rms_rows(P[1], P[24] + l * DM, MN, BATCH * MEMLEN, gw, NGW, lane); SEAM(); }
        if (IN(pb + 7)) { sgemm_phase<0>(lds, H, DM, P[25] + (size_t)l * DM * DM, DM, Qb, DM, MTOK, DM, DM);
            sgemm_phase<0>(lds, MN, DM, P[26] + (size_t)l * DM * 2 * DM, 2 * DM, KV, 2 * DM, BATCH * MEMLEN, 2 * DM, DM); SEAM(); }
        if (IN(pb + 8)) { for (int u = blockIdx.x; u < BATCH * 4 * 16; u += G) { U_XA(xattn_unit(lds, Qb, KV, Ob, u >> 6, (u >> 4) & 3, u & 15)); } SEAM(); }
        if (IN(pb + 9)) { sgemm_phase<0>(lds, Ob, DM, P[27] + (size_t)l * DM * DM, DM, Y, DM, MTOK, DM, DM); SEAM(); }
        if (IN(pb + 10)) { PH_IDS rowop(OUT, Y, P[28] + l * DM, P[29] + l * DM, OUT, H, gw, NGW, lane); SEAM(); }
        if (IN(pb + 11)) { sgemm_phase<1>(lds, H, DM, P[30] + (size_t)l * DM * DFF, DFF, HID, DFF, MTOK, DFF, DM); SEAM(); }
        if (IN(pb + 12)) { sgemm_phase<0>(lds, HID, DFF, P[31] + (size_t)l * DFF * DM, DM, Y, DM, MTOK, DM, DFF); SEAM(); }
        if (IN(pb + 13)) { PH_IDS rowop(OUT, Y, P[32] + l * DM, (l + 1 < DEPTH) ? P[2] + (l + 1) * DM : nullptr, OUT, H, gw, NGW, lane); SEAM(); }
    }
#undef IN
}

extern "C" void kernel_launch(void* const* d_in, const int* in_sizes, int n_in, void* d_out, int out_size, void* d_ws, size_t ws_size, hipStream_t stream) {
    static int grid = 0;
    if (grid == 0) {
        if (n_in != 33 || out_size != MTOK * DM || ws_size < WS_END) { fprintf(stderr, "kernel_launch: unexpected shapes (n_in %d out %d ws %zu)\n", n_in, out_size, ws_size); grid = -1; return; }
        int dev = 0, cus = 0;
        if (hipGetDevice(&dev) != hipSuccess || hipDeviceGetAttribute(&cus, hipDeviceAttributeMultiprocessorCount, dev) != hipSuccess) { grid = -1; return; }
        if (hipFuncSetAttribute((const void*)mk_fwd, hipFuncAttributeMaxDynamicSharedMemorySize, LDS_BYTES) != hipSuccess) { fprintf(stderr, "kernel_launch: hipFuncSetAttribute failed\n"); grid = -1; return; }
        grid = cus;
    }
    if (grid < 0) return;
    (void)hipMemsetAsync((char*)d_ws + WS_CTL, 0, 1 * MiB, stream);
    Args a{};
    for (int i = 0; i < 33; ++i) a.in[i] = (const float*)d_in[i];
    a.out = (float*)d_out; a.ws = (unsigned char*)d_ws;
#if MK_PER_PHASE
    for (int p = 0; p < NPHASES; ++p) { a.ph_lo = p; a.ph_hi = p + 1; hipLaunchKernelGGL(mk_fwd, dim3(grid), dim3(NT), LDS_BYTES, stream, a); }
#else
    a.ph_lo = 0; a.ph_hi = NPHASES; hipLaunchKernelGGL(mk_fwd, dim3(grid), dim3(NT), LDS_BYTES, stream, a);
#endif
}
```

```cpp
#include <hip/hip_runtime.h>
#include <cstdio>
#include <cstdint>

#ifndef MK_PER_PHASE
#define MK_PER_PHASE 0
#endif
#define LAS __attribute__((address_space(3)))
typedef float f4 __attribute__((ext_vector_type(4)));
typedef unsigned short bf16_t;

constexpr int NWAVES = 8, NT = 512;
constexpr int BATCH = 8, SEQ = 2048, DM = 1024, DEPTH = 4, MTOK = BATCH * SEQ;
constexpr int MEMLEN = 256, MW = 256, HD = 64, MH = 4, DFF = 4096;
constexpr int IN_COLS = 7436, GATE_OFF = 3340;
constexpr int ZLD = 3328, NZ = 7424;
constexpr int NCMP = 127;
constexpr int C_Q = 0, C_KC = 256, C_VC = 320, C_KS = 384, C_VS = 448, C_KW = 512, C_VW = 576;
constexpr int C_RQ = 640, C_RK = 896, C_RV = 1152, C_RG = 1408, C_RW = 1664, C_CB = 2560, C_CC = 2816, C_CX = 3072;
constexpr int RWKV_COLS = 896;

constexpr size_t MiB = 1u << 20;
constexpr size_t WS_CTL = 0, WS_TAB = 1 * MiB, WS_CMP = 2 * MiB, WS_NG = 3 * MiB;
constexpr size_t WS_W = 4 * MiB;
constexpr size_t WS_H = 47 * MiB;
constexpr size_t WS_Z = 79 * MiB;
constexpr size_t WS_ZG = 183 * MiB;
constexpr size_t WS_RW = 311 * MiB;
constexpr size_t WS_BR = 423 * MiB;
constexpr size_t WS_MACC = 79 * MiB, WS_MERGED = 143 * MiB;
constexpr size_t WS_Q = 183 * MiB, WS_O = 247 * MiB, WS_KV = 279 * MiB, WS_MN = 295 * MiB, WS_HID = 183 * MiB;
constexpr size_t WS_Y = 311 * MiB;
constexpr size_t WS_END = 455 * MiB;
constexpr size_t WO_IN = 0, WO_BR = WO_IN + (size_t)NZ * DM, WO_MO = WO_BR + (size_t)4 * DM * MW, WO_Q = WO_MO + (size_t)DM * DM, WO_KV = WO_Q + (size_t)DM * DM,
                 WO_O = WO_KV + (size_t)2 * DM * DM, WO_1 = WO_O + (size_t)DM * DM, WO_2 = WO_1 + (size_t)DFF * DM, WO_END = WO_2 + (size_t)DFF * DM;
static_assert(WS_W + WO_END * 2 <= WS_H, "weight copies fit");
constexpr int LDS_BYTES = 147456, XB_LDS_OFF = 147440;
constexpr int CW_BAR = 4096;

__device__ const unsigned char T5B[128] = {0, 1, 2, 3, 4, 5, 6, 7, 8, 9, 10, 11, 12, 13, 14, 15, 16, 16, 16, 17, 17, 18, 18, 18, 19, 19, 19, 20, 20, 20, 20, 21, 21, 21, 21, 22, 22, 22, 22, 22, 23, 23, 23, 23, 23, 23, 24, 24, 24, 24, 24, 24, 25, 25, 25, 25, 25, 25, 25, 26, 26, 26, 26, 26, 26, 26, 26, 27, 27, 27, 27, 27, 27, 27, 27, 27, 27, 28, 28, 28, 28, 28, 28, 28, 28, 28, 28, 29, 29, 29, 29, 29, 29, 29, 29, 29, 29, 29, 29, 30, 30, 30, 30, 30, 30, 30, 30, 30, 30, 30, 30, 30, 30, 31, 31, 31, 31, 31, 31, 31, 31, 31, 31, 31, 31, 31, 31, 31};

__device__ const double INVF_REV[32] = {0.15915494309189535, 0.11934937021124885, 0.08949940160889101, 0.06711508300522726, 0.05032921210448703, 0.037741584717419764, 0.028302195830623395, 0.02122365276477766, 0.01591549430918953, 0.011934937021124881, 0.008949940160889099, 0.0067115083005227245, 0.005032921210448702, 0.003774158471741975, 0.0028302195830623394, 0.0021223652764777645, 0.0015915494309189527, 0.0011934937021124885, 0.0008949940160889096, 0.0006711508300522724, 0.0005032921210448699, 0.00037741584717419747, 0.00028302195830623385, 0.00021223652764777642, 0.00015915494309189524, 0.00011934937021124881, 8.949940160889094e-05, 6.711508300522721e-05, 5.032921210448702e-05, 3.7741584717419736e-05, 2.830219583062336e-05, 2.1223652764777656e-05};


struct Args { const float* in[33]; float* out; unsigned char* ws; int ph_lo, ph_hi; };
__device__ __forceinline__ int tid_now(int wv);
#define XB_TMO      128
#define XB_XCNT(j)  (256  + 64 * (j))
#define XB_XSUB(j)  (1280 + 64 * (j))
#define XB_XGEN(j)  (2304 + 64 * (j))
#define XB_TOP      3328
#define XB_TOPGEN   3392
#define XCD_BAR_WORDS 3456
#define XB_SPIN_CAP (1u << 18)

__device__ __forceinline__ unsigned xb_ld(unsigned* p)              { return __hip_atomic_load(p, __ATOMIC_RELAXED, __HIP_MEMORY_SCOPE_AGENT); }
__device__ __forceinline__ unsigned xb_add(unsigned* p, unsigned v) { return __hip_atomic_fetch_add(p, v, __ATOMIC_RELAXED, __HIP_MEMORY_SCOPE_AGENT); }
__device__ __forceinline__ unsigned xb_xcc_id() { return (unsigned)__builtin_amdgcn_s_getreg((3 << 11) | 20) & 0xFu; }
#define XB_SPIN(cond, bar) do { unsigned _sp = 0; while (cond) { __builtin_amdgcn_s_sleep(1); \
    if ((++_sp & 255u) == 0u) { if (xb_ld(&(bar)[XB_TMO])) break; if (_sp > XB_SPIN_CAP) { atomicAdd(&(bar)[XB_TMO], 1u); break; } } } } while (0)

struct XcdBarrier {
    unsigned* bar; unsigned x; int wv;
    volatile LAS unsigned* st;
};

__device__ __forceinline__ XcdBarrier xcd_barrier_post(unsigned* bar, volatile LAS unsigned* st, int wv) {
    XcdBarrier b; b.bar = bar; b.x = xb_xcc_id(); b.st = st; b.wv = wv;
    if (tid_now(wv) == 0) (void)xb_add(&bar[XB_XCNT(b.x)], 1u);
    return b;
}
__device__ __forceinline__ void xcd_barrier_complete(unsigned* bar, unsigned x, unsigned& nloc, unsigned& nx) {
    const unsigned G = gridDim.x * gridDim.y * gridDim.z;
    unsigned sum, cnt, mine, sp = 0u;
    for (;;) {
        sum = 0u; cnt = 0u; mine = 0u;
#pragma unroll
        for (unsigned j = 0; j < 16; ++j) { const unsigned c = xb_ld(&bar[XB_XCNT(j)]); sum += c; cnt += (c > 0u) ? 1u : 0u; mine = (j == x) ? c : mine; }
        if (sum == G) break;
        __builtin_amdgcn_s_sleep(1);
        if ((++sp & 255u) == 0u) { if (xb_ld(&bar[XB_TMO])) break; if (sp > XB_SPIN_CAP) { atomicAdd(&bar[XB_TMO], 1u); break; } }
    }
    nloc = mine > 0u ? mine : 1u; nx = cnt > 0u ? cnt : 1u;
}

__device__ __forceinline__ void xcd_barrier(const XcdBarrier& b) {
    asm volatile("s_waitcnt vmcnt(0)" ::: "memory");
    __syncthreads();
    if (tid_now(b.wv) == 0) {
        unsigned* bar = b.bar;
        __builtin_amdgcn_s_waitcnt(0);
        unsigned nloc = b.st[0], nx = b.st[1];
        if (nloc == 0u) { xcd_barrier_complete(bar, b.x, nloc, nx); b.st[0] = nloc; b.st[1] = nx; }
        const unsigned old = xb_add(&bar[XB_XSUB(b.x)], 1u);
        const unsigned gen = old / nloc;
        if (old + 1u == (gen + 1u) * nloc) {
            __builtin_amdgcn_fence(__ATOMIC_RELEASE, "agent");
            asm volatile("s_waitcnt vmcnt(0)" ::: "memory");
            const unsigned og = xb_add(&bar[XB_TOP], 1u);
            const unsigned tg = og / nx;
            if (og + 1u == (tg + 1u) * nx) xb_add(&bar[XB_TOPGEN], 1u);
            else XB_SPIN(xb_ld(&bar[XB_TOPGEN]) == tg, bar);
            __builtin_amdgcn_fence(__ATOMIC_ACQUIRE, "agent");
            xb_add(&bar[XB_XGEN(b.x)], 1u);
            asm volatile("s_waitcnt vmcnt(0)" ::: "memory");
        } else {
            XB_SPIN(xb_ld(&bar[XB_XGEN(b.x)]) == gen, bar);
            __builtin_amdgcn_fence(__ATOMIC_ACQUIRE, "agent");
            asm volatile("s_waitcnt vmcnt(0)" ::: "memory");
        }
    }
    __syncthreads();
}


__device__ __forceinline__ int tid_now(int wv) { int l; asm volatile("v_mbcnt_lo_u32_b32 %0, -1, 0\n\tv_mbcnt_hi_u32_b32 %0, -1, %0" : "=v"(l)); return (wv << 6) | l; }
__device__ __forceinline__ float wsum(float v) {
#pragma unroll
    for (int o = 32; o >= 1; o >>= 1) v += __shfl_xor(v, o);
    return v;
}
__device__ __forceinline__ float gsum16(float v) {
#pragma unroll
    for (int o = 8; o >= 1; o >>= 1) v += __shfl_xor(v, o);
    return v;
}
__device__ __forceinline__ float sigmoidf_(float x) { return 1.f / (1.f + __expf(-x)); }
__device__ __forceinline__ float bflo(unsigned u) { return __uint_as_float(u << 16); }
__device__ __forceinline__ float bfhi(unsigned u) { return __uint_as_float(u & 0xffff0000u); }
__device__ __forceinline__ float bf2f(bf16_t b) { return __uint_as_float((unsigned)b << 16); }
__device__ __forceinline__ unsigned pkbf(float lo, float hi) { unsigned r; asm volatile("v_cvt_pk_bf16_f32 %0, %1, %2" : "=v"(r) : "v"(lo), "v"(hi)); return r; }
__device__ __forceinline__ f4 ld4bf(const bf16_t* p) { const uint2 u = *(const uint2*)p; return (f4){bflo(u.x), bfhi(u.x), bflo(u.y), bfhi(u.y)}; }
__device__ __forceinline__ void st4bf(bf16_t* p, f4 v) { uint2 u; u.x = pkbf(v.x, v.y); u.y = pkbf(v.z, v.w); *(uint2*)p = u; }
__device__ __forceinline__ float dot64(const float (&q)[64], const LAS f4* k) {
    float a0 = 0.f, a1 = 0.f, a2 = 0.f, a3 = 0.f;
#pragma unroll
    for (int i = 0; i < 16; ++i) { const f4 kv = k[i]; a0 += q[4 * i] * kv.x; a1 += q[4 * i + 1] * kv.y; a2 += q[4 * i + 2] * kv.z; a3 += q[4 * i + 3] * kv.w; }
    return (a0 + a1) + (a2 + a3);
}
__device__ __forceinline__ void osm_update(float s, const LAS f4* v, float& m, float& l, float (&o)[64]) {
    const float mn = fmaxf(m, s), sc = __expf(m - mn), p = __expf(s - mn);
    l = l * sc + p; m = mn;
#pragma unroll
    for (int i = 0; i < 16; ++i) { const f4 vv = v[i];
        o[4 * i] = o[4 * i] * sc + p * vv.x; o[4 * i + 1] = o[4 * i + 1] * sc + p * vv.y; o[4 * i + 2] = o[4 * i + 2] * sc + p * vv.z; o[4 * i + 3] = o[4 * i + 3] * sc + p * vv.w; }
}

namespace pg8 {
#define PG8_LAS __attribute__((address_space(3)))
typedef unsigned short bf16_t;
typedef short bf16x8 __attribute__((ext_vector_type(8)));
typedef float f32x4 __attribute__((ext_vector_type(4)));
typedef unsigned u32x4 __attribute__((ext_vector_type(4)));
constexpr int BM = 256, BK = 64, HALF = 128, HTB = HALF * BK * 2  , STAGE_BYTES = 8 * HTB, NXCD = 8, WGM = 8;

__host__ __device__ __forceinline__ int lds_byte(int r, int c) { const int st = (r >> 4) * 2 + (c >> 5), rr = r & 15, cc = c & 31, ob = rr * 64 + cc * 2; return st * 1024 + (ob ^ (((ob >> 9) & 1) << 5)); }
__host__ __device__ __forceinline__ void stage_rc(int b, int& R, int& C) { const int st = b / 1024, sb = b % 1024, swz = sb ^ (((sb >> 9) & 1) << 5); R = (st >> 1) * 16 + swz / 64; C = (st & 1) * 32 + (swz % 64) / 2; }
__host__ __device__ __forceinline__ int perm32(int rho) { const int n = rho >> 4, i = rho & 15; return 8 * (i >> 2) + 4 * n + (i & 3); }

struct Unit { int pm, pn; };
struct Gemm { const bf16_t* A; const bf16_t* Bt; int M, N, K; };

struct StaticOrder {
    int nM, nN, nwg, G, c;
    __host__ __device__ void init(int M, int N, int G_, int c_) { nM = M / BM; nN = N / BM; nwg = nM * nN; G = G_; c = c_; }
    __host__ __device__ bool next(int i, Unit& u) const {
        const long L = (long)i * G + c; if (L >= nwg) return false;
        int wgid = (int)L; { const int q = nwg / NXCD, r = nwg % NXCD, xcd = wgid % NXCD, off = wgid / NXCD; wgid = (xcd < r ? xcd * (q + 1) : r * (q + 1) + (xcd - r) * q) + off; }
        const int nig = WGM * nN, gid = wgid / nig, fm = gid * WGM, gsz = (nM - fm) < WGM ? (nM - fm) : WGM;
        u.pm = fm + ((wgid % nig) % gsz); u.pn = (wgid % nig) / gsz; return true;
    }
    __device__ __forceinline__ void a_ready(const Unit&) const {}
    __device__ __forceinline__ void done(const Unit&) const {}
};

__device__ __forceinline__ unsigned cvt_pk_bf16(float lo, float hi) { unsigned r; asm volatile("v_cvt_pk_bf16_f32 %0, %1, %2" : "=v"(r) : "v"(lo), "v"(hi)); return r; }
typedef float f32x2 __attribute__((ext_vector_type(2)));

template <int MODE> struct Epi {
    static constexpr bool PERM = true, AFTER_DRAIN = false;
    bf16_t* O; int ldc; bf16_t* O2; float* F; const bf16_t* SG; int mi;
    __device__ __forceinline__ void operator()(const f32x4 (&acc)[2][2][4][2], const Unit& u, int wr, int wc, int fr, int fq) const {
        const int row0 = u.pm * BM + wr * 64 + fr, col0 = u.pn * BM + wc * 32 + 8 * fq;
#pragma unroll
        for (int ai = 0; ai < 2; ++ai)
#pragma unroll
            for (int m = 0; m < 4; ++m) { const size_t row = (size_t)(row0 + ai * HALF + m * 16);
#pragma unroll
                for (int bj = 0; bj < 2; ++bj) { f32x4 v0 = acc[ai][bj][m][0], v1 = acc[ai][bj][m][1]; const int col = col0 + bj * HALF;
                    if (MODE == 3) { float* p = F + row * ldc + col; *(f32x4*)p = v0; *(f32x4*)(p + 4) = v1; }
                    else {
                        bf16_t* dst = O + row * ldc + col;
                        if (MODE == 1) { if (u.pn >= ZLD / BM) { dst = O2 + row * (4 * DM) + (col - ZLD);
#pragma unroll
                            for (int e = 0; e < 4; ++e) { v0[e] = sigmoidf_(v0[e]); v1[e] = sigmoidf_(v1[e]); } } }
                        if (MODE == 2) {
#pragma unroll
                            for (int e = 0; e < 4; ++e) { const float a = fmaxf(v0[e], 0.f), b = fmaxf(v1[e], 0.f); v0[e] = a * a; v1[e] = b * b; } }
                        if (MODE == 4) { const u32x4 g = *(const u32x4*)(SG + row * (4 * DM) + mi * DM + col);
                            v0[0] *= bflo(g.x); v0[1] *= bfhi(g.x); v0[2] *= bflo(g.y); v0[3] *= bfhi(g.y); v1[0] *= bflo(g.z); v1[1] *= bfhi(g.z); v1[2] *= bflo(g.w); v1[3] *= bfhi(g.w);
                            float* p = F + row * DM + col;
                            if (mi > 0) { v0 += *(const f32x4*)p; v1 += *(const f32x4*)(p + 4); }
                            if (mi < 3) { *(f32x4*)p = v0; *(f32x4*)(p + 4) = v1; continue; } }
                        u32x4 w; w.x = cvt_pk_bf16(v0[0], v0[1]); w.y = cvt_pk_bf16(v0[2], v0[3]); w.z = cvt_pk_bf16(v1[0], v1[1]); w.w = cvt_pk_bf16(v1[2], v1[3]);
                        *(u32x4*)dst = w; } } }
    }
};
template <class Epi, class Sched, bool ALIGN_EPI = false, bool SP2 = false>
__device__ __forceinline__ void gemm_phase(PG8_LAS unsigned char* lds, const Gemm g, const Sched& S, const Epi& E, int wv) {
    const int tid = tid_now(wv), wid = __builtin_amdgcn_readfirstlane(tid >> 6), lane = tid & 63, wr = wid >> 2, wc = wid & 3, fr = lane & 15, fq = lane >> 4;
    const int K = g.K, nt = K / BK;
    unsigned voffA[2], voffB[2];
#pragma unroll
    for (int i = 0; i < 2; ++i) { int R, C; stage_rc(tid * 16 + i * 8192, R, C); const int Rb = Epi::PERM ? ((R & ~31) + perm32(R & 31)) : R;
        voffA[i] = (unsigned)(R * K + C) * 2u; voffB[i] = (unsigned)(Rb * K + C) * 2u; }
    const size_t kstep = (size_t)(BK * 2);
    const size_t hstep = (size_t)HALF * K * 2;
    const size_t tstep = 2 * hstep;
    const unsigned ldsw = (unsigned)wid * 1024u;
    const int aoff = lds_byte(wr * 64 + fr, fq * 8), boff = lds_byte(wc * 32 + fr, fq * 8);
#define PG8_SA(b, h) (((b) * 2 + (h)) * HTB)
#define PG8_SB(b, h) ((4 + (b) * 2 + (h)) * HTB)
#define PG8_STAGE(bufoff, gbase, voff) do { _Pragma("unroll") for (int _i = 0; _i < 2; ++_i) \
        __builtin_amdgcn_global_load_lds((const unsigned*)((const char*)(gbase) + (voff)[_i]), (PG8_LAS unsigned*)(lds + (bufoff) + ldsw + _i * 8192), 16, 0, 0); } while (0)
#define PG8_LDA(dst, b, h) do { _Pragma("unroll") for (int m = 0; m < 4; ++m) _Pragma("unroll") for (int k = 0; k < 2; ++k) dst[m][k] = *(const PG8_LAS bf16x8*)(lds + PG8_SA(b, h) + aoff + m * 2048 + k * 1024); } while (0)
#define PG8_LDB(dst, b, h) do { _Pragma("unroll") for (int n = 0; n < 2; ++n) _Pragma("unroll") for (int k = 0; k < 2; ++k) dst[n][k] = *(const PG8_LAS bf16x8*)(lds + PG8_SB(b, h) + boff + n * 2048 + k * 1024); } while (0)
#define PG8_MMA(ai, bj, At, Bt) do { __builtin_amdgcn_s_setprio(1); _Pragma("unroll") for (int m = 0; m < 4; ++m) _Pragma("unroll") for (int n = 0; n < 2; ++n) _Pragma("unroll") for (int k = 0; k < 2; ++k) \
        acc[ai][bj][m][n] = __builtin_amdgcn_mfma_f32_16x16x32_bf16(Bt[n][k], At[m][k], acc[ai][bj][m][n], 0, 0, 0); __builtin_amdgcn_s_setprio(0); } while (0)
#define PG8_WAIT_V(n) asm volatile("s_waitcnt vmcnt(" #n ")" ::: "memory")
#define PG8_WAIT_L(n) asm volatile("s_waitcnt lgkmcnt(" #n ")" ::: "memory")
#define PG8_BAR __builtin_amdgcn_s_barrier()
#define PG8_SCHED __builtin_amdgcn_sched_barrier(0)
    Unit cur, nxt; int ui = 0;
    if (!S.next(0, cur)) return;
    f32x4 acc[2][2][4][2];
#pragma unroll
    for (int a = 0; a < 2; ++a)
#pragma unroll
        for (int b = 0; b < 2; ++b)
#pragma unroll
            for (int m = 0; m < 4; ++m)
#pragma unroll
                for (int n = 0; n < 2; ++n) acc[a][b][m][n] = (f32x4){0.f, 0.f, 0.f, 0.f};
    bf16x8 At[4][2], B0[2][2], B1[2][2];
    const char* cA = (const char*)g.A + (size_t)cur.pm * tstep; const char* cB = (const char*)g.Bt + (size_t)cur.pn * tstep;
    S.a_ready(cur);
    if constexpr (SP2) {
        PG8_STAGE(PG8_SB(0, 0), cB, voffB); PG8_STAGE(PG8_SB(0, 1), cB + hstep, voffB); PG8_STAGE(PG8_SA(0, 0), cA, voffA); PG8_STAGE(PG8_SA(0, 1), cA + hstep, voffA);
        if (wr == 1) PG8_BAR;
        PG8_WAIT_V(2); PG8_BAR;
        PG8_STAGE(PG8_SB(1, 0), cB + kstep, voffB); PG8_STAGE(PG8_SA(1, 0), cA + kstep, voffA); PG8_STAGE(PG8_SB(1, 1), cB + hstep + kstep, voffB);
        PG8_WAIT_V(6); PG8_BAR;
    } else {
        PG8_STAGE(PG8_SB(0, 0), cB, voffB); PG8_STAGE(PG8_SA(0, 0), cA, voffA); PG8_STAGE(PG8_SB(0, 1), cB + hstep, voffB); PG8_STAGE(PG8_SA(0, 1), cA + hstep, voffA);
        if (wr == 1) PG8_BAR;
        PG8_WAIT_V(4); PG8_BAR;
        PG8_STAGE(PG8_SB(1, 0), cB + kstep, voffB); PG8_STAGE(PG8_SA(1, 0), cA + kstep, voffA); PG8_STAGE(PG8_SB(1, 1), cB + hstep + kstep, voffB);
        PG8_WAIT_V(6); PG8_BAR;
    }
    for (;;) {
        const bool has_next = S.next(ui + 1, nxt);
        const char* nA = has_next ? (const char*)g.A + (size_t)nxt.pm * tstep : cA; const char* nB = has_next ? (const char*)g.Bt + (size_t)nxt.pn * tstep : cB;
        for (int t = 0; t < nt; t += 2) {
            const bool last = (t == nt - 2);
            const char* a1 = cA + (size_t)(t + 1) * kstep;
            const char* a2 = last ? nA : cA + (size_t)(t + 2) * kstep; const char* b2 = last ? nB : cB + (size_t)(t + 2) * kstep;
            const char* a3 = a2 + kstep; const char* b3 = b2 + kstep;
            if (last && has_next) S.a_ready(nxt);
            if constexpr (SP2) {
            PG8_LDB(B0, 0, 0); PG8_LDB(B1, 0, 1); PG8_SCHED; PG8_LDA(At, 0, 0); PG8_STAGE(PG8_SA(1, 1), a1 + hstep, voffA);
            PG8_WAIT_V(8); PG8_WAIT_L(0); PG8_BAR; PG8_MMA(0, 0, At, B0); PG8_MMA(0, 1, At, B1); PG8_BAR; PG8_SCHED;
            PG8_LDA(At, 0, 1); PG8_STAGE(PG8_SB(0, 0), b2, voffB); PG8_STAGE(PG8_SB(0, 1), b2 + hstep, voffB); PG8_STAGE(PG8_SA(0, 0), a2, voffA);
            PG8_WAIT_V(8); PG8_WAIT_L(0); PG8_BAR; PG8_MMA(1, 0, At, B0); PG8_MMA(1, 1, At, B1); PG8_BAR; PG8_SCHED;
            PG8_LDB(B0, 1, 0); PG8_LDB(B1, 1, 1); PG8_SCHED; PG8_LDA(At, 1, 0); PG8_STAGE(PG8_SA(0, 1), a2 + hstep, voffA);
            PG8_WAIT_V(8); PG8_WAIT_L(0); PG8_BAR; PG8_MMA(0, 0, At, B0); PG8_MMA(0, 1, At, B1); PG8_BAR; PG8_SCHED;
            PG8_LDA(At, 1, 1); PG8_STAGE(PG8_SB(1, 0), b3, voffB); PG8_STAGE(PG8_SB(1, 1), b3 + hstep, voffB); PG8_STAGE(PG8_SA(1, 0), a3, voffA);
            PG8_WAIT_V(8); PG8_WAIT_L(0); PG8_BAR; PG8_MMA(1, 0, At, B0); PG8_MMA(1, 1, At, B1); PG8_BAR; PG8_SCHED;
            } else {
            PG8_LDB(B0, 0, 0); PG8_SCHED; PG8_LDA(At, 0, 0); PG8_STAGE(PG8_SA(1, 1), a1 + hstep, voffA);
            PG8_WAIT_L(8); PG8_BAR; PG8_WAIT_L(0); PG8_MMA(0, 0, At, B0); PG8_BAR; PG8_SCHED;
            PG8_LDB(B1, 0, 1); PG8_STAGE(PG8_SB(0, 0), b2, voffB);
            PG8_BAR; PG8_WAIT_L(0); PG8_MMA(0, 1, At, B1); PG8_BAR;
            PG8_LDA(At, 0, 1); PG8_STAGE(PG8_SA(0, 0), a2, voffA);
            PG8_BAR; PG8_WAIT_L(0); PG8_MMA(1, 0, At, B0); PG8_BAR; PG8_SCHED;
            PG8_STAGE(PG8_SB(0, 1), b2 + hstep, voffB);
            PG8_WAIT_V(6); PG8_BAR; PG8_MMA(1, 1, At, B1); PG8_BAR;
            PG8_LDB(B0, 1, 0); PG8_SCHED; PG8_LDA(At, 1, 0); PG8_STAGE(PG8_SA(0, 1), a2 + hstep, voffA);
            PG8_WAIT_L(8); PG8_BAR; PG8_WAIT_L(0); PG8_MMA(0, 0, At, B0); PG8_BAR; PG8_SCHED;
            PG8_LDB(B1, 1, 1); PG8_STAGE(PG8_SB(1, 0), b3, voffB);
            PG8_BAR; PG8_WAIT_L(0); PG8_MMA(0, 1, At, B1); PG8_BAR;
            PG8_LDA(At, 1, 1); PG8_STAGE(PG8_SA(1, 0), a3, voffA);
            PG8_BAR; PG8_WAIT_L(0); PG8_MMA(1, 0, At, B0); PG8_BAR; PG8_SCHED;
            PG8_STAGE(PG8_SB(1, 1), b3 + hstep, voffB);
            PG8_WAIT_V(6); PG8_BAR; PG8_MMA(1, 1, At, B1); PG8_BAR;
            }
        }
        if constexpr (ALIGN_EPI) { if (wr == 0) PG8_BAR; }
        if constexpr (!Epi::AFTER_DRAIN) { E(acc, cur, wr, wc, fr, fq); S.done(cur); }
        if (!has_next) break;
#pragma unroll
        for (int a = 0; a < 2; ++a)
#pragma unroll
            for (int b = 0; b < 2; ++b)
#pragma unroll
                for (int m = 0; m < 4; ++m)
#pragma unroll
                    for (int n = 0; n < 2; ++n) acc[a][b][m][n] = (f32x4){0.f, 0.f, 0.f, 0.f};
        cur = nxt; cA = nA; cB = nB; ++ui;
        if constexpr (ALIGN_EPI) { if (wr == 1) PG8_BAR; }
    }
    PG8_WAIT_V(0);
    if constexpr (!ALIGN_EPI) { if (wr == 0) PG8_BAR; }
    PG8_BAR;
    if constexpr (Epi::AFTER_DRAIN) { E.fused(acc, cur, wr, wc, fr, fq, lds, wid, lane); S.done(cur); }
#undef PG8_SA
#undef PG8_SB
#undef PG8_STAGE
#undef PG8_LDA
#undef PG8_LDB
#undef PG8_MMA
#undef PG8_WAIT_V
#undef PG8_WAIT_L
#undef PG8_BAR
#undef PG8_SCHED
}
}

template <int MODE>
__device__ __forceinline__ void gemm_run(LAS unsigned char* lds, const bf16_t* A, const bf16_t* Bt, int M, int N, int K, const pg8::Epi<MODE>& E, int wv, int G, int bid) {
    pg8::Gemm g{A, Bt, M, N, K}; pg8::StaticOrder S; S.init(M, N, G, bid);
    pg8::gemm_phase<pg8::Epi<MODE>, pg8::StaticOrder, true, true>(lds, g, S, E, wv);
}

__device__ __forceinline__ void transpose_item(const float* W, int ldw, int src_c0, bf16_t* WT, int K, int dst_r0, int k0, LAS float* scr, int lane) {
#pragma unroll 8
    for (int i = 0; i < 32; ++i) { const int kk = 2 * i + (lane >> 5); scr[kk * 33 + (lane & 31)] = W[(size_t)(k0 + kk) * ldw + src_c0 + (lane & 31)]; }
    asm volatile("s_waitcnt lgkmcnt(0)" ::: "memory");
    const int c = lane & 7;
#pragma unroll
    for (int j = 0; j < 4; ++j) { const int n = (lane >> 3) + 8 * j; const LAS float* s = scr + (8 * c) * 33 + n;
        uint4 o; o.x = pkbf(s[0 * 33], s[1 * 33]); o.y = pkbf(s[2 * 33], s[3 * 33]); o.z = pkbf(s[4 * 33], s[5 * 33]); o.w = pkbf(s[6 * 33], s[7 * 33]);
        *(uint4*)(WT + (size_t)(dst_r0 + n) * K + k0 + 8 * c) = o; }
    asm volatile("s_waitcnt lgkmcnt(0)" ::: "memory");
}
__device__ __forceinline__ void convert_layer(const float* const* P, int l, bf16_t* Wb, LAS unsigned char* lds, int wave, int lane, int gw, int NGW) {
    LAS float* scr = (LAS float*)(lds + wave * 16384);
    constexpr int I_IN = 16 * (NZ / 32), I_BR = 4 * 4 * 32, I_SQ = 16 * 32, I_KV = 16 * 64, I_1 = 16 * 128, I_2 = 64 * 32;
    constexpr int NIT = I_IN + I_BR + 3 * I_SQ + I_KV + I_1 + I_2;
    for (int it = gw; it < NIT; it += NGW) {
        int r = it;
        if (r < I_IN) { const int kb = r / (NZ / 32), nb = r % (NZ / 32), n0 = 32 * nb; transpose_item(P[3] + (size_t)l * DM * IN_COLS, IN_COLS, n0 + (n0 >= 640 ? 12 : 0), Wb + WO_IN, DM, n0, 64 * kb, scr, lane); continue; } r -= I_IN;
        if (r < I_BR) { const int m = r >> 7, kb = (r >> 5) & 3, nb = r & 31; transpose_item(P[20] + ((size_t)l * 4 + m) * MW * DM, DM, 32 * nb, Wb + WO_BR + (size_t)m * DM * MW, MW, 32 * nb, 64 * kb, scr, lane); continue; } r -= I_BR;
        if (r < I_SQ) { transpose_item(P[21] + (size_t)l * DM * DM, DM, 32 * (r & 31), Wb + WO_MO, DM, 32 * (r & 31), 64 * (r >> 5), scr, lane); continue; } r -= I_SQ;
        if (r < I_SQ) { transpose_item(P[25] + (size_t)l * DM * DM, DM, 32 * (r & 31), Wb + WO_Q, DM, 32 * (r & 31), 64 * (r >> 5), scr, lane); continue; } r -= I_SQ;
        if (r < I_KV) { transpose_item(P[26] + (size_t)l * DM * 2 * DM, 2 * DM, 32 * (r & 63), Wb + WO_KV, DM, 32 * (r & 63), 64 * (r >> 6), scr, lane); continue; } r -= I_KV;
        if (r < I_SQ) { transpose_item(P[27] + (size_t)l * DM * DM, DM, 32 * (r & 31), Wb + WO_O, DM, 32 * (r & 31), 64 * (r >> 5), scr, lane); continue; } r -= I_SQ;
        if (r < I_1) { transpose_item(P[30] + (size_t)l * DM * DFF, DFF, 32 * (r & 127), Wb + WO_1, DM, 32 * (r & 127), 64 * (r >> 7), scr, lane); continue; } r -= I_1;
        transpose_item(P[31] + (size_t)l * DFF * DM, DM, 32 * (r & 31), Wb + WO_2, DFF, 32 * (r & 31), 64 * (r >> 5), scr, lane);
    }
}

__device__ __forceinline__ void ng_row(const f4 (&v)[4], const LAS float* wng, float* ngo, int lane) {
    float acc[12];
#pragma unroll
    for (int j = 0; j < 12; ++j) { float a = 0.f;
#pragma unroll
        for (int jj = 0; jj < 4; ++jj) { const f4 w = *(const LAS f4*)(wng + j * DM + 4 * lane + 256 * jj); a += v[jj].x * w.x + v[jj].y * w.y + v[jj].z * w.z + v[jj].w * w.w; }
        acc[j] = wsum(a); }
    if (lane == 0) { *(f4*)ngo = (f4){acc[0], acc[1], acc[2], acc[3]}; *(f4*)(ngo + 4) = (f4){acc[4], acc[5], acc[6], acc[7]}; *(f4*)(ngo + 8) = (f4){acc[8], acc[9], acc[10], acc[11]}; }
}
__device__ __forceinline__ void stage_wng(LAS float* wng, const float* w_in_l, int tid) {
    for (int i = tid; i < 12 * DM; i += NT) { const int c = i / 12, j = i % 12; wng[j * DM + c] = w_in_l[(size_t)c * IN_COLS + 640 + j]; }
}
__device__ __forceinline__ void rms_rows(const float* x, const float* g, bf16_t* out, int nrows, const LAS float* wng, float* ng, int gw, int NGW, int lane) {
    for (int m = gw; m < nrows; m += NGW) {
        const f4* xr = (const f4*)(x + (size_t)m * DM) + lane; f4 v[4]; float s = 0.f;
#pragma unroll
        for (int j = 0; j < 4; ++j) { v[j] = xr[64 * j]; s += v[j].x * v[j].x + v[j].y * v[j].y + v[j].z * v[j].z + v[j].w * v[j].w; }
        const float r = 1.f / sqrtf(wsum(s) * (1.f / DM) + 1e-6f);
#pragma unroll
        for (int j = 0; j < 4; ++j) { const f4 gg = ((const f4*)g)[lane + 64 * j]; v[j] = v[j] * r * gg; st4bf(out + (size_t)m * DM + 4 * lane + 256 * j, v[j]); }
        if (ng) ng_row(v, wng, ng + (size_t)m * 12, lane);
    }
}
__device__ __forceinline__ void rowop(const float* xin, const float* y, const float* g1, const float* g2, float* xout, bf16_t* h, const LAS float* wng, float* ng, int gw, int NGW, int lane) {
    for (int m = gw; m < MTOK; m += NGW) {
        const f4* yr = (const f4*)(y + (size_t)m * DM) + lane; const f4* xr = (const f4*)(xin + (size_t)m * DM) + lane; f4 v[4]; float s = 0.f;
#pragma unroll
        for (int j = 0; j < 4; ++j) { v[j] = yr[64 * j]; s += v[j].x * v[j].x + v[j].y * v[j].y + v[j].z * v[j].z + v[j].w * v[j].w; }
        const float r = 1.f / sqrtf(wsum(s) * (1.f / DM) + 1e-6f);
        float s2 = 0.f; f4* xo = (f4*)(xout + (size_t)m * DM) + lane;
#pragma unroll
        for (int j = 0; j < 4; ++j) { const f4 gg = ((const f4*)g1)[lane + 64 * j]; v[j] = xr[64 * j] + v[j] * r * gg; xo[64 * j] = v[j];
            s2 += v[j].x * v[j].x + v[j].y * v[j].y + v[j].z * v[j].z + v[j].w * v[j].w; }
        if (g2) { const float r2 = 1.f / sqrtf(wsum(s2) * (1.f / DM) + 1e-6f);
#pragma unroll
            for (int j = 0; j < 4; ++j) { const f4 gg = ((const f4*)g2)[lane + 64 * j]; v[j] = v[j] * r2 * gg; st4bf(h + (size_t)m * DM + 4 * lane + 256 * j, v[j]); }
            if (ng) ng_row(v, wng, ng + (size_t)m * 12, lane); }
    }
}

__device__ __forceinline__ void nsa_compress_unit(const bf16_t* z, const float* cmp_w_l, const float* pe_l, float* cmp_out, int u, int lane) {
    const int which = u & 1, bn = u >> 1, b = bn / NCMP, n = bn % NCMP;
    const float* W = cmp_w_l + (size_t)which * 32 * 64 * 64; const int col = which ? C_VC : C_KC;
    float acc = 0.f;
    for (int l = 0; l < 32; ++l) {
        const bf16_t* zr = z + (size_t)(b * SEQ + 16 * n + l) * ZLD + col;
#pragma unroll 8
        for (int d = 0; d < 64; ++d) acc += (bf2f(zr[d]) + pe_l[l * 64 + d]) * W[(l * 64 + d) * 64 + lane];
    }
    cmp_out[(size_t)which * BATCH * NCMP * 64 + (size_t)(b * NCMP + n) * 64 + lane] = acc;
}
__device__ __forceinline__ void rwkv_prep_token(const bf16_t* zb, float* rw, const float* const* P, int l, int tok, int lane, LAS float* scr) {
    const float* mu = P[8] + l * RWKV_COLS; const float* w0 = P[9] + l * MW; const float* w2 = P[10] + (size_t)l * 32 * MW; const float* a0 = P[11] + l * MW;
    const float* a2 = P[12] + (size_t)l * 32 * MW; const float* g2 = P[13] + (size_t)l * 64 * MW; const float* k_k = P[14] + l * MW; const float* k_a = P[15] + l * MW;
    const int t = tok % SEQ; const bf16_t* z = zb + (size_t)tok * ZLD + C_RW; const bf16_t* zp = z - ZLD;
    f4 rkv[3];
#pragma unroll
    for (int j = 0; j < 3; ++j) { const f4 c = ld4bf(z + j * 256 + 4 * lane); const f4 p = t ? ld4bf(zp + j * 256 + 4 * lane) : (f4){0.f, 0.f, 0.f, 0.f};
        const f4 m = *(const f4*)(mu + j * 256 + 4 * lane); rkv[j] = c + (p - c) * m; }
    if (lane < 32) { const f4 c = ld4bf(z + 768 + 4 * lane); const f4 p = t ? ld4bf(zp + 768 + 4 * lane) : (f4){0.f, 0.f, 0.f, 0.f};
        const f4 m = *(const f4*)(mu + 768 + 4 * lane); f4 v = c + (p - c) * m;
        if (lane < 8) { v.x = tanhf(v.x); v.y = tanhf(v.y); v.z = tanhf(v.z); v.w = tanhf(v.w); }
        else if (lane >= 16) { v.x = sigmoidf_(v.x); v.y = sigmoidf_(v.y); v.z = sigmoidf_(v.z); v.w = sigmoidf_(v.w); }
        *(LAS f4*)(scr + 4 * lane) = v; }
    asm volatile("s_waitcnt lgkmcnt(0)" ::: "memory");
    f4 aw = (f4){0.f, 0.f, 0.f, 0.f}, aa = aw, ag = aw;
#pragma unroll 4
    for (int j = 0; j < 32; ++j) { aw += scr[j] * *(const f4*)(w2 + j * MW + 4 * lane); aa += scr[32 + j] * *(const f4*)(a2 + j * MW + 4 * lane); }
#pragma unroll 4
    for (int j = 0; j < 64; ++j) ag += scr[64 + j] * *(const f4*)(g2 + j * MW + 4 * lane);
    asm volatile("s_waitcnt lgkmcnt(0)" ::: "memory");
    const f4 w0v = *(const f4*)(w0 + 4 * lane), a0v = *(const f4*)(a0 + 4 * lane), kkv = *(const f4*)(k_k + 4 * lane), kav = *(const f4*)(k_a + 4 * lane);
    float dec[4], av[4], kk[4], k2[4]; float ss = 0.f;
#pragma unroll
    for (int i = 0; i < 4; ++i) { const float y = -(w0v[i] + aw[i]); const float sp = (y > 20.f) ? y : log1pf(expf(y)); const float wl = -sp - 0.5f; dec[i] = expf(-expf(wl));
        av[i] = 1.f / (1.f + expf(-(a0v[i] + aa[i]))); kk[i] = rkv[1][i] * kkv[i]; ss += kk[i] * kk[i]; k2[i] = rkv[1][i] * (1.f + (av[i] - 1.f) * kav[i]); }
    ss = gsum16(ss); const float inv = 1.f / fmaxf(sqrtf(ss), 1e-12f);
    float* o = rw + (size_t)tok * 7 * MW + 4 * lane;
    *(f4*)(o) = rkv[0]; *(f4*)(o + MW) = (f4){dec[0], dec[1], dec[2], dec[3]}; *(f4*)(o + 2 * MW) = (f4){k2[0], k2[1], k2[2], k2[3]}; *(f4*)(o + 3 * MW) = rkv[2];
    *(f4*)(o + 4 * MW) = (f4){kk[0] * inv, kk[1] * inv, kk[2] * inv, kk[3] * inv}; *(f4*)(o + 5 * MW) = (f4){kk[0] * inv * av[0], kk[1] * inv * av[1], kk[2] * inv * av[2], kk[3] * inv * av[3]};
    *(f4*)(o + 6 * MW) = ag;
}

__device__ __forceinline__ void rwkv_scan_unit(LAS unsigned char* lds, float* rw, int b, int h, int wv) {
    const int tid = tid_now(wv), row = tid >> 3, cg = tid & 7;
    LAS f4* buf = (LAS f4*)lds;
    LAS float* yb = (LAS float*)(lds + 98304);
    float s[8];
#pragma unroll
    for (int j = 0; j < 8; ++j) s[j] = 0.f;
    f4 pre[6];
#define GSRC(c, k) ((const f4*)(rw + ((size_t)(b * SEQ + (c) * 32 + (tid + 512 * (k)) / 96) * 7 + (((tid + 512 * (k)) % 96) >> 4)) * MW + h * 64 + (((tid + 512 * (k)) % 96) & 15) * 4))
#pragma unroll
    for (int k = 0; k < 6; ++k) pre[k] = *GSRC(0, k);
    __syncthreads();
#pragma unroll
    for (int k = 0; k < 6; ++k) buf[tid + 512 * k] = pre[k];
    __syncthreads();
    for (int c = 0; c < SEQ / 32; ++c) {
        if (c + 1 < SEQ / 32) {
#pragma unroll
            for (int k = 0; k < 6; ++k) pre[k] = *GSRC(c + 1, k);
        }
        const LAS f4* cb = buf + (c & 1) * 3072; LAS float* ybc = yb + (c & 1) * 2048;
        for (int i = 0; i < 32; ++i) {
            const LAS f4* S = cb + i * 96;
            const f4 k0 = S[64 + cg * 2], k1 = S[64 + cg * 2 + 1];
            float d = s[0] * k0.x + s[1] * k0.y + s[2] * k0.z + s[3] * k0.w + s[4] * k1.x + s[5] * k1.y + s[6] * k1.z + s[7] * k1.w;
            d += __shfl_xor(d, 1); d += __shfl_xor(d, 2); d += __shfl_xor(d, 4);
            const float sa = -d, vv = ((const LAS float*)(S + 48))[row];
            const f4 w0 = S[16 + cg * 2], w1 = S[16 + cg * 2 + 1], q0 = S[80 + cg * 2], q1 = S[80 + cg * 2 + 1], kk0 = S[32 + cg * 2], kk1 = S[32 + cg * 2 + 1];
            s[0] = s[0] * w0.x + sa * q0.x + vv * kk0.x; s[1] = s[1] * w0.y + sa * q0.y + vv * kk0.y; s[2] = s[2] * w0.z + sa * q0.z + vv * kk0.z; s[3] = s[3] * w0.w + sa * q0.w + vv * kk0.w;
            s[4] = s[4] * w1.x + sa * q1.x + vv * kk1.x; s[5] = s[5] * w1.y + sa * q1.y + vv * kk1.y; s[6] = s[6] * w1.z + sa * q1.z + vv * kk1.z; s[7] = s[7] * w1.w + sa * q1.w + vv * kk1.w;
            const f4 r0 = S[cg * 2], r1 = S[cg * 2 + 1];
            float y = s[0] * r0.x + s[1] * r0.y + s[2] * r0.z + s[3] * r0.w + s[4] * r1.x + s[5] * r1.y + s[6] * r1.z + s[7] * r1.w;
            y += __shfl_xor(y, 1); y += __shfl_xor(y, 2); y += __shfl_xor(y, 4);
            if (cg == 0) ybc[i * 64 + row] = y;
        }
        if (c + 1 < SEQ / 32) {
#pragma unroll
            for (int k = 0; k < 6; ++k) buf[((c + 1) & 1) * 3072 + tid + 512 * k] = pre[k];
        }
        __syncthreads();
        { const int i = tid >> 4, q = tid & 15; *(f4*)(rw + ((size_t)(b * SEQ + c * 32 + i) * 7 + 5) * MW + h * 64 + q * 4) = *(const LAS f4*)(ybc + i * 64 + q * 4); }
    }
    __syncthreads();
#undef GSRC
}
__device__ __forceinline__ void rwkv_fin_token(const float* rw, bf16_t* o_rwkv, const float* r_k, const float* ln_g, const float* ln_b, int tok, int lane) {
    const float* p = rw + (size_t)tok * 7 * MW + 4 * lane;
    const f4 r = *(const f4*)p, k2 = *(const f4*)(p + 2 * MW), v = *(const f4*)(p + 3 * MW), y = *(const f4*)(p + 5 * MW), g = *(const f4*)(p + 6 * MW);
    const f4 rk = *(const f4*)(r_k + 4 * lane), lg = *(const f4*)(ln_g + 4 * lane), lb = *(const f4*)(ln_b + 4 * lane);
    const float mu = gsum16(y.x + y.y + y.z + y.w) * (1.f / 64.f); const f4 yc = y - mu;
    const float var = gsum16(yc.x * yc.x + yc.y * yc.y + yc.z * yc.z + yc.w * yc.w) * (1.f / 64.f); const float rs = 1.f / sqrtf(var + 64e-5f);
    const float bonus = gsum16(r.x * k2.x * rk.x + r.y * k2.y * rk.y + r.z * k2.z * rk.z + r.w * k2.w * rk.w);
    st4bf(o_rwkv + (size_t)tok * MW + 4 * lane, (yc * rs * lg + lb + bonus * v) * g);
}

__device__ __forceinline__ void stage_tile64(LAS f4* KT, LAS f4* VT, const bf16_t* ksrc, const bf16_t* vsrc, int ld, int wv) {
    const int tid = tid_now(wv);
#pragma unroll
    for (int k = 0; k < 2; ++k) { const int idx = tid + 512 * k, r = idx >> 4, q = idx & 15; KT[idx] = ld4bf(ksrc + (size_t)r * ld + q * 4); VT[idx] = ld4bf(vsrc + (size_t)r * ld + q * 4); }
}
__device__ __forceinline__ void nsa_unit(LAS unsigned char* lds, const bf16_t* z, const float* ngl, const float* kcmp, const float* vcmp, const float* biasd_g, bf16_t* o_nsa, int b, int qt, int wv) {
    const int tid = tid_now(wv), wave = __builtin_amdgcn_readfirstlane(tid >> 6), lane = tid & 63, h = wave & 3; const bool act = wave < 4;
    LAS f4* KC = (LAS f4*)lds; LAS f4* VC = (LAS f4*)(lds + 32768); LAS float* IMP = (LAS float*)(lds + 65536);
    LAS f4* KT = (LAS f4*)(lds + 98304); LAS f4* VT = (LAS f4*)(lds + 114688); LAS float* BD = (LAS float*)(lds + 131072); LAS unsigned* UNI = (LAS unsigned*)(lds + 133120);
    LAS float* OUTL = (LAS float*)lds;
    const int t = qt * 64 + lane; const size_t row = (size_t)b * SEQ + t;
    __syncthreads();
    for (int i = tid; i < 2048; i += NT) { f4 zz = (f4){0.f, 0.f, 0.f, 0.f}; KC[i] = (i < NCMP * 16) ? ((const f4*)(kcmp + (size_t)b * NCMP * 64))[i] : zz; VC[i] = (i < NCMP * 16) ? ((const f4*)(vcmp + (size_t)b * NCMP * 64))[i] : zz; }
    BD[tid] = biasd_g[tid];
    float q[64], o[64]; float g0 = 0.f, g1 = 0.f, g2 = 0.f;
    if (act) {
        const bf16_t* zr = z + row * ZLD;
#pragma unroll
        for (int i = 0; i < 16; ++i) { const f4 v = ld4bf(zr + C_Q + h * 64 + 4 * i); q[4 * i] = v.x * 0.125f; q[4 * i + 1] = v.y * 0.125f; q[4 * i + 2] = v.z * 0.125f; q[4 * i + 3] = v.w * 0.125f; }
        const float* gp = ngl + row * 12 + h * 3;
        g0 = sigmoidf_(gp[0]); g1 = sigmoidf_(gp[1]); g2 = sigmoidf_(gp[2]);
    }
    __syncthreads();
    const LAS float* bd = BD + h * 128;
    const int nv = (t >= 31) ? ((t - 31) >> 4) + 1 : 0;
    const int tmax = qt * 64 + 63, nvmax = ((tmax - 31) >> 4) + 1;
    if (act) {
        float m = -3e38f, l = 0.f;
        for (int n = 0; n < nvmax; ++n) if (n < nv) { const int dd = t - (16 * n + 31); const float s = dot64(q, KC + n * 16) + bd[dd < 127 ? dd : 127];
            const float mn = fmaxf(m, s); l = l * __expf(m - mn) + __expf(s - mn); m = mn; }
        const float inv = (nv > 0) ? 1.f / l : 0.f;
#pragma unroll
        for (int i = 0; i < 64; ++i) o[i] = 0.f;
        float accb = 0.f;
        for (int mb = 0; mb < 32; ++mb) {
#pragma unroll
            for (int j = 0; j < 4; ++j) { const int n = 4 * mb + j; float p = 0.f;
                if (n < nvmax) { if (n < nv) { const int dd = t - (16 * n + 31); const float s = dot64(q, KC + n * 16) + bd[dd < 127 ? dd : 127]; p = __expf(s - m) * inv;
#pragma unroll
                    for (int i = 0; i < 16; ++i) { const f4 vv = VC[n * 16 + i]; o[4 * i] += p * vv.x; o[4 * i + 1] += p * vv.y; o[4 * i + 2] += p * vv.z; o[4 * i + 3] += p * vv.w; } } }
                if (j < 3) accb += p; else { IMP[(h * 32 + mb) * 64 + lane] = accb + 0.5f * p; accb = 0.5f * p; } }
        }
    }
    __syncthreads();
    unsigned sel = 0u;
    if (act) {
        for (int r = 0; r < 8; ++r) { float best = -3e38f; int bi = -1;
            for (int mb = 0; mb <= qt; ++mb) if (!((sel >> mb) & 1u)) { float v = ((IMP[(0 * 32 + mb) * 64 + lane] + IMP[(1 * 32 + mb) * 64 + lane]) + IMP[(2 * 32 + mb) * 64 + lane]) + IMP[(3 * 32 + mb) * 64 + lane];
                if (mb == 0 || mb == qt || mb == qt - 1) v += 1e4f; if (v > best) { best = v; bi = mb; } }
            if (bi >= 0) sel |= 1u << bi; }
        unsigned uni = 0u;
        for (int mb = 0; mb <= qt; ++mb) if (__ballot((sel >> mb) & 1u) != 0ull) uni |= 1u << mb;
        if (wave == 0 && lane == 0) *UNI = uni;
    }
    __syncthreads();
    const unsigned uni = *UNI;
    if (act) {
#pragma unroll
        for (int i = 0; i < 64; ++i) OUTL[(h * 64 + i) * 64 + lane] = g0 * o[i];
    }
    float m = -3e38f, l = 0.f;
#pragma unroll
    for (int i = 0; i < 64; ++i) o[i] = 0.f;
    for (int blk = 0; blk <= qt; ++blk) {
        if (!((uni >> blk) & 1u)) continue;
        __syncthreads();
        stage_tile64(KT, VT, z + (size_t)(b * SEQ + blk * 64) * ZLD + C_KS, z + (size_t)(b * SEQ + blk * 64) * ZLD + C_VS, ZLD, wv);
        __syncthreads();
        if (act && ((sel >> blk) & 1u)) {
            for (int r = 0; r < 64; ++r) { const int dd = t - (blk * 64 + r); if (dd >= 0) { const float s = dot64(q, KT + r * 16) + bd[dd < 127 ? dd : 127]; osm_update(s, VT + r * 16, m, l, o); } }
        }
    }
    if (act) { const float sc = g1 / l;
#pragma unroll
        for (int i = 0; i < 64; ++i) OUTL[(h * 64 + i) * 64 + lane] += sc * o[i]; }
    m = -3e38f; l = 0.f;
#pragma unroll
    for (int i = 0; i < 64; ++i) o[i] = 0.f;
    for (int tb = (qt >= 8 ? qt - 8 : 0); tb <= qt; ++tb) {
        __syncthreads();
        stage_tile64(KT, VT, z + (size_t)(b * SEQ + tb * 64) * ZLD + C_KW, z + (size_t)(b * SEQ + tb * 64) * ZLD + C_VW, ZLD, wv);
        __syncthreads();
        if (act) {
            for (int r = 0; r < 64; ++r) { const int dd = t - (tb * 64 + r); if (dd >= 0 && dd < 512) { const float s = dot64(q, KT + r * 16) + bd[dd < 127 ? dd : 127]; osm_update(s, VT + r * 16, m, l, o); } }
        }
    }
    if (act) { const float sc = g2 / l; bf16_t* op = o_nsa + row * MW + h * 64;
#pragma unroll
        for (int i = 0; i < 16; ++i) { f4 v; v.x = OUTL[(h * 64 + 4 * i) * 64 + lane] + sc * o[4 * i]; v.y = OUTL[(h * 64 + 4 * i + 1) * 64 + lane] + sc * o[4 * i + 1];
            v.z = OUTL[(h * 64 + 4 * i + 2) * 64 + lane] + sc * o[4 * i + 2]; v.w = OUTL[(h * 64 + 4 * i + 3) * 64 + lane] + sc * o[4 * i + 3]; st4bf(op + 4 * i, v); } }
    __syncthreads();
}

__device__ __forceinline__ void ret_unit(LAS unsigned char* lds, const bf16_t* z, const float* norm_g, bf16_t* o_ret, int b, int qt, int wv) {
    const int tid = tid_now(wv), wave = __builtin_amdgcn_readfirstlane(tid >> 6), lane = tid & 63, h = wave & 3; const bool act = wave < 4;
    LAS f4* KT = (LAS f4*)lds;
    LAS f4* VT = (LAS f4*)(lds + 65536);
    const int t = qt * 64 + lane; const size_t row = (size_t)b * SEQ + t;
    float q[64], o[64];
    if (act) { const bf16_t* zr = z + row * ZLD + C_RQ + h * 64;
#pragma unroll
        for (int i = 0; i < 16; ++i) { const f4 v = ld4bf(zr + 4 * i); q[4 * i] = v.x; q[4 * i + 1] = v.y; q[4 * i + 2] = v.z; q[4 * i + 3] = v.w; } }
#pragma unroll
    for (int i = 0; i < 64; ++i) o[i] = 0.f;
    const float lg2 = log2f(1.f - exp2f(-5.f - (float)h));
    for (int kb = 0; kb <= qt; ++kb) {
        __syncthreads();
#pragma unroll
        for (int k = 0; k < 8; ++k) { const int idx = tid + 512 * k, r = idx >> 6, c = idx & 63, hh = c >> 4, qq = c & 15;
            const bf16_t* src = z + (size_t)(b * SEQ + kb * 64 + r) * ZLD;
            KT[(hh * 64 + r) * 16 + qq] = ld4bf(src + C_RK + c * 4); VT[(hh * 64 + r) * 16 + qq] = ld4bf(src + C_RV + c * 4); }
        __syncthreads();
        if (act) {
            for (int r = 0; r < 64; ++r) { const int dd = t - (kb * 64 + r); if (dd >= 0) { const float w = dot64(q, KT + (h * 64 + r) * 16) * exp2f((float)dd * lg2);
#pragma unroll
                for (int i = 0; i < 16; ++i) { const f4 vv = VT[(h * 64 + r) * 16 + i]; o[4 * i] += w * vv.x; o[4 * i + 1] += w * vv.y; o[4 * i + 2] += w * vv.z; o[4 * i + 3] += w * vv.w; } } }
        }
    }
    if (act) {
        float mu = 0.f;
#pragma unroll
        for (int i = 0; i < 64; ++i) mu += o[i];
        mu *= (1.f / 64.f); float var = 0.f;
#pragma unroll
        for (int i = 0; i < 64; ++i) { o[i] -= mu; var += o[i] * o[i]; }
        const float rs = 1.f / sqrtf(var * (1.f / 64.f) + 1e-5f);
        const bf16_t* gr = z + row * ZLD + C_RG + h * 64; bf16_t* op = o_ret + row * MW + h * 64;
#pragma unroll
        for (int i = 0; i < 16; ++i) { const f4 g = ld4bf(gr + 4 * i), ng = *(const f4*)(norm_g + h * 64 + 4 * i); f4 v;
            v.x = g.x * sigmoidf_(g.x) * o[4 * i] * rs * ng.x; v.y = g.y * sigmoidf_(g.y) * o[4 * i + 1] * rs * ng.y; v.z = g.z * sigmoidf_(g.z) * o[4 * i + 2] * rs * ng.z; v.w = g.w * sigmoidf_(g.w) * o[4 * i + 3] * rs * ng.w;
            st4bf(op + 4 * i, v); }
    }
    __syncthreads();
}

__device__ __forceinline__ void xattn_unit(LAS unsigned char* lds, const float* Q, const float* KV, bf16_t* O, int b, int hh, int qt, int wv) {
    const int tid = tid_now(wv), ql = tid >> 2, sl = tid & 3;
    LAS f4* KT = (LAS f4*)lds;
    LAS f4* VT = (LAS f4*)(lds + 32768);
    const size_t row = (size_t)b * SEQ + qt * 128 + ql;
    float q[64], o[64];
    { const float* qr = Q + row * DM + hh * 256 + sl * 64;
#pragma unroll
        for (int i = 0; i < 16; ++i) { const f4 v = *(const f4*)(qr + 4 * i); q[4 * i] = v.x * 0.0625f; q[4 * i + 1] = v.y * 0.0625f; q[4 * i + 2] = v.z * 0.0625f; q[4 * i + 3] = v.w * 0.0625f; } }
#pragma unroll
    for (int i = 0; i < 64; ++i) o[i] = 0.f;
    float m = -3e38f, l = 0.f;
    for (int kb = 0; kb < 8; ++kb) {
        __syncthreads();
#pragma unroll
        for (int k = 0; k < 4; ++k) { const int idx = tid + 512 * k, r = idx >> 6, c = idx & 63; const float* src = KV + (size_t)(b * MEMLEN + kb * 32 + r) * 2048 + hh * 256 + c * 4;
            KT[idx] = *(const f4*)src; VT[idx] = *(const f4*)(src + 1024); }
        __syncthreads();
        for (int r = 0; r < 32; ++r) { float s = dot64(q, KT + r * 64 + sl * 16); s += __shfl_xor(s, 1); s += __shfl_xor(s, 2); osm_update(s, VT + r * 64 + sl * 16, m, l, o); }
    }
    const float inv = 1.f / l; bf16_t* op = O + row * DM + hh * 256 + sl * 64;
#pragma unroll
    for (int i = 0; i < 16; ++i) st4bf(op + 4 * i, (f4){o[4 * i] * inv, o[4 * i + 1] * inv, o[4 * i + 2] * inv, o[4 * i + 3] * inv});
    __syncthreads();
}

constexpr int NPL = 14, NPHASES = 1 + DEPTH * NPL;
typedef const __attribute__((address_space(4))) unsigned char* kaptr_t;
#define PHASE_ENV \
    kaptr_t ka_ = (kaptr_t)__builtin_amdgcn_kernarg_segment_ptr(); asm volatile("" : "+s"(ka_)); \
    const float* const* P = (const float* const*)ka_; float* const OUT = (float*)P[33]; unsigned char* const ws = (unsigned char*)P[34]; (void)OUT; (void)ws; \
    int G = G0, bid = (int)blockIdx.x, wv = wv0; asm volatile("" : "+s"(G), "+s"(bid), "+s"(wv)); const int NGW = G * NWAVES, NGT = G * NT; (void)NGW; (void)NGT; \
    const int tid = tid_now(wv), lane = tid & 63, wave = wv, gw = bid * NWAVES + wave, gt = bid * NT + tid; (void)lane; (void)gw; (void)gt; \
    LAS unsigned char* lds = lds0; asm volatile("" : "+s"(lds));
#define WSF(off) ((float*)(ws + (off)))
#define WSB(off) ((bf16_t*)(ws + (off)))
#define IN(k) (lo <= (k) && (k) < hi)
#if MK_PER_PHASE
#define SEAM() do { } while (0)
#else
#define SEAM() do { XcdBarrier b_ = bar; asm volatile("" : "+s"(b_.bar), "+s"(b_.x), "+s"(b_.st), "+s"(b_.wv)); xcd_barrier(b_); } while (0)
#endif
template <int l>
__device__ __forceinline__ void layer_phases(LAS unsigned char* const lds0, const int G0, const int wv0, const int lo, const int hi, const XcdBarrier& bar) {
        const int pb = 1 + l * NPL;
        if (IN(pb + 0)) { PHASE_ENV pg8::Epi<1> E{WSB(WS_Z), ZLD, WSB(WS_ZG), nullptr, nullptr, 0}; gemm_run<1>(lds, WSB(WS_H), WSB(WS_W) + WO_IN, MTOK, NZ, DM, E, wv, G, bid); SEAM(); }
        if (IN(pb + 1)) {
            PHASE_ENV
            bf16_t* Z = WSB(WS_Z); float* TABC = WSF(WS_TAB); float* TABS = TABC + 65536;
            for (int u = gw; u < BATCH * NCMP * 2; u += NGW) nsa_compress_unit(Z, P[4] + (size_t)l * 2 * 32 * 64 * 64, P[5] + (size_t)l * 32 * 64, WSF(WS_CMP), u, lane);
            { LAS float* scr = (LAS float*)lds + wave * 128; float* RW = WSF(WS_RW); for (int tok = gw; tok < MTOK; tok += NGW) rwkv_prep_token(Z, RW, P, l, tok, lane, scr); }
            { const float* cw = P[19] + (size_t)l * 3 * MW; bf16_t* oc = WSB(WS_BR) + (size_t)3 * MTOK * MW;
                for (int i = gt; i < MTOK * 64; i += NGT) { const int tok = i >> 6, c4 = (i & 63) * 4, t = tok % SEQ; const bf16_t* z = Z + (size_t)tok * ZLD;
                    const f4 bg = ld4bf(z + C_CB + c4); f4 u2 = ld4bf(z + C_CC + c4) * ld4bf(z + C_CX + c4);
                    f4 u1 = (f4){0.f, 0.f, 0.f, 0.f}, u0 = u1; if (t >= 1) u1 = ld4bf(z - ZLD + C_CC + c4) * ld4bf(z - ZLD + C_CX + c4); if (t >= 2) u0 = ld4bf(z - 2 * ZLD + C_CC + c4) * ld4bf(z - 2 * ZLD + C_CX + c4);
                    st4bf(oc + (size_t)tok * MW + c4, bg * (*(const f4*)(cw + c4) * u0 + *(const f4*)(cw + MW + c4) * u1 + *(const f4*)(cw + 2 * MW + c4) * u2)); } }
            for (int i = gt; i < MTOK * 2 * 4 * 32; i += NGT) { const int j = i & 31, h = (i >> 5) & 3, qk = (i >> 7) & 1, tok = i >> 8, t = tok % SEQ;
                bf16_t* p = Z + (size_t)tok * ZLD + (qk ? C_RK : C_RQ) + h * 64 + j; const float c = TABC[t * 32 + j], s = TABS[t * 32 + j], u1 = bf2f(p[0]), u2 = bf2f(p[32]), sc = qk ? 1.f : 0.125f;
                const unsigned a = pkbf((u1 * c - u2 * s) * sc, (u2 * c + u1 * s) * sc); p[0] = (bf16_t)(a & 0xffffu); p[32] = (bf16_t)(a >> 16); }
            SEAM();
        }
        if (IN(pb + 2)) {
            PHASE_ENV
            for (int u = bid; u < 32 + 256 + 256; u += G) {
                if (u < 32) rwkv_scan_unit(lds, WSF(WS_RW), u >> 2, u & 3, wv);
                else if (u < 288) nsa_unit(lds, WSB(WS_Z), WSF(WS_NG), WSF(WS_CMP), WSF(WS_CMP) + BATCH * NCMP * 64, WSF(WS_TAB) + 131072, WSB(WS_BR), (u - 32) >> 5, (u - 32) & 31, wv);
                else ret_unit(lds, WSB(WS_Z), P[7] + l * MW, WSB(WS_BR) + (size_t)MTOK * MW, (u - 288) >> 5, (u - 288) & 31, wv);
            }
            SEAM();
        }
        if (IN(pb + 3)) { PHASE_ENV for (int tok = gw; tok < MTOK; tok += NGW) rwkv_fin_token(WSF(WS_RW), WSB(WS_BR) + (size_t)2 * MTOK * MW, P[16] + l * MW, P[17] + l * MW, P[18] + l * MW, tok, lane); SEAM(); }
        if (IN(pb + 4)) {
#pragma unroll 1
            for (int m = 0; m < 4; ++m) { PHASE_ENV pg8::Epi<4> E{WSB(WS_MERGED), DM, nullptr, WSF(WS_MACC), WSB(WS_ZG), m}; gemm_run<4>(lds, WSB(WS_BR) + (size_t)m * MTOK * MW, WSB(WS_W) + WO_BR + (size_t)m * DM * MW, MTOK, DM, MW, E, wv, G, bid); }
            SEAM(); }
        if (IN(pb + 5)) { PHASE_ENV pg8::Epi<3> E{nullptr, DM, nullptr, WSF(WS_Y), nullptr, 0}; gemm_run<3>(lds, WSB(WS_MERGED), WSB(WS_W) + WO_MO, MTOK, DM, DM, E, wv, G, bid); SEAM(); }
        if (IN(pb + 6)) { PHASE_ENV rowop((l == 0) ? P[0] : OUT, WSF(WS_Y), P[22] + l * DM, P[23] + l * DM, OUT, WSB(WS_H), nullptr, nullptr, gw, NGW, lane); rms_rows(P[1], P[24] + l * DM, WSB(WS_MN), BATCH * MEMLEN, nullptr, nullptr, gw, NGW, lane); SEAM(); }
        if (IN(pb + 7)) { { PHASE_ENV pg8::Epi<3> E{nullptr, DM, nullptr, WSF(WS_Q), nullptr, 0}; gemm_run<3>(lds, WSB(WS_H), WSB(WS_W) + WO_Q, MTOK, DM, DM, E, wv, G, bid); }
            { PHASE_ENV pg8::Epi<3> E{nullptr, 2 * DM, nullptr, WSF(WS_KV), nullptr, 0}; gemm_run<3>(lds, WSB(WS_MN), WSB(WS_W) + WO_KV, BATCH * MEMLEN, 2 * DM, DM, E, wv, G, bid); } SEAM(); }
        if (IN(pb + 8)) { PHASE_ENV for (int u = bid; u < BATCH * 4 * 16; u += G) xattn_unit(lds, WSF(WS_Q), WSF(WS_KV), WSB(WS_O), u >> 6, (u >> 4) & 3, u & 15, wv); SEAM(); }
        if (IN(pb + 9)) { PHASE_ENV pg8::Epi<3> E{nullptr, DM, nullptr, WSF(WS_Y), nullptr, 0}; gemm_run<3>(lds, WSB(WS_O), WSB(WS_W) + WO_O, MTOK, DM, DM, E, wv, G, bid); SEAM(); }
        if (IN(pb + 10)) { PHASE_ENV rowop(OUT, WSF(WS_Y), P[28] + l * DM, P[29] + l * DM, OUT, WSB(WS_H), nullptr, nullptr, gw, NGW, lane); SEAM(); }
        if (IN(pb + 11)) { PHASE_ENV pg8::Epi<2> E{WSB(WS_HID), DFF, nullptr, nullptr, nullptr, 0}; gemm_run<2>(lds, WSB(WS_H), WSB(WS_W) + WO_1, MTOK, DFF, DM, E, wv, G, bid); SEAM(); }
        if (IN(pb + 12)) { PHASE_ENV pg8::Epi<3> E{nullptr, DM, nullptr, WSF(WS_Y), nullptr, 0}; gemm_run<3>(lds, WSB(WS_HID), WSB(WS_W) + WO_2, MTOK, DM, DFF, E, wv, G, bid); SEAM(); }
        if (IN(pb + 13)) {
            PHASE_ENV
            if (l + 1 < DEPTH) { convert_layer(P, l + 1, WSB(WS_W), lds, wave, lane, gw, NGW); __syncthreads(); stage_wng((LAS float*)lds, P[3] + (size_t)(l + 1) * DM * IN_COLS, tid); __syncthreads();
                rowop(OUT, WSF(WS_Y), P[32] + l * DM, P[2] + (l + 1) * DM, OUT, WSB(WS_H), (const LAS float*)lds, WSF(WS_NG), gw, NGW, lane); }
            else rowop(OUT, WSF(WS_Y), P[32] + l * DM, nullptr, OUT, WSB(WS_H), nullptr, nullptr, gw, NGW, lane);
            SEAM(); }
    }

__global__ void __launch_bounds__(NT, 2) mk_fwd(Args args) {
    extern __shared__ __attribute__((aligned(16))) unsigned char lds_raw[];
    LAS unsigned char* const lds0 = (LAS unsigned char*)lds_raw;
    const int G0 = gridDim.x;
    const int wv0 = __builtin_amdgcn_readfirstlane((int)threadIdx.x >> 6);
    const int lo = args.ph_lo, hi = args.ph_hi;
#if MK_PER_PHASE
    XcdBarrier bar; bar.bar = nullptr; bar.x = 0; bar.wv = 0; bar.st = nullptr;
#else
    { const int t0 = tid_now(wv0); if (t0 < 4) ((LAS unsigned*)(lds0 + XB_LDS_OFF))[t0] = 0u; }
    __syncthreads();
    const XcdBarrier bar = xcd_barrier_post((unsigned*)(args.ws + WS_CTL) + CW_BAR, (volatile LAS unsigned*)(lds0 + XB_LDS_OFF), wv0);
#endif

    if (IN(0)) {
        PHASE_ENV
        float* TABC = WSF(WS_TAB); float* TABS = TABC + 65536; float* BIASD = TABC + 131072;
        for (int i = gt; i < SEQ * 32; i += NGT) { const int t = i >> 5, j = i & 31; const double rev = (double)t * INVF_REV[j]; const float fr = (float)(rev - floor(rev)); TABC[i] = __builtin_amdgcn_cosf(fr); TABS[i] = __builtin_amdgcn_sinf(fr); }
        for (int i = gt; i < 512; i += NGT) { const int h = i >> 7, d = i & 127; BIASD[i] = P[6][T5B[d] * MH + h]; }
        convert_layer(P, 0, WSB(WS_W), lds, wave, lane, gw, NGW);
        __syncthreads();
        stage_wng((LAS float*)lds, P[3], tid);
        __syncthreads();
        rms_rows(P[0], P[2], WSB(WS_H), MTOK, (const LAS float*)lds, WSF(WS_NG), gw, NGW, lane);
        SEAM();
    }
    layer_phases<0>(lds0, G0, wv0, lo, hi, bar); layer_phases<1>(lds0, G0, wv0, lo, hi, bar); layer_phases<2>(lds0, G0, wv0, lo, hi, bar); layer_phases<3>(lds0, G0, wv0, lo, hi, bar);
#undef IN
}

extern "C" void kernel_launch(void* const* d_in, const int* in_sizes, int n_in, void* d_out, int out_size, void* d_ws, size_t ws_size, hipStream_t stream) {
    static int grid = 0;
    if (grid == 0) {
        if (n_in != 33 || out_size != MTOK * DM || ws_size < WS_END) { fprintf(stderr, "kernel_launch: unexpected shapes (n_in %d out %d ws %zu)\n", n_in, out_size, ws_size); grid = -1; return; }
        int dev = 0, cus = 0;
        if (hipGetDevice(&dev) != hipSuccess || hipDeviceGetAttribute(&cus, hipDeviceAttributeMultiprocessorCount, dev) != hipSuccess) { grid = -1; return; }
        if (hipFuncSetAttribute((const void*)mk_fwd, hipFuncAttributeMaxDynamicSharedMemorySize, LDS_BYTES) != hipSuccess) { fprintf(stderr, "kernel_launch: hipFuncSetAttribute failed\n"); grid = -1; return; }
        grid = cus;
    }
    if (grid < 0) return;
    (void)hipMemsetAsync((char*)d_ws + WS_CTL, 0, 1 * MiB, stream);
    Args a{};
    for (int i = 0; i < 33; ++i) a.in[i] = (const float*)d_in[i];
    a.out = (float*)d_out; a.ws = (unsigned char*)d_ws;
#if MK_PER_PHASE
    for (int p = 0; p < NPHASES; ++p) { a.ph_lo = p; a.ph_hi = p + 1; hipLaunchKernelGGL(mk_fwd, dim3(grid), dim3(NT), LDS_BYTES, stream, a); }
#else
    a.ph_lo = 0; a.ph_hi = NPHASES; hipLaunchKernelGGL(mk_fwd, dim3(grid), dim3(NT), LDS_BYTES, stream, a);
#endif
}
```

```cpp
#include <hip/hip_runtime.h>
#include <cstdio>
#include <cstdint>

#ifndef MK_PER_PHASE
#define MK_PER_PHASE 0
#endif
#define LAS __attribute__((address_space(3)))
typedef float f4 __attribute__((ext_vector_type(4)));
typedef unsigned short bf16_t;

constexpr int NWAVES = 8, NT = 512;
constexpr int BATCH = 8, SEQ = 2048, DM = 1024, DEPTH = 4, MTOK = BATCH * SEQ;
constexpr int MEMLEN = 256, MW = 256, HD = 64, MH = 4, DFF = 4096;
constexpr int IN_COLS = 7436, GATE_OFF = 3340;
constexpr int ZLD = 3328, NZ = 7424;
constexpr int NCMP = 127;
constexpr int C_Q = 0, C_KC = 256, C_VC = 320, C_KS = 384, C_VS = 448, C_KW = 512, C_VW = 576;
constexpr int C_RQ = 640, C_RK = 896, C_RV = 1152, C_RG = 1408, C_RW = 1664, C_CB = 2560, C_CC = 2816, C_CX = 3072;
constexpr int RWKV_COLS = 896;

constexpr size_t MiB = 1u << 20;
constexpr size_t WS_CTL = 0, WS_TAB = 1 * MiB, WS_CMP = 2 * MiB, WS_NG = 3 * MiB;
constexpr size_t WS_W = 4 * MiB;
constexpr size_t WS_H = 47 * MiB;
constexpr size_t WS_Z = 79 * MiB;
constexpr size_t WS_ZG = 183 * MiB;
constexpr size_t WS_RW = 311 * MiB;
constexpr size_t WS_BR = 423 * MiB;
constexpr size_t WS_MACC = 79 * MiB, WS_MERGED = 143 * MiB;
constexpr size_t WS_Q = 183 * MiB, WS_O = 247 * MiB, WS_KX = 279 * MiB, WS_VT = 283 * MiB, WS_MN = 295 * MiB, WS_HID = 183 * MiB;
constexpr size_t WS_Y = 311 * MiB;
constexpr size_t WS_END = 455 * MiB;
constexpr size_t WO_IN = 0, WO_BR = WO_IN + (size_t)NZ * DM, WO_MO = WO_BR + (size_t)4 * DM * MW, WO_Q = WO_MO + (size_t)DM * DM, WO_KV = WO_Q + (size_t)DM * DM,
                 WO_O = WO_KV + (size_t)2 * DM * DM, WO_1 = WO_O + (size_t)DM * DM, WO_2 = WO_1 + (size_t)DFF * DM, WO_END = WO_2 + (size_t)DFF * DM;
static_assert(WS_W + WO_END * 2 <= WS_H, "weight copies fit");
constexpr int LDS_BYTES = 147456, XB_LDS_OFF = 147440;
constexpr int CW_BAR = 4096;

__device__ const unsigned char T5B[128] = {0, 1, 2, 3, 4, 5, 6, 7, 8, 9, 10, 11, 12, 13, 14, 15, 16, 16, 16, 17, 17, 18, 18, 18, 19, 19, 19, 20, 20, 20, 20, 21, 21, 21, 21, 22, 22, 22, 22, 22, 23, 23, 23, 23, 23, 23, 24, 24, 24, 24, 24, 24, 25, 25, 25, 25, 25, 25, 25, 26, 26, 26, 26, 26, 26, 26, 26, 27, 27, 27, 27, 27, 27, 27, 27, 27, 27, 28, 28, 28, 28, 28, 28, 28, 28, 28, 28, 29, 29, 29, 29, 29, 29, 29, 29, 29, 29, 29, 29, 30, 30, 30, 30, 30, 30, 30, 30, 30, 30, 30, 30, 30, 30, 31, 31, 31, 31, 31, 31, 31, 31, 31, 31, 31, 31, 31, 31, 31};

__device__ const double INVF_REV[32] = {0.15915494309189535, 0.11934937021124885, 0.08949940160889101, 0.06711508300522726, 0.05032921210448703, 0.037741584717419764, 0.028302195830623395, 0.02122365276477766, 0.01591549430918953, 0.011934937021124881, 0.008949940160889099, 0.0067115083005227245, 0.005032921210448702, 0.003774158471741975, 0.0028302195830623394, 0.0021223652764777645, 0.0015915494309189527, 0.0011934937021124885, 0.0008949940160889096, 0.0006711508300522724, 0.0005032921210448699, 0.00037741584717419747, 0.00028302195830623385, 0.00021223652764777642, 0.00015915494309189524, 0.00011934937021124881, 8.949940160889094e-05, 6.711508300522721e-05, 5.032921210448702e-05, 3.7741584717419736e-05, 2.830219583062336e-05, 2.1223652764777656e-05};


struct Args { const float* in[33]; float* out; unsigned char* ws; int ph_lo, ph_hi; };
__device__ __forceinline__ int tid_now(int wv);
#define XB_TMO      128
#define XB_XCNT(j)  (256  + 64 * (j))
#define XB_XSUB(j)  (1280 + 64 * (j))
#define XB_XGEN(j)  (2304 + 64 * (j))
#define XB_TOP      3328
#define XB_TOPGEN   3392
#define XCD_BAR_WORDS 3456
#define XB_SPIN_CAP (1u << 18)

__device__ __forceinline__ unsigned xb_ld(unsigned* p)              { return __hip_atomic_load(p, __ATOMIC_RELAXED, __HIP_MEMORY_SCOPE_AGENT); }
__device__ __forceinline__ unsigned xb_add(unsigned* p, unsigned v) { return __hip_atomic_fetch_add(p, v, __ATOMIC_RELAXED, __HIP_MEMORY_SCOPE_AGENT); }
__device__ __forceinline__ unsigned xb_xcc_id() { return (unsigned)__builtin_amdgcn_s_getreg((3 << 11) | 20) & 0xFu; }
#define XB_SPIN(cond, bar) do { unsigned _sp = 0; while (cond) { __builtin_amdgcn_s_sleep(1); \
    if ((++_sp & 255u) == 0u) { if (xb_ld(&(bar)[XB_TMO])) break; if (_sp > XB_SPIN_CAP) { atomicAdd(&(bar)[XB_TMO], 1u); break; } } } } while (0)

struct XcdBarrier {
    unsigned* bar; unsigned x; int wv;
    volatile LAS unsigned* st;
};

__device__ __forceinline__ XcdBarrier xcd_barrier_post(unsigned* bar, volatile LAS unsigned* st, int wv) {
    XcdBarrier b; b.bar = bar; b.x = xb_xcc_id(); b.st = st; b.wv = wv;
    if (tid_now(wv) == 0) (void)xb_add(&bar[XB_XCNT(b.x)], 1u);
    return b;
}
__device__ __forceinline__ void xcd_barrier_complete(unsigned* bar, unsigned x, unsigned& nloc, unsigned& nx) {
    const unsigned G = gridDim.x * gridDim.y * gridDim.z;
    unsigned sum, cnt, mine, sp = 0u;
    for (;;) {
        sum = 0u; cnt = 0u; mine = 0u;
#pragma unroll
        for (unsigned j = 0; j < 16; ++j) { const unsigned c = xb_ld(&bar[XB_XCNT(j)]); sum += c; cnt += (c > 0u) ? 1u : 0u; mine = (j == x) ? c : mine; }
        if (sum == G) break;
        __builtin_amdgcn_s_sleep(1);
        if ((++sp & 255u) == 0u) { if (xb_ld(&bar[XB_TMO])) break; if (sp > XB_SPIN_CAP) { atomicAdd(&bar[XB_TMO], 1u); break; } }
    }
    nloc = mine > 0u ? mine : 1u; nx = cnt > 0u ? cnt : 1u;
}

__device__ __forceinline__ void xcd_barrier(const XcdBarrier& b) {
    asm volatile("s_waitcnt vmcnt(0)" ::: "memory");
    __syncthreads();
    if (tid_now(b.wv) == 0) {
        unsigned* bar = b.bar;
        __builtin_amdgcn_s_waitcnt(0);
        unsigned nloc = b.st[0], nx = b.st[1];
        if (nloc == 0u) { xcd_barrier_complete(bar, b.x, nloc, nx); b.st[0] = nloc; b.st[1] = nx; }
        const unsigned old = xb_add(&bar[XB_XSUB(b.x)], 1u);
        const unsigned gen = old / nloc;
        if (old + 1u == (gen + 1u) * nloc) {
            __builtin_amdgcn_fence(__ATOMIC_RELEASE, "agent");
            asm volatile("s_waitcnt vmcnt(0)" ::: "memory");
            const unsigned og = xb_add(&bar[XB_TOP], 1u);
            const unsigned tg = og / nx;
            if (og + 1u == (tg + 1u) * nx) xb_add(&bar[XB_TOPGEN], 1u);
            else XB_SPIN(xb_ld(&bar[XB_TOPGEN]) == tg, bar);
            __builtin_amdgcn_fence(__ATOMIC_ACQUIRE, "agent");
            xb_add(&bar[XB_XGEN(b.x)], 1u);
            asm volatile("s_waitcnt vmcnt(0)" ::: "memory");
        } else {
            XB_SPIN(xb_ld(&bar[XB_XGEN(b.x)]) == gen, bar);
            __builtin_amdgcn_fence(__ATOMIC_ACQUIRE, "agent");
            asm volatile("s_waitcnt vmcnt(0)" ::: "memory");
        }
    }
    __syncthreads();
}


__device__ __forceinline__ int tid_now(int wv) { int l; asm volatile("v_mbcnt_lo_u32_b32 %0, -1, 0\n\tv_mbcnt_hi_u32_b32 %0, -1, %0" : "=v"(l)); return (wv << 6) | l; }
__device__ __forceinline__ float wsum(float v) {
#pragma unroll
    for (int o = 32; o >= 1; o >>= 1) v += __shfl_xor(v, o);
    return v;
}
__device__ __forceinline__ float gsum16(float v) {
#pragma unroll
    for (int o = 8; o >= 1; o >>= 1) v += __shfl_xor(v, o);
    return v;
}
__device__ __forceinline__ float sigmoidf_(float x) { return 1.f / (1.f + __expf(-x)); }
__device__ __forceinline__ float bflo(unsigned u) { return __uint_as_float(u << 16); }
__device__ __forceinline__ float bfhi(unsigned u) { return __uint_as_float(u & 0xffff0000u); }
__device__ __forceinline__ float bf2f(bf16_t b) { return __uint_as_float((unsigned)b << 16); }
__device__ __forceinline__ unsigned pkbf(float lo, float hi) { unsigned r; asm volatile("v_cvt_pk_bf16_f32 %0, %1, %2" : "=v"(r) : "v"(lo), "v"(hi)); return r; }
__device__ __forceinline__ f4 ld4bf(const bf16_t* p) { const uint2 u = *(const uint2*)p; return (f4){bflo(u.x), bfhi(u.x), bflo(u.y), bfhi(u.y)}; }
__device__ __forceinline__ void st4bf(bf16_t* p, f4 v) { uint2 u; u.x = pkbf(v.x, v.y); u.y = pkbf(v.z, v.w); *(uint2*)p = u; }
__device__ __forceinline__ float dot64(const float (&q)[64], const LAS f4* k) {
    float a0 = 0.f, a1 = 0.f, a2 = 0.f, a3 = 0.f;
#pragma unroll
    for (int i = 0; i < 16; ++i) { const f4 kv = k[i]; a0 += q[4 * i] * kv.x; a1 += q[4 * i + 1] * kv.y; a2 += q[4 * i + 2] * kv.z; a3 += q[4 * i + 3] * kv.w; }
    return (a0 + a1) + (a2 + a3);
}
__device__ __forceinline__ void osm_update(float s, const LAS f4* v, float& m, float& l, float (&o)[64]) {
    const float mn = fmaxf(m, s), sc = __expf(m - mn), p = __expf(s - mn);
    l = l * sc + p; m = mn;
#pragma unroll
    for (int i = 0; i < 16; ++i) { const f4 vv = v[i];
        o[4 * i] = o[4 * i] * sc + p * vv.x; o[4 * i + 1] = o[4 * i + 1] * sc + p * vv.y; o[4 * i + 2] = o[4 * i + 2] * sc + p * vv.z; o[4 * i + 3] = o[4 * i + 3] * sc + p * vv.w; }
}

typedef short bf16x8_t __attribute__((ext_vector_type(8)));
typedef float f32x16_t __attribute__((ext_vector_type(16)));
typedef unsigned u32x4_t __attribute__((ext_vector_type(4))); typedef unsigned u32x2_t __attribute__((ext_vector_type(2)));
typedef float f32x2_t __attribute__((ext_vector_type(2))); typedef __bf16 bf16x2_t __attribute__((ext_vector_type(2)));
__device__ __forceinline__ unsigned cvtpk(float lo, float hi) { f32x2_t v = {lo, hi}; bf16x2_t b = __builtin_convertvector(v, bf16x2_t); return __builtin_bit_cast(unsigned, b); }
#define MFMA32(a, b, c) __builtin_amdgcn_mfma_f32_32x32x16_bf16((a), (b), (c), 0, 0, 0)
__device__ __forceinline__ float xhalf(float v) { return __shfl_xor(v, 32); }

namespace pg8 {
#define PG8_LAS __attribute__((address_space(3)))
typedef unsigned short bf16_t;
typedef short bf16x8 __attribute__((ext_vector_type(8)));
typedef float f32x4 __attribute__((ext_vector_type(4)));
typedef unsigned u32x4 __attribute__((ext_vector_type(4)));
constexpr int BM = 256, BK = 64, HALF = 128, HTB = HALF * BK * 2  , STAGE_BYTES = 8 * HTB, NXCD = 8, WGM = 8;

__host__ __device__ __forceinline__ int lds_byte(int r, int c) { const int st = (r >> 4) * 2 + (c >> 5), rr = r & 15, cc = c & 31, ob = rr * 64 + cc * 2; return st * 1024 + (ob ^ (((ob >> 9) & 1) << 5)); }
__host__ __device__ __forceinline__ void stage_rc(int b, int& R, int& C) { const int st = b / 1024, sb = b % 1024, swz = sb ^ (((sb >> 9) & 1) << 5); R = (st >> 1) * 16 + swz / 64; C = (st & 1) * 32 + (swz % 64) / 2; }
__host__ __device__ __forceinline__ int perm32(int rho) { const int n = rho >> 4, i = rho & 15; return 8 * (i >> 2) + 4 * n + (i & 3); }

struct Unit { int pm, pn; };
struct Gemm { const bf16_t* A; const bf16_t* Bt; int M, N, K; };

struct StaticOrder {
    int nM, nN, nwg, G, c;
    __host__ __device__ void init(int M, int N, int G_, int c_) { nM = M / BM; nN = N / BM; nwg = nM * nN; G = G_; c = c_; }
    __host__ __device__ bool next(int i, Unit& u) const {
        const long L = (long)i * G + c; if (L >= nwg) return false;
        int wgid = (int)L; { const int q = nwg / NXCD, r = nwg % NXCD, xcd = wgid % NXCD, off = wgid / NXCD; wgid = (xcd < r ? xcd * (q + 1) : r * (q + 1) + (xcd - r) * q) + off; }
        const int nig = WGM * nN, gid = wgid / nig, fm = gid * WGM, gsz = (nM - fm) < WGM ? (nM - fm) : WGM;
        u.pm = fm + ((wgid % nig) % gsz); u.pn = (wgid % nig) / gsz; return true;
    }
    __device__ __forceinline__ void a_ready(const Unit&) const {}
    __device__ __forceinline__ void done(const Unit&) const {}
};

__device__ __forceinline__ unsigned cvt_pk_bf16(float lo, float hi) { unsigned r; asm volatile("v_cvt_pk_bf16_f32 %0, %1, %2" : "=v"(r) : "v"(lo), "v"(hi)); return r; }
typedef float f32x2 __attribute__((ext_vector_type(2)));

template <int MODE> struct Epi {
    static constexpr bool PERM = true, AFTER_DRAIN = false;
    bf16_t* O; int ldc; bf16_t* O2; float* F; const bf16_t* SG; int mi;
    __device__ __forceinline__ void operator()(const f32x4 (&acc)[2][2][4][2], const Unit& u, int wr, int wc, int fr, int fq) const {
        const int row0 = u.pm * BM + wr * 64 + fr, col0 = u.pn * BM + wc * 32 + 8 * fq;
#pragma unroll
        for (int ai = 0; ai < 2; ++ai)
#pragma unroll
            for (int m = 0; m < 4; ++m) { const size_t row = (size_t)(row0 + ai * HALF + m * 16);
#pragma unroll
                for (int bj = 0; bj < 2; ++bj) { f32x4 v0 = acc[ai][bj][m][0], v1 = acc[ai][bj][m][1]; const int col = col0 + bj * HALF;
                    if (MODE == 3) { float* p = F + row * ldc + col; *(f32x4*)p = v0; *(f32x4*)(p + 4) = v1; }
                    else {
                        bf16_t* dst = O + row * ldc + col;
                        if (MODE == 1) { if (u.pn >= ZLD / BM) { dst = O2 + row * (4 * DM) + (col - ZLD);
#pragma unroll
                            for (int e = 0; e < 4; ++e) { v0[e] = sigmoidf_(v0[e]); v1[e] = sigmoidf_(v1[e]); } } }
                        if (MODE == 2) {
#pragma unroll
                            for (int e = 0; e < 4; ++e) { const float a = fmaxf(v0[e], 0.f), b = fmaxf(v1[e], 0.f); v0[e] = a * a; v1[e] = b * b; } }
                        if (MODE == 4) { const u32x4 g = *(const u32x4*)(SG + row * (4 * DM) + mi * DM + col);
                            v0[0] *= bflo(g.x); v0[1] *= bfhi(g.x); v0[2] *= bflo(g.y); v0[3] *= bfhi(g.y); v1[0] *= bflo(g.z); v1[1] *= bfhi(g.z); v1[2] *= bflo(g.w); v1[3] *= bfhi(g.w);
                            float* p = F + row * DM + col;
                            if (mi > 0) { v0 += *(const f32x4*)p; v1 += *(const f32x4*)(p + 4); }
                            if (mi < 3) { *(f32x4*)p = v0; *(f32x4*)(p + 4) = v1; continue; } }
                        u32x4 w; w.x = cvt_pk_bf16(v0[0], v0[1]); w.y = cvt_pk_bf16(v0[2], v0[3]); w.z = cvt_pk_bf16(v1[0], v1[1]); w.w = cvt_pk_bf16(v1[2], v1[3]);
                        *(u32x4*)dst = w; } } }
    }
};
template <class Epi, class Sched, bool ALIGN_EPI = false, bool SP2 = false>
__device__ __forceinline__ void gemm_phase(PG8_LAS unsigned char* lds, const Gemm g, const Sched& S, const Epi& E, int wv) {
    const int tid = tid_now(wv), wid = __builtin_amdgcn_readfirstlane(tid >> 6), lane = tid & 63, wr = wid >> 2, wc = wid & 3, fr = lane & 15, fq = lane >> 4;
    const int K = g.K, nt = K / BK;
    unsigned voffA[2], voffB[2];
#pragma unroll
    for (int i = 0; i < 2; ++i) { int R, C; stage_rc(tid * 16 + i * 8192, R, C); const int Rb = Epi::PERM ? ((R & ~31) + perm32(R & 31)) : R;
        voffA[i] = (unsigned)(R * K + C) * 2u; voffB[i] = (unsigned)(Rb * K + C) * 2u; }
    const size_t kstep = (size_t)(BK * 2);
    const size_t hstep = (size_t)HALF * K * 2;
    const size_t tstep = 2 * hstep;
    const unsigned ldsw = (unsigned)wid * 1024u;
    const int aoff = lds_byte(wr * 64 + fr, fq * 8), boff = lds_byte(wc * 32 + fr, fq * 8);
#define PG8_SA(b, h) (((b) * 2 + (h)) * HTB)
#define PG8_SB(b, h) ((4 + (b) * 2 + (h)) * HTB)
#define PG8_STAGE(bufoff, gbase, voff) do { _Pragma("unroll") for (int _i = 0; _i < 2; ++_i) \
        __builtin_amdgcn_global_load_lds((const unsigned*)((const char*)(gbase) + (voff)[_i]), (PG8_LAS unsigned*)(lds + (bufoff) + ldsw + _i * 8192), 16, 0, 0); } while (0)
#define PG8_LDA(dst, b, h) do { _Pragma("unroll") for (int m = 0; m < 4; ++m) _Pragma("unroll") for (int k = 0; k < 2; ++k) dst[m][k] = *(const PG8_LAS bf16x8*)(lds + PG8_SA(b, h) + aoff + m * 2048 + k * 1024); } while (0)
#define PG8_LDB(dst, b, h) do { _Pragma("unroll") for (int n = 0; n < 2; ++n) _Pragma("unroll") for (int k = 0; k < 2; ++k) dst[n][k] = *(const PG8_LAS bf16x8*)(lds + PG8_SB(b, h) + boff + n * 2048 + k * 1024); } while (0)
#define PG8_MMA(ai, bj, At, Bt) do { __builtin_amdgcn_s_setprio(1); _Pragma("unroll") for (int m = 0; m < 4; ++m) _Pragma("unroll") for (int n = 0; n < 2; ++n) _Pragma("unroll") for (int k = 0; k < 2; ++k) \
        acc[ai][bj][m][n] = __builtin_amdgcn_mfma_f32_16x16x32_bf16(Bt[n][k], At[m][k], acc[ai][bj][m][n], 0, 0, 0); __builtin_amdgcn_s_setprio(0); } while (0)
#define PG8_WAIT_V(n) asm volatile("s_waitcnt vmcnt(" #n ")" ::: "memory")
#define PG8_WAIT_L(n) asm volatile("s_waitcnt lgkmcnt(" #n ")" ::: "memory")
#define PG8_BAR __builtin_amdgcn_s_barrier()
#define PG8_SCHED __builtin_amdgcn_sched_barrier(0)
    Unit cur, nxt; int ui = 0;
    if (!S.next(0, cur)) return;
    f32x4 acc[2][2][4][2];
#pragma unroll
    for (int a = 0; a < 2; ++a)
#pragma unroll
        for (int b = 0; b < 2; ++b)
#pragma unroll
            for (int m = 0; m < 4; ++m)
#pragma unroll
                for (int n = 0; n < 2; ++n) acc[a][b][m][n] = (f32x4){0.f, 0.f, 0.f, 0.f};
    bf16x8 At[4][2], B0[2][2], B1[2][2];
    const char* cA = (const char*)g.A + (size_t)cur.pm * tstep; const char* cB = (const char*)g.Bt + (size_t)cur.pn * tstep;
    S.a_ready(cur);
    if constexpr (SP2) {
        PG8_STAGE(PG8_SB(0, 0), cB, voffB); PG8_STAGE(PG8_SB(0, 1), cB + hstep, voffB); PG8_STAGE(PG8_SA(0, 0), cA, voffA); PG8_STAGE(PG8_SA(0, 1), cA + hstep, voffA);
        if (wr == 1) PG8_BAR;
        PG8_WAIT_V(2); PG8_BAR;
        PG8_STAGE(PG8_SB(1, 0), cB + kstep, voffB); PG8_STAGE(PG8_SA(1, 0), cA + kstep, voffA); PG8_STAGE(PG8_SB(1, 1), cB + hstep + kstep, voffB);
        PG8_WAIT_V(6); PG8_BAR;
    } else {
        PG8_STAGE(PG8_SB(0, 0), cB, voffB); PG8_STAGE(PG8_SA(0, 0), cA, voffA); PG8_STAGE(PG8_SB(0, 1), cB + hstep, voffB); PG8_STAGE(PG8_SA(0, 1), cA + hstep, voffA);
        if (wr == 1) PG8_BAR;
        PG8_WAIT_V(4); PG8_BAR;
        PG8_STAGE(PG8_SB(1, 0), cB + kstep, voffB); PG8_STAGE(PG8_SA(1, 0), cA + kstep, voffA); PG8_STAGE(PG8_SB(1, 1), cB + hstep + kstep, voffB);
        PG8_WAIT_V(6); PG8_BAR;
    }
    for (;;) {
        const bool has_next = S.next(ui + 1, nxt);
        const char* nA = has_next ? (const char*)g.A + (size_t)nxt.pm * tstep : cA; const char* nB = has_next ? (const char*)g.Bt + (size_t)nxt.pn * tstep : cB;
        for (int t = 0; t < nt; t += 2) {
            const bool last = (t == nt - 2);
            const char* a1 = cA + (size_t)(t + 1) * kstep;
            const char* a2 = last ? nA : cA + (size_t)(t + 2) * kstep; const char* b2 = last ? nB : cB + (size_t)(t + 2) * kstep;
            const char* a3 = a2 + kstep; const char* b3 = b2 + kstep;
            if (last && has_next) S.a_ready(nxt);
            if constexpr (SP2) {
            PG8_LDB(B0, 0, 0); PG8_LDB(B1, 0, 1); PG8_SCHED; PG8_LDA(At, 0, 0); PG8_STAGE(PG8_SA(1, 1), a1 + hstep, voffA);
            PG8_WAIT_V(8); PG8_WAIT_L(0); PG8_BAR; PG8_MMA(0, 0, At, B0); PG8_MMA(0, 1, At, B1); PG8_BAR; PG8_SCHED;
            PG8_LDA(At, 0, 1); PG8_STAGE(PG8_SB(0, 0), b2, voffB); PG8_STAGE(PG8_SB(0, 1), b2 + hstep, voffB); PG8_STAGE(PG8_SA(0, 0), a2, voffA);
            PG8_WAIT_V(8); PG8_WAIT_L(0); PG8_BAR; PG8_MMA(1, 0, At, B0); PG8_MMA(1, 1, At, B1); PG8_BAR; PG8_SCHED;
            PG8_LDB(B0, 1, 0); PG8_LDB(B1, 1, 1); PG8_SCHED; PG8_LDA(At, 1, 0); PG8_STAGE(PG8_SA(0, 1), a2 + hstep, voffA);
            PG8_WAIT_V(8); PG8_WAIT_L(0); PG8_BAR; PG8_MMA(0, 0, At, B0); PG8_MMA(0, 1, At, B1); PG8_BAR; PG8_SCHED;
            PG8_LDA(At, 1, 1); PG8_STAGE(PG8_SB(1, 0), b3, voffB); PG8_STAGE(PG8_SB(1, 1), b3 + hstep, voffB); PG8_STAGE(PG8_SA(1, 0), a3, voffA);
            PG8_WAIT_V(8); PG8_WAIT_L(0); PG8_BAR; PG8_MMA(1, 0, At, B0); PG8_MMA(1, 1, At, B1); PG8_BAR; PG8_SCHED;
            } else {
            PG8_LDB(B0, 0, 0); PG8_SCHED; PG8_LDA(At, 0, 0); PG8_STAGE(PG8_SA(1, 1), a1 + hstep, voffA);
            PG8_WAIT_L(8); PG8_BAR; PG8_WAIT_L(0); PG8_MMA(0, 0, At, B0); PG8_BAR; PG8_SCHED;
            PG8_LDB(B1, 0, 1); PG8_STAGE(PG8_SB(0, 0), b2, voffB);
            PG8_BAR; PG8_WAIT_L(0); PG8_MMA(0, 1, At, B1); PG8_BAR;
            PG8_LDA(At, 0, 1); PG8_STAGE(PG8_SA(0, 0), a2, voffA);
            PG8_BAR; PG8_WAIT_L(0); PG8_MMA(1, 0, At, B0); PG8_BAR; PG8_SCHED;
            PG8_STAGE(PG8_SB(0, 1), b2 + hstep, voffB);
            PG8_WAIT_V(6); PG8_BAR; PG8_MMA(1, 1, At, B1); PG8_BAR;
            PG8_LDB(B0, 1, 0); PG8_SCHED; PG8_LDA(At, 1, 0); PG8_STAGE(PG8_SA(0, 1), a2 + hstep, voffA);
            PG8_WAIT_L(8); PG8_BAR; PG8_WAIT_L(0); PG8_MMA(0, 0, At, B0); PG8_BAR; PG8_SCHED;
            PG8_LDB(B1, 1, 1); PG8_STAGE(PG8_SB(1, 0), b3, voffB);
            PG8_BAR; PG8_WAIT_L(0); PG8_MMA(0, 1, At, B1); PG8_BAR;
            PG8_LDA(At, 1, 1); PG8_STAGE(PG8_SA(1, 0), a3, voffA);
            PG8_BAR; PG8_WAIT_L(0); PG8_MMA(1, 0, At, B0); PG8_BAR; PG8_SCHED;
            PG8_STAGE(PG8_SB(1, 1), b3 + hstep, voffB);
            PG8_WAIT_V(6); PG8_BAR; PG8_MMA(1, 1, At, B1); PG8_BAR;
            }
        }
        if constexpr (ALIGN_EPI) { if (wr == 0) PG8_BAR; }
        if constexpr (!Epi::AFTER_DRAIN) { E(acc, cur, wr, wc, fr, fq); S.done(cur); }
        if (!has_next) break;
#pragma unroll
        for (int a = 0; a < 2; ++a)
#pragma unroll
            for (int b = 0; b < 2; ++b)
#pragma unroll
                for (int m = 0; m < 4; ++m)
#pragma unroll
                    for (int n = 0; n < 2; ++n) acc[a][b][m][n] = (f32x4){0.f, 0.f, 0.f, 0.f};
        cur = nxt; cA = nA; cB = nB; ++ui;
        if constexpr (ALIGN_EPI) { if (wr == 1) PG8_BAR; }
    }
    PG8_WAIT_V(0);
    if constexpr (!ALIGN_EPI) { if (wr == 0) PG8_BAR; }
    PG8_BAR;
    if constexpr (Epi::AFTER_DRAIN) { E.fused(acc, cur, wr, wc, fr, fq, lds, wid, lane); S.done(cur); }
#undef PG8_SA
#undef PG8_SB
#undef PG8_STAGE
#undef PG8_LDA
#undef PG8_LDB
#undef PG8_MMA
#undef PG8_WAIT_V
#undef PG8_WAIT_L
#undef PG8_BAR
#undef PG8_SCHED
}
}

template <int MODE>
__device__ __forceinline__ void gemm_run(LAS unsigned char* lds, const bf16_t* A, const bf16_t* Bt, int M, int N, int K, const pg8::Epi<MODE>& E, int wv, int G, int bid) {
    pg8::Gemm g{A, Bt, M, N, K}; pg8::StaticOrder S; S.init(M, N, G, bid);
    pg8::gemm_phase<pg8::Epi<MODE>, pg8::StaticOrder, true, true>(lds, g, S, E, wv);
}

__device__ __forceinline__ void transpose_item(const float* W, int ldw, int src_c0, bf16_t* WT, int K, int dst_r0, int k0, LAS float* scr, int lane) {
#pragma unroll 8
    for (int i = 0; i < 32; ++i) { const int kk = 2 * i + (lane >> 5); scr[kk * 33 + (lane & 31)] = W[(size_t)(k0 + kk) * ldw + src_c0 + (lane & 31)]; }
    asm volatile("s_waitcnt lgkmcnt(0)" ::: "memory");
    const int c = lane & 7;
#pragma unroll
    for (int j = 0; j < 4; ++j) { const int n = (lane >> 3) + 8 * j; const LAS float* s = scr + (8 * c) * 33 + n;
        uint4 o; o.x = pkbf(s[0 * 33], s[1 * 33]); o.y = pkbf(s[2 * 33], s[3 * 33]); o.z = pkbf(s[4 * 33], s[5 * 33]); o.w = pkbf(s[6 * 33], s[7 * 33]);
        *(uint4*)(WT + (size_t)(dst_r0 + n) * K + k0 + 8 * c) = o; }
    asm volatile("s_waitcnt lgkmcnt(0)" ::: "memory");
}
__device__ __forceinline__ void convert_layer(const float* const* P, int l, bf16_t* Wb, LAS unsigned char* lds, int wave, int lane, int gw, int NGW) {
    LAS float* scr = (LAS float*)(lds + wave * 16384);
    constexpr int I_IN = 16 * (NZ / 32), I_BR = 4 * 4 * 32, I_SQ = 16 * 32, I_KV = 16 * 64, I_1 = 16 * 128, I_2 = 64 * 32;
    constexpr int NIT = I_IN + I_BR + 3 * I_SQ + I_KV + I_1 + I_2;
    for (int it = gw; it < NIT; it += NGW) {
        int r = it;
        if (r < I_IN) { const int kb = r / (NZ / 32), nb = r % (NZ / 32), n0 = 32 * nb; transpose_item(P[3] + (size_t)l * DM * IN_COLS, IN_COLS, n0 + (n0 >= 640 ? 12 : 0), Wb + WO_IN, DM, n0, 64 * kb, scr, lane); continue; } r -= I_IN;
        if (r < I_BR) { const int m = r >> 7, kb = (r >> 5) & 3, nb = r & 31; transpose_item(P[20] + ((size_t)l * 4 + m) * MW * DM, DM, 32 * nb, Wb + WO_BR + (size_t)m * DM * MW, MW, 32 * nb, 64 * kb, scr, lane); continue; } r -= I_BR;
        if (r < I_SQ) { transpose_item(P[21] + (size_t)l * DM * DM, DM, 32 * (r & 31), Wb + WO_MO, DM, 32 * (r & 31), 64 * (r >> 5), scr, lane); continue; } r -= I_SQ;
        if (r < I_SQ) { transpose_item(P[25] + (size_t)l * DM * DM, DM, 32 * (r & 31), Wb + WO_Q, DM, 32 * (r & 31), 64 * (r >> 5), scr, lane); continue; } r -= I_SQ;
        if (r < I_KV) { transpose_item(P[26] + (size_t)l * DM * 2 * DM, 2 * DM, 32 * (r & 63), Wb + WO_KV, DM, 32 * (r & 63), 64 * (r >> 6), scr, lane); continue; } r -= I_KV;
        if (r < I_SQ) { transpose_item(P[27] + (size_t)l * DM * DM, DM, 32 * (r & 31), Wb + WO_O, DM, 32 * (r & 31), 64 * (r >> 5), scr, lane); continue; } r -= I_SQ;
        if (r < I_1) { transpose_item(P[30] + (size_t)l * DM * DFF, DFF, 32 * (r & 127), Wb + WO_1, DM, 32 * (r & 127), 64 * (r >> 7), scr, lane); continue; } r -= I_1;
        transpose_item(P[31] + (size_t)l * DFF * DM, DM, 32 * (r & 31), Wb + WO_2, DFF, 32 * (r & 31), 64 * (r >> 5), scr, lane);
    }
}

__device__ __forceinline__ void ng_row(const f4 (&v)[4], const LAS float* wng, float* ngo, int lane) {
    float acc[12];
#pragma unroll
    for (int j = 0; j < 12; ++j) { float a = 0.f;
#pragma unroll
        for (int jj = 0; jj < 4; ++jj) { const f4 w = *(const LAS f4*)(wng + j * DM + 4 * lane + 256 * jj); a += v[jj].x * w.x + v[jj].y * w.y + v[jj].z * w.z + v[jj].w * w.w; }
        acc[j] = wsum(a); }
    if (lane == 0) { *(f4*)ngo = (f4){acc[0], acc[1], acc[2], acc[3]}; *(f4*)(ngo + 4) = (f4){acc[4], acc[5], acc[6], acc[7]}; *(f4*)(ngo + 8) = (f4){acc[8], acc[9], acc[10], acc[11]}; }
}
__device__ __forceinline__ void stage_wng(LAS float* wng, const float* w_in_l, int tid) {
    for (int i = tid; i < 12 * DM; i += NT) { const int c = i / 12, j = i % 12; wng[j * DM + c] = w_in_l[(size_t)c * IN_COLS + 640 + j]; }
}
__device__ __forceinline__ void rms_rows(const float* x, const float* g, bf16_t* out, int nrows, const LAS float* wng, float* ng, int gw, int NGW, int lane) {
    for (int m = gw; m < nrows; m += NGW) {
        const f4* xr = (const f4*)(x + (size_t)m * DM) + lane; f4 v[4]; float s = 0.f;
#pragma unroll
        for (int j = 0; j < 4; ++j) { v[j] = xr[64 * j]; s += v[j].x * v[j].x + v[j].y * v[j].y + v[j].z * v[j].z + v[j].w * v[j].w; }
        const float r = 1.f / sqrtf(wsum(s) * (1.f / DM) + 1e-6f);
#pragma unroll
        for (int j = 0; j < 4; ++j) { const f4 gg = ((const f4*)g)[lane + 64 * j]; v[j] = v[j] * r * gg; st4bf(out + (size_t)m * DM + 4 * lane + 256 * j, v[j]); }
        if (ng) ng_row(v, wng, ng + (size_t)m * 12, lane);
    }
}
__device__ __forceinline__ void rowop(const float* xin, const float* y, const float* g1, const float* g2, float* xout, bf16_t* h, const LAS float* wng, float* ng, int gw, int NGW, int lane) {
    for (int m = gw; m < MTOK; m += NGW) {
        const f4* yr = (const f4*)(y + (size_t)m * DM) + lane; const f4* xr = (const f4*)(xin + (size_t)m * DM) + lane; f4 v[4]; float s = 0.f;
#pragma unroll
        for (int j = 0; j < 4; ++j) { v[j] = yr[64 * j]; s += v[j].x * v[j].x + v[j].y * v[j].y + v[j].z * v[j].z + v[j].w * v[j].w; }
        const float r = 1.f / sqrtf(wsum(s) * (1.f / DM) + 1e-6f);
        float s2 = 0.f; f4* xo = (f4*)(xout + (size_t)m * DM) + lane;
#pragma unroll
        for (int j = 0; j < 4; ++j) { const f4 gg = ((const f4*)g1)[lane + 64 * j]; v[j] = xr[64 * j] + v[j] * r * gg; xo[64 * j] = v[j];
            s2 += v[j].x * v[j].x + v[j].y * v[j].y + v[j].z * v[j].z + v[j].w * v[j].w; }
        if (g2) { const float r2 = 1.f / sqrtf(wsum(s2) * (1.f / DM) + 1e-6f);
#pragma unroll
            for (int j = 0; j < 4; ++j) { const f4 gg = ((const f4*)g2)[lane + 64 * j]; v[j] = v[j] * r2 * gg; st4bf(h + (size_t)m * DM + 4 * lane + 256 * j, v[j]); }
            if (ng) ng_row(v, wng, ng + (size_t)m * 12, lane); }
    }
}

__device__ __forceinline__ void nsa_compress_unit(const bf16_t* z, const float* cmp_w_l, const float* pe_l, bf16_t* kc, bf16_t* vct, int u, int lane) {
    const int which = u & 1, bn = u >> 1, b = bn >> 7, n = bn & 127;
    const float* W = cmp_w_l + (size_t)which * 32 * 64 * 64; const int col = which ? C_VC : C_KC;
    float acc = 0.f;
    if (n < NCMP) {
        for (int l = 0; l < 32; ++l) {
            const bf16_t* zr = z + (size_t)(b * SEQ + 16 * n + l) * ZLD + col;
#pragma unroll 8
            for (int d = 0; d < 64; ++d) acc += (bf2f(zr[d]) + pe_l[l * 64 + d]) * W[(l * 64 + d) * 64 + lane];
        }
    }
    const bf16_t r = (bf16_t)(pkbf(acc, 0.f) & 0xffffu);
    if (which) vct[(size_t)(b * 64 + lane) * 128 + n] = r; else kc[(size_t)(b * 128 + n) * 64 + lane] = r;
}
__device__ __forceinline__ void rwkv_prep_token(const bf16_t* zb, float* rw, const float* const* P, int l, int tok, int lane, LAS float* scr) {
    const float* mu = P[8] + l * RWKV_COLS; const float* w0 = P[9] + l * MW; const float* w2 = P[10] + (size_t)l * 32 * MW; const float* a0 = P[11] + l * MW;
    const float* a2 = P[12] + (size_t)l * 32 * MW; const float* g2 = P[13] + (size_t)l * 64 * MW; const float* k_k = P[14] + l * MW; const float* k_a = P[15] + l * MW;
    const int t = tok % SEQ; const bf16_t* z = zb + (size_t)tok * ZLD + C_RW; const bf16_t* zp = z - ZLD;
    f4 rkv[3];
#pragma unroll
    for (int j = 0; j < 3; ++j) { const f4 c = ld4bf(z + j * 256 + 4 * lane); const f4 p = t ? ld4bf(zp + j * 256 + 4 * lane) : (f4){0.f, 0.f, 0.f, 0.f};
        const f4 m = *(const f4*)(mu + j * 256 + 4 * lane); rkv[j] = c + (p - c) * m; }
    if (lane < 32) { const f4 c = ld4bf(z + 768 + 4 * lane); const f4 p = t ? ld4bf(zp + 768 + 4 * lane) : (f4){0.f, 0.f, 0.f, 0.f};
        const f4 m = *(const f4*)(mu + 768 + 4 * lane); f4 v = c + (p - c) * m;
        if (lane < 8) { v.x = tanhf(v.x); v.y = tanhf(v.y); v.z = tanhf(v.z); v.w = tanhf(v.w); }
        else if (lane >= 16) { v.x = sigmoidf_(v.x); v.y = sigmoidf_(v.y); v.z = sigmoidf_(v.z); v.w = sigmoidf_(v.w); }
        *(LAS f4*)(scr + 4 * lane) = v; }
    asm volatile("s_waitcnt lgkmcnt(0)" ::: "memory");
    f4 aw = (f4){0.f, 0.f, 0.f, 0.f}, aa = aw, ag = aw;
#pragma unroll 4
    for (int j = 0; j < 32; ++j) { aw += scr[j] * *(const f4*)(w2 + j * MW + 4 * lane); aa += scr[32 + j] * *(const f4*)(a2 + j * MW + 4 * lane); }
#pragma unroll 4
    for (int j = 0; j < 64; ++j) ag += scr[64 + j] * *(const f4*)(g2 + j * MW + 4 * lane);
    asm volatile("s_waitcnt lgkmcnt(0)" ::: "memory");
    const f4 w0v = *(const f4*)(w0 + 4 * lane), a0v = *(const f4*)(a0 + 4 * lane), kkv = *(const f4*)(k_k + 4 * lane), kav = *(const f4*)(k_a + 4 * lane);
    float dec[4], av[4], kk[4], k2[4]; float ss = 0.f;
#pragma unroll
    for (int i = 0; i < 4; ++i) { const float y = -(w0v[i] + aw[i]); const float sp = (y > 20.f) ? y : log1pf(expf(y)); const float wl = -sp - 0.5f; dec[i] = expf(-expf(wl));
        av[i] = 1.f / (1.f + expf(-(a0v[i] + aa[i]))); kk[i] = rkv[1][i] * kkv[i]; ss += kk[i] * kk[i]; k2[i] = rkv[1][i] * (1.f + (av[i] - 1.f) * kav[i]); }
    ss = gsum16(ss); const float inv = 1.f / fmaxf(sqrtf(ss), 1e-12f);
    float* o = rw + (size_t)tok * 7 * MW + 4 * lane;
    *(f4*)(o) = rkv[0]; *(f4*)(o + MW) = (f4){dec[0], dec[1], dec[2], dec[3]}; *(f4*)(o + 2 * MW) = (f4){k2[0], k2[1], k2[2], k2[3]}; *(f4*)(o + 3 * MW) = rkv[2];
    *(f4*)(o + 4 * MW) = (f4){kk[0] * inv, kk[1] * inv, kk[2] * inv, kk[3] * inv}; *(f4*)(o + 5 * MW) = (f4){kk[0] * inv * av[0], kk[1] * inv * av[1], kk[2] * inv * av[2], kk[3] * inv * av[3]};
    *(f4*)(o + 6 * MW) = ag;
}

__device__ __forceinline__ void rwkv_scan_unit(LAS unsigned char* lds, float* rw, int b, int h, int wv) {
    const int tid = tid_now(wv), row = tid >> 3, cg = tid & 7;
    LAS f4* buf = (LAS f4*)lds;
    LAS float* yb = (LAS float*)(lds + 98304);
    float s[8];
#pragma unroll
    for (int j = 0; j < 8; ++j) s[j] = 0.f;
    f4 pre[6];
#define GSRC(c, k) ((const f4*)(rw + ((size_t)(b * SEQ + (c) * 32 + (tid + 512 * (k)) / 96) * 7 + (((tid + 512 * (k)) % 96) >> 4)) * MW + h * 64 + (((tid + 512 * (k)) % 96) & 15) * 4))
#pragma unroll
    for (int k = 0; k < 6; ++k) pre[k] = *GSRC(0, k);
    __syncthreads();
#pragma unroll
    for (int k = 0; k < 6; ++k) buf[tid + 512 * k] = pre[k];
    __syncthreads();
    for (int c = 0; c < SEQ / 32; ++c) {
        if (c + 1 < SEQ / 32) {
#pragma unroll
            for (int k = 0; k < 6; ++k) pre[k] = *GSRC(c + 1, k);
        }
        const LAS f4* cb = buf + (c & 1) * 3072; LAS float* ybc = yb + (c & 1) * 2048;
        for (int i = 0; i < 32; ++i) {
            const LAS f4* S = cb + i * 96;
            const f4 k0 = S[64 + cg * 2], k1 = S[64 + cg * 2 + 1];
            float d = s[0] * k0.x + s[1] * k0.y + s[2] * k0.z + s[3] * k0.w + s[4] * k1.x + s[5] * k1.y + s[6] * k1.z + s[7] * k1.w;
            d += __shfl_xor(d, 1); d += __shfl_xor(d, 2); d += __shfl_xor(d, 4);
            const float sa = -d, vv = ((const LAS float*)(S + 48))[row];
            const f4 w0 = S[16 + cg * 2], w1 = S[16 + cg * 2 + 1], q0 = S[80 + cg * 2], q1 = S[80 + cg * 2 + 1], kk0 = S[32 + cg * 2], kk1 = S[32 + cg * 2 + 1];
            s[0] = s[0] * w0.x + sa * q0.x + vv * kk0.x; s[1] = s[1] * w0.y + sa * q0.y + vv * kk0.y; s[2] = s[2] * w0.z + sa * q0.z + vv * kk0.z; s[3] = s[3] * w0.w + sa * q0.w + vv * kk0.w;
            s[4] = s[4] * w1.x + sa * q1.x + vv * kk1.x; s[5] = s[5] * w1.y + sa * q1.y + vv * kk1.y; s[6] = s[6] * w1.z + sa * q1.z + vv * kk1.z; s[7] = s[7] * w1.w + sa * q1.w + vv * kk1.w;
            const f4 r0 = S[cg * 2], r1 = S[cg * 2 + 1];
            float y = s[0] * r0.x + s[1] * r0.y + s[2] * r0.z + s[3] * r0.w + s[4] * r1.x + s[5] * r1.y + s[6] * r1.z + s[7] * r1.w;
            y += __shfl_xor(y, 1); y += __shfl_xor(y, 2); y += __shfl_xor(y, 4);
            if (cg == 0) ybc[i * 64 + row] = y;
        }
        if (c + 1 < SEQ / 32) {
#pragma unroll
            for (int k = 0; k < 6; ++k) buf[((c + 1) & 1) * 3072 + tid + 512 * k] = pre[k];
        }
        __syncthreads();
        { const int i = tid >> 4, q = tid & 15; *(f4*)(rw + ((size_t)(b * SEQ + c * 32 + i) * 7 + 5) * MW + h * 64 + q * 4) = *(const LAS f4*)(ybc + i * 64 + q * 4); }
    }
    __syncthreads();
#undef GSRC
}
__device__ __forceinline__ void rwkv_fin_token(const float* rw, bf16_t* o_rwkv, const float* r_k, const float* ln_g, const float* ln_b, int tok, int lane) {
    const float* p = rw + (size_t)tok * 7 * MW + 4 * lane;
    const f4 r = *(const f4*)p, k2 = *(const f4*)(p + 2 * MW), v = *(const f4*)(p + 3 * MW), y = *(const f4*)(p + 5 * MW), g = *(const f4*)(p + 6 * MW);
    const f4 rk = *(const f4*)(r_k + 4 * lane), lg = *(const f4*)(ln_g + 4 * lane), lb = *(const f4*)(ln_b + 4 * lane);
    const float mu = gsum16(y.x + y.y + y.z + y.w) * (1.f / 64.f); const f4 yc = y - mu;
    const float var = gsum16(yc.x * yc.x + yc.y * yc.y + yc.z * yc.z + yc.w * yc.w) * (1.f / 64.f); const float rs = 1.f / sqrtf(var + 64e-5f);
    const float bonus = gsum16(r.x * k2.x * rk.x + r.y * k2.y * rk.y + r.z * k2.z * rk.z + r.w * k2.w * rk.w);
    st4bf(o_rwkv + (size_t)tok * MW + 4 * lane, (yc * rs * lg + lb + bonus * v) * g);
}

constexpr int T_LD = 144;
constexpr int T_BYTES = 64 * T_LD;
__device__ __forceinline__ void tile_load(u32x4_t& kr, u32x4_t& vr, const bf16_t* ksrc, const bf16_t* vsrc, int ld, int tid, int wv) {
    kr = *(const u32x4_t*)(ksrc + (size_t)(tid >> 3) * ld + (tid & 7) * 8);
    vr = *(const u32x4_t*)(vsrc + (size_t)(tid & 63) * ld + wv * 8);
}
__device__ __forceinline__ void tile_store(LAS unsigned char* KL, LAS unsigned char* VL, const u32x4_t& kr, const u32x4_t& vr, int tid, int wv) {
    *(LAS u32x4_t*)(KL + (tid >> 3) * T_LD + (tid & 7) * 16) = kr;
    LAS unsigned short* vp = (LAS unsigned short*)(VL + (wv * 8) * T_LD + (tid & 63) * 2);
#pragma unroll
    for (int e = 0; e < 4; ++e) { vp[(2 * e) * (T_LD / 2)] = (unsigned short)(vr[e] & 0xffffu); vp[(2 * e + 1) * (T_LD / 2)] = (unsigned short)(vr[e] >> 16); }
}
__device__ __forceinline__ void st_tile(f32x16_t& s0, f32x16_t& s1, const LAS unsigned char* KL, const bf16x8_t (&qf)[4], int c, int hi) {
#pragma unroll
    for (int i = 0; i < 16; ++i) { s0[i] = 0.f; s1[i] = 0.f; }
#pragma unroll
    for (int ks = 0; ks < 4; ++ks) { const bf16x8_t k0 = *(const LAS bf16x8_t*)(KL + c * T_LD + ks * 32 + hi * 16), k1 = *(const LAS bf16x8_t*)(KL + (32 + c) * T_LD + ks * 32 + hi * 16);
        s0 = MFMA32(k0, qf[ks], s0); s1 = MFMA32(k1, qf[ks], s1); }
}
__device__ __forceinline__ void pv_tile(f32x16_t& o0, f32x16_t& o1, const LAS unsigned char* VL, const f32x16_t& p0, const f32x16_t& p1, int c, int hi) {
#pragma unroll
    for (int j4 = 0; j4 < 4; ++j4) {
        u32x4_t pw;
        if (j4 < 2) { pw[0] = cvtpk(p0[8 * j4], p0[8 * j4 + 1]); pw[1] = cvtpk(p0[8 * j4 + 2], p0[8 * j4 + 3]); pw[2] = cvtpk(p0[8 * j4 + 4], p0[8 * j4 + 5]); pw[3] = cvtpk(p0[8 * j4 + 6], p0[8 * j4 + 7]); }
        else { const int jj = j4 - 2; pw[0] = cvtpk(p1[8 * jj], p1[8 * jj + 1]); pw[1] = cvtpk(p1[8 * jj + 2], p1[8 * jj + 3]); pw[2] = cvtpk(p1[8 * jj + 4], p1[8 * jj + 5]); pw[3] = cvtpk(p1[8 * jj + 6], p1[8 * jj + 7]); }
        const bf16x8_t pf = __builtin_bit_cast(bf16x8_t, pw);
        const LAS unsigned char* v0 = VL + c * T_LD + (16 * j4 + 4 * hi) * 2; const LAS unsigned char* v1 = VL + (32 + c) * T_LD + (16 * j4 + 4 * hi) * 2;
        u32x4_t a0, a1; { const u32x2_t x = *(const LAS u32x2_t*)v0, y = *(const LAS u32x2_t*)(v0 + 16); a0[0] = x[0]; a0[1] = x[1]; a0[2] = y[0]; a0[3] = y[1]; }
        { const u32x2_t x = *(const LAS u32x2_t*)v1, y = *(const LAS u32x2_t*)(v1 + 16); a1[0] = x[0]; a1[1] = x[1]; a1[2] = y[0]; a1[3] = y[1]; }
        o0 = MFMA32(__builtin_bit_cast(bf16x8_t, a0), pf, o0); o1 = MFMA32(__builtin_bit_cast(bf16x8_t, a1), pf, o1);
    }
}

constexpr int NSA_KT = 0, NSA_VT = 2 * T_BYTES, NSA_KC = 4 * T_BYTES, NSA_VCT = NSA_KC + 128 * T_LD, VC_LD = 272, NSA_BD = NSA_VCT + 64 * VC_LD, NSA_IMP = NSA_BD + 2048, NSA_UNI = NSA_IMP + 32768;
template <bool SPECIAL>
__device__ __forceinline__ void nsa_tile(const LAS unsigned char* KL, const LAS unsigned char* VL, const bf16x8_t (&qf)[4], const LAS float* bd, float cfar, int t, int key0, int wlim, bool on,
                                         float& mrun, float& lrun, f32x16_t& o0, f32x16_t& o1, int c, int hi) {
    constexpr float C2 = 0.125f * 1.4426950408889634f; const float NEG = -__builtin_inff();
    f32x16_t s0, s1; st_tile(s0, s1, KL, qf, c, hi);
    float tmax = NEG;
    if (SPECIAL) {
#pragma unroll
        for (int i = 0; i < 16; ++i) { const int d0 = t - (key0 + (i & 3) + 8 * (i >> 2) + 4 * hi), d1 = d0 - 32;
            const int i0 = d0 < 0 ? 0 : (d0 < 127 ? d0 : 127), i1 = d1 < 0 ? 0 : (d1 < 127 ? d1 : 127);
            s0[i] = (on && d0 >= 0 && d0 < wlim) ? s0[i] * C2 + bd[i0] : NEG; s1[i] = (on && d1 >= 0 && d1 < wlim) ? s1[i] * C2 + bd[i1] : NEG;
            tmax = fmaxf(tmax, fmaxf(s0[i], s1[i])); }
    } else {
#pragma unroll
        for (int i = 0; i < 16; ++i) { s0[i] = on ? s0[i] * C2 + cfar : NEG; s1[i] = on ? s1[i] * C2 + cfar : NEG; tmax = fmaxf(tmax, fmaxf(s0[i], s1[i])); }
    }
    tmax = fmaxf(tmax, xhalf(tmax));
    const float mn = fmaxf(mrun, tmax), alpha = __builtin_amdgcn_exp2f(mrun - mn); mrun = mn;
    float ps = 0.f;
#pragma unroll
    for (int i = 0; i < 16; ++i) { s0[i] = __builtin_amdgcn_exp2f(s0[i] - mn); s1[i] = __builtin_amdgcn_exp2f(s1[i] - mn); ps += s0[i] + s1[i]; }
    lrun = lrun * alpha + ps;
    o0 *= alpha; o1 *= alpha;
    pv_tile(o0, o1, VL, s0, s1, c, hi);
}
__device__ __forceinline__ void nsa_unit(LAS unsigned char* lds, const bf16_t* z, const float* ngl, const bf16_t* kcg, const bf16_t* vctg, const float* biasd_g, bf16_t* o_nsa, int b, int qt, int wv) {
    const int tid = tid_now(wv), lane = tid & 63, c = lane & 31, hi = lane >> 5, h = wv & 3, th = wv >> 2;
    const int t = 64 * qt + 32 * th + c; const size_t row = (size_t)b * SEQ + t;
    LAS unsigned char* KC = lds + NSA_KC; LAS unsigned char* VCT = lds + NSA_VCT; LAS float* BD = (LAS float*)(lds + NSA_BD); LAS float* IMPH = (LAS float*)(lds + NSA_IMP); LAS unsigned* UNI = (LAS unsigned*)(lds + NSA_UNI);
    constexpr float C2 = 0.125f * 1.4426950408889634f, L2E = 1.4426950408889634f; const float NEG = -__builtin_inff();
    __syncthreads();
#pragma unroll
    for (int k = 0; k < 2; ++k) { const int idx = tid + 512 * k; *(LAS u32x4_t*)(KC + (idx >> 3) * T_LD + (idx & 7) * 16) = *(const u32x4_t*)(kcg + (size_t)b * 128 * 64 + idx * 8);
        *(LAS u32x4_t*)(VCT + (idx >> 4) * VC_LD + (idx & 15) * 16) = *(const u32x4_t*)(vctg + (size_t)b * 64 * 128 + idx * 8); }
    BD[tid] = biasd_g[tid] * L2E;
    bf16x8_t qf[4];
    { const bf16_t* qr = z + row * ZLD + C_Q + h * 64 + 8 * hi;
#pragma unroll
        for (int ks = 0; ks < 4; ++ks) qf[ks] = *(const bf16x8_t*)(qr + 16 * ks); }
    const float* gp = ngl + row * 12 + h * 3; const float g0 = sigmoidf_(gp[0]), g1 = sigmoidf_(gp[1]), g2 = sigmoidf_(gp[2]);
    __syncthreads();
    const LAS float* bd = BD + h * 128; const float cfar = bd[127];
    f32x16_t out0, out1;
    {
        const int nv = (t >= 31) ? ((t - 31) >> 4) + 1 : 0;
        f32x16_t s[4];
#pragma unroll
        for (int kb = 0; kb < 4; ++kb) {
#pragma unroll
            for (int i = 0; i < 16; ++i) s[kb][i] = 0.f;
#pragma unroll
            for (int ks = 0; ks < 4; ++ks) s[kb] = MFMA32(*(const LAS bf16x8_t*)(KC + (32 * kb + c) * T_LD + ks * 32 + hi * 16), qf[ks], s[kb]); }
        float m = -1e30f;
#pragma unroll
        for (int kb = 0; kb < 4; ++kb)
#pragma unroll
            for (int i = 0; i < 16; ++i) { const int n = 32 * kb + (i & 3) + 8 * (i >> 2) + 4 * hi, dd = t - (16 * n + 31); const int di = dd < 0 ? 0 : (dd < 127 ? dd : 127);
                s[kb][i] = (n < nv) ? s[kb][i] * C2 + bd[di] : NEG; m = fmaxf(m, s[kb][i]); }
        m = fmaxf(m, xhalf(m));
        float l = 0.f;
#pragma unroll
        for (int kb = 0; kb < 4; ++kb)
#pragma unroll
            for (int i = 0; i < 16; ++i) { s[kb][i] = __builtin_amdgcn_exp2f(s[kb][i] - m); l += s[kb][i]; }
        l += xhalf(l); const float inv = (l > 0.f) ? 1.f / l : 0.f;
#pragma unroll
        for (int kb = 0; kb < 4; ++kb) s[kb] *= inv;
        float part[16], cr[16];
#pragma unroll
        for (int kb = 0; kb < 4; ++kb)
#pragma unroll
            for (int a = 0; a < 4; ++a) { part[kb * 4 + a] = s[kb][4 * a] + s[kb][4 * a + 1] + s[kb][4 * a + 2] + 0.5f * s[kb][4 * a + 3]; cr[kb * 4 + a] = 0.5f * s[kb][4 * a + 3]; }
        { float prev = 0.f;
#pragma unroll
            for (int sl = 0; sl < 16; ++sl) { const float xc = xhalf(cr[sl]); part[sl] += hi ? xc : prev; prev = xc; } }
        { LAS float* ip = IMPH + (h * 64 + 32 * th + c) * 32 + hi;
#pragma unroll
            for (int sl = 0; sl < 16; ++sl) ip[2 * sl] = part[sl]; }
#pragma unroll
        for (int i = 0; i < 16; ++i) { out0[i] = 0.f; out1[i] = 0.f; }
#pragma unroll
        for (int j8 = 0; j8 < 8; ++j8) { const f32x16_t& pp = s[j8 >> 1]; const int jj = j8 & 1; u32x4_t pw;
            pw[0] = cvtpk(pp[8 * jj], pp[8 * jj + 1]); pw[1] = cvtpk(pp[8 * jj + 2], pp[8 * jj + 3]); pw[2] = cvtpk(pp[8 * jj + 4], pp[8 * jj + 5]); pw[3] = cvtpk(pp[8 * jj + 6], pp[8 * jj + 7]);
            const bf16x8_t pf = __builtin_bit_cast(bf16x8_t, pw);
            const LAS unsigned char* v0 = VCT + c * VC_LD + (16 * j8 + 4 * hi) * 2; const LAS unsigned char* v1 = VCT + (32 + c) * VC_LD + (16 * j8 + 4 * hi) * 2;
            u32x4_t a0, a1; { const u32x2_t x = *(const LAS u32x2_t*)v0, y = *(const LAS u32x2_t*)(v0 + 16); a0[0] = x[0]; a0[1] = x[1]; a0[2] = y[0]; a0[3] = y[1]; }
            { const u32x2_t x = *(const LAS u32x2_t*)v1, y = *(const LAS u32x2_t*)(v1 + 16); a1[0] = x[0]; a1[1] = x[1]; a1[2] = y[0]; a1[3] = y[1]; }
            out0 = MFMA32(__builtin_bit_cast(bf16x8_t, a0), pf, out0); out1 = MFMA32(__builtin_bit_cast(bf16x8_t, a1), pf, out1); }
        out0 *= g0; out1 *= g0;
    }
    __syncthreads();
    unsigned sel = 0u;
    {
        float v[16];
        const LAS float* ip = IMPH + (32 * th + c) * 32 + 16 * hi;
#pragma unroll
        for (int j = 0; j < 16; ++j) { const int mb = 16 * hi + j; float x = ((ip[j] + ip[64 * 32 + j]) + ip[2 * 64 * 32 + j]) + ip[3 * 64 * 32 + j];
            if (mb == 0 || mb == qt || mb == qt - 1) x += 1e4f; v[j] = (mb <= qt) ? x : NEG; }
        for (int r = 0; r < 8; ++r) {
            float best = NEG; int bi = 0;
#pragma unroll
            for (int j = 0; j < 16; ++j) if (v[j] > best) { best = v[j]; bi = j; }
            const float ob = xhalf(best); const int oi = __shfl_xor(bi, 32);
            const float lowv = hi ? ob : best, highv = hi ? best : ob; const int lowi = hi ? oi : bi, highi = (hi ? bi : oi) + 16;
            const bool lowwin = lowv >= highv; const float wval = lowwin ? lowv : highv; const int widx = lowwin ? lowi : highi;
            if (wval > NEG) { sel |= 1u << widx;
#pragma unroll
                for (int j = 0; j < 16; ++j) if (16 * hi + j == widx) v[j] = NEG; }
        }
        unsigned uni = 0u;
        for (int mb = 0; mb <= qt; ++mb) if (__ballot((sel >> mb) & 1u) != 0ull) uni |= 1u << mb;
        if (h == 0 && lane == 0) UNI[th] = uni;
    }
    __syncthreads();
    const unsigned uni = UNI[0] | UNI[1];
    const bf16_t* zb = z + (size_t)b * SEQ * ZLD;
    u32x4_t kr, vr;
    {
        float mrun = -1e30f, lrun = 0.f; f32x16_t o0, o1;
#pragma unroll
        for (int i = 0; i < 16; ++i) { o0[i] = 0.f; o1[i] = 0.f; }
        unsigned rem = uni; int blk = __builtin_ctz(rem); rem &= rem - 1u;
        tile_load(kr, vr, zb + (size_t)blk * 64 * ZLD + C_KS, zb + (size_t)blk * 64 * ZLD + C_VS, ZLD, tid, wv);
        tile_store(lds + NSA_KT, lds + NSA_VT, kr, vr, tid, wv);
        __syncthreads();
        for (int it = 0;; ++it) {
            const bool nxt = rem != 0u; const int nb = nxt ? __builtin_ctz(rem) : 0; rem &= rem - 1u;
            if (nxt) tile_load(kr, vr, zb + (size_t)nb * 64 * ZLD + C_KS, zb + (size_t)nb * 64 * ZLD + C_VS, ZLD, tid, wv);
            const LAS unsigned char* KL = lds + NSA_KT + (it & 1) * T_BYTES; const LAS unsigned char* VL = lds + NSA_VT + (it & 1) * T_BYTES;
            const bool on = (sel >> blk) & 1u;
            if (qt - blk <= 2) nsa_tile<true>(KL, VL, qf, bd, cfar, t, 64 * blk, 1 << 30, on, mrun, lrun, o0, o1, c, hi);
            else nsa_tile<false>(KL, VL, qf, bd, cfar, t, 64 * blk, 1 << 30, on, mrun, lrun, o0, o1, c, hi);
            if (nxt) tile_store(lds + NSA_KT + ((it + 1) & 1) * T_BYTES, lds + NSA_VT + ((it + 1) & 1) * T_BYTES, kr, vr, tid, wv);
            __syncthreads();
            if (!nxt) break;
            blk = nb;
        }
        lrun += xhalf(lrun); const float sc = g1 / lrun;
        out0 += o0 * sc; out1 += o1 * sc;
    }
    {
        float mrun = -1e30f, lrun = 0.f; f32x16_t o0, o1;
#pragma unroll
        for (int i = 0; i < 16; ++i) { o0[i] = 0.f; o1[i] = 0.f; }
        const int tb0 = qt >= 8 ? qt - 8 : 0;
        tile_load(kr, vr, zb + (size_t)tb0 * 64 * ZLD + C_KW, zb + (size_t)tb0 * 64 * ZLD + C_VW, ZLD, tid, wv);
        tile_store(lds + NSA_KT, lds + NSA_VT, kr, vr, tid, wv);
        __syncthreads();
        for (int tb = tb0; tb <= qt; ++tb) {
            const int it = tb - tb0; const bool nxt = tb < qt;
            if (nxt) tile_load(kr, vr, zb + (size_t)(tb + 1) * 64 * ZLD + C_KW, zb + (size_t)(tb + 1) * 64 * ZLD + C_VW, ZLD, tid, wv);
            const LAS unsigned char* KL = lds + NSA_KT + (it & 1) * T_BYTES; const LAS unsigned char* VL = lds + NSA_VT + (it & 1) * T_BYTES;
            if (qt - tb <= 2 || qt - tb == 8) nsa_tile<true>(KL, VL, qf, bd, cfar, t, 64 * tb, 512, true, mrun, lrun, o0, o1, c, hi);
            else nsa_tile<false>(KL, VL, qf, bd, cfar, t, 64 * tb, 512, true, mrun, lrun, o0, o1, c, hi);
            if (nxt) tile_store(lds + NSA_KT + ((it + 1) & 1) * T_BYTES, lds + NSA_VT + ((it + 1) & 1) * T_BYTES, kr, vr, tid, wv);
            __syncthreads();
        }
        lrun += xhalf(lrun); const float sc = g2 / lrun;
        out0 += o0 * sc; out1 += o1 * sc;
    }
    bf16_t* op = o_nsa + row * MW + h * 64;
#pragma unroll
    for (int a = 0; a < 4; ++a) { u32x2_t u0, u1; u0[0] = cvtpk(out0[4 * a], out0[4 * a + 1]); u0[1] = cvtpk(out0[4 * a + 2], out0[4 * a + 3]); u1[0] = cvtpk(out1[4 * a], out1[4 * a + 1]); u1[1] = cvtpk(out1[4 * a + 2], out1[4 * a + 3]);
        *(u32x2_t*)(op + 8 * a + 4 * hi) = u0; *(u32x2_t*)(op + 32 + 8 * a + 4 * hi) = u1; }
}

__device__ __forceinline__ void ret_unit(LAS unsigned char* lds, const bf16_t* z, const float* norm_g, bf16_t* o_ret, int b, int h, int q8, int wv) {
    const int tid = tid_now(wv), lane = tid & 63, c = lane & 31, hi = lane >> 5, w = wv;
    const int t = 256 * q8 + 32 * w + c; const size_t row = (size_t)b * SEQ + t;
    const int ntiles = 4 * q8 + 4, ktd = 4 * q8 + (w >> 1);
    const float lg2 = log2f(1.f - exp2f(-5.f - (float)h));
    bf16x8_t qf[4];
    { const bf16_t* qr = z + row * ZLD + C_RQ + h * 64 + 8 * hi;
#pragma unroll
        for (int ks = 0; ks < 4; ++ks) qf[ks] = *(const bf16x8_t*)(qr + 16 * ks); }
    f32x16_t bc0, bc1, o0, o1;
#pragma unroll
    for (int i = 0; i < 16; ++i) { const int j = (i & 3) + 8 * (i >> 2) + 4 * hi; bc0[i] = exp2f((float)(63 - j) * lg2); bc1[i] = exp2f((float)(31 - j) * lg2); o0[i] = 0.f; o1[i] = 0.f; }
    const float g64 = exp2f(64.f * lg2);
    const bf16_t* kbase = z + (size_t)b * SEQ * ZLD + C_RK + h * 64; const bf16_t* vbase = z + (size_t)b * SEQ * ZLD + C_RV + h * 64;
    u32x4_t kr, vr;
    __syncthreads();
    tile_load(kr, vr, kbase, vbase, ZLD, tid, wv);
    tile_store(lds, lds + 2 * T_BYTES, kr, vr, tid, wv);
    __syncthreads();
    for (int kt = 0; kt < ntiles; ++kt) {
        const bool nxt = kt + 1 < ntiles;
        if (nxt) tile_load(kr, vr, kbase + (size_t)(kt + 1) * 64 * ZLD, vbase + (size_t)(kt + 1) * 64 * ZLD, ZLD, tid, wv);
        if (kt <= ktd) {
            const LAS unsigned char* KL = lds + (kt & 1) * T_BYTES; const LAS unsigned char* VL = lds + (2 + (kt & 1)) * T_BYTES;
            f32x16_t s0, s1; st_tile(s0, s1, KL, qf, c, hi);
            s0 *= bc0; s1 *= bc1;
            if (kt == ktd) {
#pragma unroll
                for (int i = 0; i < 16; ++i) { const int key = 64 * kt + (i & 3) + 8 * (i >> 2) + 4 * hi; if (key > t) s0[i] = 0.f; if (key + 32 > t) s1[i] = 0.f; } }
            o0 *= g64; o1 *= g64;
            pv_tile(o0, o1, VL, s0, s1, c, hi);
        }
        if (nxt) tile_store(lds + ((kt + 1) & 1) * T_BYTES, lds + (2 + ((kt + 1) & 1)) * T_BYTES, kr, vr, tid, wv);
        __syncthreads();
    }
    const float fin = exp2f((float)(t - 64 * ktd - 63) * lg2);
    o0 *= fin; o1 *= fin;
    float sm = 0.f;
#pragma unroll
    for (int i = 0; i < 16; ++i) sm += o0[i] + o1[i];
    sm += xhalf(sm); const float mu = sm * (1.f / 64.f);
    float var = 0.f;
#pragma unroll
    for (int i = 0; i < 16; ++i) { o0[i] -= mu; o1[i] -= mu; var += o0[i] * o0[i] + o1[i] * o1[i]; }
    var += xhalf(var); const float rs = 1.f / sqrtf(var * (1.f / 64.f) + 1e-5f);
    const bf16_t* gr = z + row * ZLD + C_RG + h * 64; bf16_t* op = o_ret + row * MW + h * 64;
#pragma unroll
    for (int db = 0; db < 2; ++db)
#pragma unroll
        for (int a = 0; a < 4; ++a) { const int d = 32 * db + 8 * a + 4 * hi; const f4 g = ld4bf(gr + d), ng = *(const f4*)(norm_g + h * 64 + d); f4 v;
            const f32x16_t& oo = db ? o1 : o0;
            v.x = g.x * sigmoidf_(g.x) * oo[4 * a] * rs * ng.x; v.y = g.y * sigmoidf_(g.y) * oo[4 * a + 1] * rs * ng.y; v.z = g.z * sigmoidf_(g.z) * oo[4 * a + 2] * rs * ng.z; v.w = g.w * sigmoidf_(g.w) * oo[4 * a + 3] * rs * ng.w;
            st4bf(op + d, v); }
}

constexpr int XA_LD = 528;
__device__ __forceinline__ void xattn_unit(LAS unsigned char* lds, const bf16_t* Q, const bf16_t* Kx, const bf16_t* VT, bf16_t* O, int b, int hh, int qt, int wv) {
    const int tid = tid_now(wv), lane = tid & 63, c = lane & 31, hi = lane >> 5, w = wv;
    LAS unsigned char* QL = lds; LAS unsigned char* PL = lds + 64 * XA_LD; LAS float* RMAX = (LAS float*)(lds + 2 * 64 * XA_LD); LAS float* RSUM = RMAX + 512;
    const size_t tok0 = (size_t)b * SEQ + qt * 64;
    __syncthreads();
#pragma unroll
    for (int k = 0; k < 4; ++k) { const int idx = tid + 512 * k, r = idx >> 5, ch = idx & 31; *(LAS u32x4_t*)(QL + r * XA_LD + ch * 16) = *(const u32x4_t*)(Q + (tok0 + r) * DM + hh * 256 + ch * 8); }
    bf16x8_t af[16];
    { const bf16_t* kr = Kx + (size_t)(b * MEMLEN + 32 * w + c) * DM + hh * 256 + 8 * hi;
#pragma unroll
        for (int ks = 0; ks < 16; ++ks) af[ks] = *(const bf16x8_t*)(kr + 16 * ks); }
    __syncthreads();
    f32x16_t s0, s1;
#pragma unroll
    for (int i = 0; i < 16; ++i) { s0[i] = 0.f; s1[i] = 0.f; }
#pragma unroll
    for (int ks = 0; ks < 16; ++ks) { const bf16x8_t q0 = *(const LAS bf16x8_t*)(QL + c * XA_LD + ks * 32 + hi * 16), q1 = *(const LAS bf16x8_t*)(QL + (32 + c) * XA_LD + ks * 32 + hi * 16);
        s0 = MFMA32(af[ks], q0, s0); s1 = MFMA32(af[ks], q1, s1); }
    constexpr float C2 = 0.0625f * 1.4426950408889634f;
    float m0 = s0[0], m1 = s1[0];
#pragma unroll
    for (int i = 1; i < 16; ++i) { m0 = fmaxf(m0, s0[i]); m1 = fmaxf(m1, s1[i]); }
    m0 = fmaxf(m0, xhalf(m0)); m1 = fmaxf(m1, xhalf(m1));
    if (hi == 0) { RMAX[w * 64 + c] = m0; RMAX[w * 64 + 32 + c] = m1; }
    __syncthreads();
    float g0 = RMAX[c], g1 = RMAX[32 + c];
#pragma unroll
    for (int ww = 1; ww < 8; ++ww) { g0 = fmaxf(g0, RMAX[ww * 64 + c]); g1 = fmaxf(g1, RMAX[ww * 64 + 32 + c]); }
    float l0 = 0.f, l1 = 0.f;
#pragma unroll
    for (int i = 0; i < 16; ++i) { s0[i] = __builtin_amdgcn_exp2f((s0[i] - g0) * C2); s1[i] = __builtin_amdgcn_exp2f((s1[i] - g1) * C2); l0 += s0[i]; l1 += s1[i]; }
    l0 += xhalf(l0); l1 += xhalf(l1);
    if (hi == 0) { RSUM[w * 64 + c] = l0; RSUM[w * 64 + 32 + c] = l1; }
#pragma unroll
    for (int a = 0; a < 4; ++a) { u32x2_t u0, u1; u0.x = cvtpk(s0[4 * a], s0[4 * a + 1]); u0.y = cvtpk(s0[4 * a + 2], s0[4 * a + 3]); u1.x = cvtpk(s1[4 * a], s1[4 * a + 1]); u1.y = cvtpk(s1[4 * a + 2], s1[4 * a + 3]);
        *(LAS u32x2_t*)(PL + c * XA_LD + (32 * w + 8 * a + 4 * hi) * 2) = u0; *(LAS u32x2_t*)(PL + (32 + c) * XA_LD + (32 * w + 8 * a + 4 * hi) * 2) = u1; }
    { const bf16_t* vr = VT + (size_t)(hh * 256 + 32 * w + c) * (BATCH * MEMLEN) + b * MEMLEN + 8 * hi;
#pragma unroll
        for (int j = 0; j < 16; ++j) af[j] = *(const bf16x8_t*)(vr + 16 * j); }
    __syncthreads();
    float t0 = RSUM[c], t1 = RSUM[32 + c];
#pragma unroll
    for (int ww = 1; ww < 8; ++ww) { t0 += RSUM[ww * 64 + c]; t1 += RSUM[ww * 64 + 32 + c]; }
#pragma unroll
    for (int i = 0; i < 16; ++i) { s0[i] = 0.f; s1[i] = 0.f; }
#pragma unroll
    for (int j = 0; j < 16; ++j) { const bf16x8_t p0 = *(const LAS bf16x8_t*)(PL + c * XA_LD + j * 32 + hi * 16), p1 = *(const LAS bf16x8_t*)(PL + (32 + c) * XA_LD + j * 32 + hi * 16);
        s0 = MFMA32(af[j], p0, s0); s1 = MFMA32(af[j], p1, s1); }
    const float i0 = 1.f / t0, i1 = 1.f / t1;
#pragma unroll
    for (int a = 0; a < 4; ++a) { u32x2_t u0, u1; u0.x = cvtpk(s0[4 * a] * i0, s0[4 * a + 1] * i0); u0.y = cvtpk(s0[4 * a + 2] * i0, s0[4 * a + 3] * i0); u1.x = cvtpk(s1[4 * a] * i1, s1[4 * a + 1] * i1); u1.y = cvtpk(s1[4 * a + 2] * i1, s1[4 * a + 3] * i1);
        *(u32x2_t*)(O + (tok0 + c) * DM + hh * 256 + 32 * w + 8 * a + 4 * hi) = u0; *(u32x2_t*)(O + (tok0 + 32 + c) * DM + hh * 256 + 32 * w + 8 * a + 4 * hi) = u1; }
}

constexpr int NPL = 14, NPHASES = 1 + DEPTH * NPL;
typedef const __attribute__((address_space(4))) unsigned char* kaptr_t;
#define PHASE_ENV \
    kaptr_t ka_ = (kaptr_t)__builtin_amdgcn_kernarg_segment_ptr(); asm volatile("" : "+s"(ka_)); \
    const float* const* P = (const float* const*)ka_; float* const OUT = (float*)P[33]; unsigned char* const ws = (unsigned char*)P[34]; (void)OUT; (void)ws; \
    int G = G0, bid = (int)blockIdx.x, wv = wv0; asm volatile("" : "+s"(G), "+s"(bid), "+s"(wv)); const int NGW = G * NWAVES, NGT = G * NT; (void)NGW; (void)NGT; \
    const int tid = tid_now(wv), lane = tid & 63, wave = wv, gw = bid * NWAVES + wave, gt = bid * NT + tid; (void)lane; (void)gw; (void)gt; \
    LAS unsigned char* lds = lds0; asm volatile("" : "+s"(lds));
#define WSF(off) ((float*)(ws + (off)))
#define WSB(off) ((bf16_t*)(ws + (off)))
#define IN(k) (lo <= (k) && (k) < hi)
#if MK_PER_PHASE
#define SEAM() do { } while (0)
#else
#define SEAM() do { XcdBarrier b_ = bar; asm volatile("" : "+s"(b_.bar), "+s"(b_.x), "+s"(b_.st), "+s"(b_.wv)); xcd_barrier(b_); } while (0)
#endif
template <int l>
__device__ __forceinline__ void layer_phases(LAS unsigned char* const lds0, const int G0, const int wv0, const int lo, const int hi, const XcdBarrier& bar) {
        const int pb = 1 + l * NPL;
        if (IN(pb + 0)) { PHASE_ENV pg8::Epi<1> E{WSB(WS_Z), ZLD, WSB(WS_ZG), nullptr, nullptr, 0}; gemm_run<1>(lds, WSB(WS_H), WSB(WS_W) + WO_IN, MTOK, NZ, DM, E, wv, G, bid); SEAM(); }
        if (IN(pb + 1)) {
            PHASE_ENV
            bf16_t* Z = WSB(WS_Z); float* TABC = WSF(WS_TAB); float* TABS = TABC + 65536;
            for (int u = gw; u < BATCH * 128 * 2; u += NGW) nsa_compress_unit(Z, P[4] + (size_t)l * 2 * 32 * 64 * 64, P[5] + (size_t)l * 32 * 64, WSB(WS_CMP), WSB(WS_CMP) + BATCH * 128 * 64, u, lane);
            { LAS float* scr = (LAS float*)lds + wave * 128; float* RW = WSF(WS_RW); for (int tok = gw; tok < MTOK; tok += NGW) rwkv_prep_token(Z, RW, P, l, tok, lane, scr); }
            { const float* cw = P[19] + (size_t)l * 3 * MW; bf16_t* oc = WSB(WS_BR) + (size_t)3 * MTOK * MW;
                for (int i = gt; i < MTOK * 64; i += NGT) { const int tok = i >> 6, c4 = (i & 63) * 4, t = tok % SEQ; const bf16_t* z = Z + (size_t)tok * ZLD;
                    const f4 bg = ld4bf(z + C_CB + c4); f4 u2 = ld4bf(z + C_CC + c4) * ld4bf(z + C_CX + c4);
                    f4 u1 = (f4){0.f, 0.f, 0.f, 0.f}, u0 = u1; if (t >= 1) u1 = ld4bf(z - ZLD + C_CC + c4) * ld4bf(z - ZLD + C_CX + c4); if (t >= 2) u0 = ld4bf(z - 2 * ZLD + C_CC + c4) * ld4bf(z - 2 * ZLD + C_CX + c4);
                    st4bf(oc + (size_t)tok * MW + c4, bg * (*(const f4*)(cw + c4) * u0 + *(const f4*)(cw + MW + c4) * u1 + *(const f4*)(cw + 2 * MW + c4) * u2)); } }
            for (int i = gt; i < MTOK * 2 * 4 * 32; i += NGT) { const int j = i & 31, h = (i >> 5) & 3, qk = (i >> 7) & 1, tok = i >> 8, t = tok % SEQ;
                bf16_t* p = Z + (size_t)tok * ZLD + (qk ? C_RK : C_RQ) + h * 64 + j; const float c = TABC[t * 32 + j], s = TABS[t * 32 + j], u1 = bf2f(p[0]), u2 = bf2f(p[32]), sc = qk ? 1.f : 0.125f;
                const unsigned a = pkbf((u1 * c - u2 * s) * sc, (u2 * c + u1 * s) * sc); p[0] = (bf16_t)(a & 0xffffu); p[32] = (bf16_t)(a >> 16); }
            SEAM();
        }
        if (IN(pb + 2)) {
            PHASE_ENV
            for (int u = bid; u < 32 + 256 + 256; u += G) {
                if (u < 32) rwkv_scan_unit(lds, WSF(WS_RW), u >> 2, u & 3, wv);
                else if (u < 288) nsa_unit(lds, WSB(WS_Z), WSF(WS_NG), WSB(WS_CMP), WSB(WS_CMP) + BATCH * 128 * 64, WSF(WS_TAB) + 131072, WSB(WS_BR), (u - 32) >> 5, (u - 32) & 31, wv);
                else ret_unit(lds, WSB(WS_Z), P[7] + l * MW, WSB(WS_BR) + (size_t)MTOK * MW, (u - 288) >> 5, ((u - 288) >> 3) & 3, (u - 288) & 7, wv);
            }
            SEAM();
        }
        if (IN(pb + 3)) { PHASE_ENV for (int tok = gw; tok < MTOK; tok += NGW) rwkv_fin_token(WSF(WS_RW), WSB(WS_BR) + (size_t)2 * MTOK * MW, P[16] + l * MW, P[17] + l * MW, P[18] + l * MW, tok, lane); SEAM(); }
        if (IN(pb + 4)) {
#pragma unroll 1
            for (int m = 0; m < 4; ++m) { PHASE_ENV pg8::Epi<4> E{WSB(WS_MERGED), DM, nullptr, WSF(WS_MACC), WSB(WS_ZG), m}; gemm_run<4>(lds, WSB(WS_BR) + (size_t)m * MTOK * MW, WSB(WS_W) + WO_BR + (size_t)m * DM * MW, MTOK, DM, MW, E, wv, G, bid); }
            SEAM(); }
        if (IN(pb + 5)) { PHASE_ENV pg8::Epi<3> E{nullptr, DM, nullptr, WSF(WS_Y), nullptr, 0}; gemm_run<3>(lds, WSB(WS_MERGED), WSB(WS_W) + WO_MO, MTOK, DM, DM, E, wv, G, bid); SEAM(); }
        if (IN(pb + 6)) { PHASE_ENV rowop((l == 0) ? P[0] : OUT, WSF(WS_Y), P[22] + l * DM, P[23] + l * DM, OUT, WSB(WS_H), nullptr, nullptr, gw, NGW, lane); rms_rows(P[1], P[24] + l * DM, WSB(WS_MN), BATCH * MEMLEN, nullptr, nullptr, gw, NGW, lane); SEAM(); }
        if (IN(pb + 7)) {
            { PHASE_ENV pg8::Epi<0> E{WSB(WS_Q), DM, nullptr, nullptr, nullptr, 0}; gemm_run<0>(lds, WSB(WS_H), WSB(WS_W) + WO_Q, MTOK, DM, DM, E, wv, G, bid); }
            { PHASE_ENV pg8::Epi<0> E{WSB(WS_KX), DM, nullptr, nullptr, nullptr, 0}; gemm_run<0>(lds, WSB(WS_MN), WSB(WS_W) + WO_KV, BATCH * MEMLEN, DM, DM, E, wv, G, (bid + 224) % G); }
            { PHASE_ENV pg8::Epi<0> E{WSB(WS_VT), BATCH * MEMLEN, nullptr, nullptr, nullptr, 0}; gemm_run<0>(lds, WSB(WS_W) + WO_KV + (size_t)DM * DM, WSB(WS_MN), DM, BATCH * MEMLEN, DM, E, wv, G, (bid + 192) % G); }
            SEAM(); }
        if (IN(pb + 8)) { PHASE_ENV for (int u = bid; u < BATCH * 4 * 32; u += G) xattn_unit(lds, WSB(WS_Q), WSB(WS_KX), WSB(WS_VT), WSB(WS_O), u >> 7, (u >> 5) & 3, u & 31, wv); SEAM(); }
        if (IN(pb + 9)) { PHASE_ENV pg8::Epi<3> E{nullptr, DM, nullptr, WSF(WS_Y), nullptr, 0}; gemm_run<3>(lds, WSB(WS_O), WSB(WS_W) + WO_O, MTOK, DM, DM, E, wv, G, bid); SEAM(); }
        if (IN(pb + 10)) { PHASE_ENV rowop(OUT, WSF(WS_Y), P[28] + l * DM, P[29] + l * DM, OUT, WSB(WS_H), nullptr, nullptr, gw, NGW, lane); SEAM(); }
        if (IN(pb + 11)) { PHASE_ENV pg8::Epi<2> E{WSB(WS_HID), DFF, nullptr, nullptr, nullptr, 0}; gemm_run<2>(lds, WSB(WS_H), WSB(WS_W) + WO_1, MTOK, DFF, DM, E, wv, G, bid); SEAM(); }
        if (IN(pb + 12)) { PHASE_ENV pg8::Epi<3> E{nullptr, DM, nullptr, WSF(WS_Y), nullptr, 0}; gemm_run<3>(lds, WSB(WS_HID), WSB(WS_W) + WO_2, MTOK, DM, DFF, E, wv, G, bid); SEAM(); }
        if (IN(pb + 13)) {
            PHASE_ENV
            if (l + 1 < DEPTH) { convert_layer(P, l + 1, WSB(WS_W), lds, wave, lane, gw, NGW); __syncthreads(); stage_wng((LAS float*)lds, P[3] + (size_t)(l + 1) * DM * IN_COLS, tid); __syncthreads();
                rowop(OUT, WSF(WS_Y), P[32] + l * DM, P[2] + (l + 1) * DM, OUT, WSB(WS_H), (const LAS float*)lds, WSF(WS_NG), gw, NGW, lane); }
            else rowop(OUT, WSF(WS_Y), P[32] + l * DM, nullptr, OUT, WSB(WS_H), nullptr, nullptr, gw, NGW, lane);
            SEAM(); }
    }

__global__ void __launch_bounds__(NT, 2) mk_fwd(Args args) {
    extern __shared__ __attribute__((aligned(16))) unsigned char lds_raw[];
    LAS unsigned char* const lds0 = (LAS unsigned char*)lds_raw;
    const int G0 = gridDim.x;
    const int wv0 = __builtin_amdgcn_readfirstlane((int)threadIdx.x >> 6);
    const int lo = args.ph_lo, hi = args.ph_hi;
#if MK_PER_PHASE
    XcdBarrier bar; bar.bar = nullptr; bar.x = 0; bar.wv = 0; bar.st = nullptr;
#else
    { const int t0 = tid_now(wv0); if (t0 < 4) ((LAS unsigned*)(lds0 + XB_LDS_OFF))[t0] = 0u; }
    __syncthreads();
    const XcdBarrier bar = xcd_barrier_post((unsigned*)(args.ws + WS_CTL) + CW_BAR, (volatile LAS unsigned*)(lds0 + XB_LDS_OFF), wv0);
#endif

    if (IN(0)) {
        PHASE_ENV
        float* TABC = WSF(WS_TAB); float* TABS = TABC + 65536; float* BIASD = TABC + 131072;
        for (int i = gt; i < SEQ * 32; i += NGT) { const int t = i >> 5, j = i & 31; const double rev = (double)t * INVF_REV[j]; const float fr = (float)(rev - floor(rev)); TABC[i] = __builtin_amdgcn_cosf(fr); TABS[i] = __builtin_amdgcn_sinf(fr); }
        for (int i = gt; i < 512; i += NGT) { const int h = i >> 7, d = i & 127; BIASD[i] = P[6][T5B[d] * MH + h]; }
        convert_layer(P, 0, WSB(WS_W), lds, wave, lane, gw, NGW);
        __syncthreads();
        stage_wng((LAS float*)lds, P[3], tid);
        __syncthreads();
        rms_rows(P[0], P[2], WSB(WS_H), MTOK, (const LAS float*)lds, WSF(WS_NG), gw, NGW, lane);
        SEAM();
    }
    layer_phases<0>(lds0, G0, wv0, lo, hi, bar); layer_phases<1>(lds0, G0, wv0, lo, hi, bar); layer_phases<2>(lds0, G0, wv0, lo, hi, bar); layer_phases<3>(lds0, G0, wv0, lo, hi, bar);
#undef IN
}

extern "C" void kernel_launch(void* const* d_in, const int* in_sizes, int n_in, void* d_out, int out_size, void* d_ws, size_t ws_size, hipStream_t stream) {
    static int grid = 0;
    if (grid == 0) {
        if (n_in != 33 || out_size != MTOK * DM || ws_size < WS_END) { fprintf(stderr, "kernel_launch: unexpected shapes (n_in %d out %d ws %zu)\n", n_in, out_size, ws_size); grid = -1; return; }
        int dev = 0, cus = 0;
        if (hipGetDevice(&dev) != hipSuccess || hipDeviceGetAttribute(&cus, hipDeviceAttributeMultiprocessorCount, dev) != hipSuccess) { grid = -1; return; }
        if (hipFuncSetAttribute((const void*)mk_fwd, hipFuncAttributeMaxDynamicSharedMemorySize, LDS_BYTES) != hipSuccess) { fprintf(stderr, "kernel_launch: hipFuncSetAttribute failed\n"); grid = -1; return; }
        grid = cus;
    }
    if (grid < 0) return;
    (void)hipMemsetAsync((char*)d_ws + WS_CTL, 0, 1 * MiB, stream);
    Args a{};
    for (int i = 0; i < 33; ++i) a.in[i] = (const float*)d_in[i];
    a.out = (float*)d_out; a.ws = (unsigned char*)d_ws;
#if MK_PER_PHASE
    for (int p = 0; p < NPHASES; ++p) { a.ph_lo = p; a.ph_hi = p + 1; hipLaunchKernelGGL(mk_fwd, dim3(grid), dim3(NT), LDS_BYTES, stream, a); }
#else
    a.ph_lo = 0; a.ph_hi = NPHASES; hipLaunchKernelGGL(mk_fwd, dim3(grid), dim3(NT), LDS_BYTES, stream, a);
#endif
}
```

```cpp
#include <hip/hip_runtime.h>
#include <cstdio>
#include <cstdint>

#ifndef MK_PER_PHASE
#define MK_PER_PHASE 0
#endif
#define LAS __attribute__((address_space(3)))
typedef float f4 __attribute__((ext_vector_type(4)));
typedef unsigned short bf16_t;

constexpr int NWAVES = 8, NT = 512;
constexpr int BATCH = 8, SEQ = 2048, DM = 1024, DEPTH = 4, MTOK = BATCH * SEQ;
constexpr int MEMLEN = 256, MW = 256, HD = 64, MH = 4, DFF = 4096;
constexpr int IN_COLS = 7436, GATE_OFF = 3340;
constexpr int ZLD = 3328, NZ = 7424;
constexpr int NCMP = 127;
constexpr int C_Q = 0, C_KC = 256, C_VC = 320, C_KS = 384, C_VS = 448, C_KW = 512, C_VW = 576;
constexpr int C_RQ = 640, C_RK = 896, C_RV = 1152, C_RG = 1408, C_RW = 1664, C_CB = 2560, C_CC = 2816, C_CX = 3072;
constexpr int RWKV_COLS = 896;

constexpr size_t MiB = 1u << 20;
constexpr size_t WS_CTL = 0, WS_TAB = 1 * MiB, WS_CMP = 2 * MiB, WS_NG = 3 * MiB;
constexpr size_t WS_W = 4 * MiB;
constexpr size_t WS_H = 47 * MiB;
constexpr size_t WS_Z = 79 * MiB;
constexpr size_t WS_ZG = 183 * MiB;
constexpr size_t WS_RW = 311 * MiB;
constexpr size_t WS_BR = 423 * MiB;
constexpr size_t WS_MACC = 79 * MiB, WS_MERGED = 143 * MiB;
constexpr size_t WS_Q = 183 * MiB, WS_O = 247 * MiB, WS_KX = 279 * MiB, WS_VT = 283 * MiB, WS_MN = 295 * MiB, WS_HID = 183 * MiB;
constexpr size_t WS_Y = 311 * MiB;
constexpr size_t WS_END = 455 * MiB;
constexpr size_t WO_IN = 0, WO_BR = WO_IN + (size_t)NZ * DM, WO_MO = WO_BR + (size_t)4 * DM * MW, WO_Q = WO_MO + (size_t)DM * DM, WO_KV = WO_Q + (size_t)DM * DM,
                 WO_O = WO_KV + (size_t)2 * DM * DM, WO_1 = WO_O + (size_t)DM * DM, WO_2 = WO_1 + (size_t)DFF * DM, WO_END = WO_2 + (size_t)DFF * DM;
static_assert(WS_W + WO_END * 2 <= WS_H, "weight copies fit");
constexpr int LDS_BYTES = 147456, XB_LDS_OFF = 147440;
constexpr int CW_BAR = 4096;

__device__ const unsigned char T5B[128] = {0, 1, 2, 3, 4, 5, 6, 7, 8, 9, 10, 11, 12, 13, 14, 15, 16, 16, 16, 17, 17, 18, 18, 18, 19, 19, 19, 20, 20, 20, 20, 21, 21, 21, 21, 22, 22, 22, 22, 22, 23, 23, 23, 23, 23, 23, 24, 24, 24, 24, 24, 24, 25, 25, 25, 25, 25, 25, 25, 26, 26, 26, 26, 26, 26, 26, 26, 27, 27, 27, 27, 27, 27, 27, 27, 27, 27, 28, 28, 28, 28, 28, 28, 28, 28, 28, 28, 29, 29, 29, 29, 29, 29, 29, 29, 29, 29, 29, 29, 30, 30, 30, 30, 30, 30, 30, 30, 30, 30, 30, 30, 30, 30, 31, 31, 31, 31, 31, 31, 31, 31, 31, 31, 31, 31, 31, 31, 31};

__device__ const double INVF_REV[32] = {0.15915494309189535, 0.11934937021124885, 0.08949940160889101, 0.06711508300522726, 0.05032921210448703, 0.037741584717419764, 0.028302195830623395, 0.02122365276477766, 0.01591549430918953, 0.011934937021124881, 0.008949940160889099, 0.0067115083005227245, 0.005032921210448702, 0.003774158471741975, 0.0028302195830623394, 0.0021223652764777645, 0.0015915494309189527, 0.0011934937021124885, 0.0008949940160889096, 0.0006711508300522724, 0.0005032921210448699, 0.00037741584717419747, 0.00028302195830623385, 0.00021223652764777642, 0.00015915494309189524, 0.00011934937021124881, 8.949940160889094e-05, 6.711508300522721e-05, 5.032921210448702e-05, 3.7741584717419736e-05, 2.830219583062336e-05, 2.1223652764777656e-05};


struct Args { const float* in[33]; float* out; unsigned char* ws; int ph_lo, ph_hi; };
__device__ __forceinline__ int tid_now(int wv);
#define XB_TMO      128
#define XB_XCNT(j)  (256  + 64 * (j))
#define XB_XSUB(j)  (1280 + 64 * (j))
#define XB_XGEN(j)  (2304 + 64 * (j))
#define XB_TOP      3328
#define XB_TOPGEN   3392
#define XCD_BAR_WORDS 3456
#define XB_SPIN_CAP (1u << 18)

__device__ __forceinline__ unsigned xb_ld(unsigned* p)              { return __hip_atomic_load(p, __ATOMIC_RELAXED, __HIP_MEMORY_SCOPE_AGENT); }
__device__ __forceinline__ unsigned xb_add(unsigned* p, unsigned v) { return __hip_atomic_fetch_add(p, v, __ATOMIC_RELAXED, __HIP_MEMORY_SCOPE_AGENT); }
__device__ __forceinline__ unsigned xb_xcc_id() { return (unsigned)__builtin_amdgcn_s_getreg((3 << 11) | 20) & 0xFu; }
#define XB_SPIN(cond, bar) do { unsigned _sp = 0; while (cond) { __builtin_amdgcn_s_sleep(1); \
    if ((++_sp & 255u) == 0u) { if (xb_ld(&(bar)[XB_TMO])) break; if (_sp > XB_SPIN_CAP) { atomicAdd(&(bar)[XB_TMO], 1u); break; } } } } while (0)

struct XcdBarrier {
    unsigned* bar; unsigned x; int wv;
    volatile LAS unsigned* st;
};

__device__ __forceinline__ XcdBarrier xcd_barrier_post(unsigned* bar, volatile LAS unsigned* st, int wv) {
    XcdBarrier b; b.bar = bar; b.x = xb_xcc_id(); b.st = st; b.wv = wv;
    if (tid_now(wv) == 0) (void)xb_add(&bar[XB_XCNT(b.x)], 1u);
    return b;
}
__device__ __forceinline__ void xcd_barrier_complete(unsigned* bar, unsigned x, unsigned& nloc, unsigned& nx) {
    const unsigned G = gridDim.x * gridDim.y * gridDim.z;
    unsigned sum, cnt, mine, sp = 0u;
    for (;;) {
        sum = 0u; cnt = 0u; mine = 0u;
#pragma unroll
        for (unsigned j = 0; j < 16; ++j) { const unsigned c = xb_ld(&bar[XB_XCNT(j)]); sum += c; cnt += (c > 0u) ? 1u : 0u; mine = (j == x) ? c : mine; }
        if (sum == G) break;
        __builtin_amdgcn_s_sleep(1);
        if ((++sp & 255u) == 0u) { if (xb_ld(&bar[XB_TMO])) break; if (sp > XB_SPIN_CAP) { atomicAdd(&bar[XB_TMO], 1u); break; } }
    }
    nloc = mine > 0u ? mine : 1u; nx = cnt > 0u ? cnt : 1u;
}

__device__ __forceinline__ void xcd_barrier(const XcdBarrier& b) {
    asm volatile("s_waitcnt vmcnt(0)" ::: "memory");
    __syncthreads();
    if (tid_now(b.wv) == 0) {
        unsigned* bar = b.bar;
        __builtin_amdgcn_s_waitcnt(0);
        unsigned nloc = b.st[0], nx = b.st[1];
        if (nloc == 0u) { xcd_barrier_complete(bar, b.x, nloc, nx); b.st[0] = nloc; b.st[1] = nx; }
        const unsigned old = xb_add(&bar[XB_XSUB(b.x)], 1u);
        const unsigned gen = old / nloc;
        if (old + 1u == (gen + 1u) * nloc) {
            __builtin_amdgcn_fence(__ATOMIC_RELEASE, "agent");
            asm volatile("s_waitcnt vmcnt(0)" ::: "memory");
            const unsigned og = xb_add(&bar[XB_TOP], 1u);
            const unsigned tg = og / nx;
            if (og + 1u == (tg + 1u) * nx) xb_add(&bar[XB_TOPGEN], 1u);
            else XB_SPIN(xb_ld(&bar[XB_TOPGEN]) == tg, bar);
            __builtin_amdgcn_fence(__ATOMIC_ACQUIRE, "agent");
            xb_add(&bar[XB_XGEN(b.x)], 1u);
            asm volatile("s_waitcnt vmcnt(0)" ::: "memory");
        } else {
            XB_SPIN(xb_ld(&bar[XB_XGEN(b.x)]) == gen, bar);
            __builtin_amdgcn_fence(__ATOMIC_ACQUIRE, "agent");
            asm volatile("s_waitcnt vmcnt(0)" ::: "memory");
        }
    }
    __syncthreads();
}


__device__ __forceinline__ int tid_now(int wv) { int l; asm volatile("v_mbcnt_lo_u32_b32 %0, -1, 0\n\tv_mbcnt_hi_u32_b32 %0, -1, %0" : "=v"(l)); return (wv << 6) | l; }
__device__ __forceinline__ float wsum(float v) {
#pragma unroll
    for (int o = 32; o >= 1; o >>= 1) v += __shfl_xor(v, o);
    return v;
}
__device__ __forceinline__ float gsum16(float v) {
#pragma unroll
    for (int o = 8; o >= 1; o >>= 1) v += __shfl_xor(v, o);
    return v;
}
__device__ __forceinline__ float sigmoidf_(float x) { return 1.f / (1.f + __expf(-x)); }
__device__ __forceinline__ float bflo(unsigned u) { return __uint_as_float(u << 16); }
__device__ __forceinline__ float bfhi(unsigned u) { return __uint_as_float(u & 0xffff0000u); }
__device__ __forceinline__ float bf2f(bf16_t b) { return __uint_as_float((unsigned)b << 16); }
__device__ __forceinline__ unsigned pkbf(float lo, float hi) { unsigned r; asm volatile("v_cvt_pk_bf16_f32 %0, %1, %2" : "=v"(r) : "v"(lo), "v"(hi)); return r; }
__device__ __forceinline__ f4 ld4bf(const bf16_t* p) { const uint2 u = *(const uint2*)p; return (f4){bflo(u.x), bfhi(u.x), bflo(u.y), bfhi(u.y)}; }
__device__ __forceinline__ void st4bf(bf16_t* p, f4 v) { uint2 u; u.x = pkbf(v.x, v.y); u.y = pkbf(v.z, v.w); *(uint2*)p = u; }
__device__ __forceinline__ float dot64(const float (&q)[64], const LAS f4* k) {
    float a0 = 0.f, a1 = 0.f, a2 = 0.f, a3 = 0.f;
#pragma unroll
    for (int i = 0; i < 16; ++i) { const f4 kv = k[i]; a0 += q[4 * i] * kv.x; a1 += q[4 * i + 1] * kv.y; a2 += q[4 * i + 2] * kv.z; a3 += q[4 * i + 3] * kv.w; }
    return (a0 + a1) + (a2 + a3);
}
__device__ __forceinline__ void osm_update(float s, const LAS f4* v, float& m, float& l, float (&o)[64]) {
    const float mn = fmaxf(m, s), sc = __expf(m - mn), p = __expf(s - mn);
    l = l * sc + p; m = mn;
#pragma unroll
    for (int i = 0; i < 16; ++i) { const f4 vv = v[i];
        o[4 * i] = o[4 * i] * sc + p * vv.x; o[4 * i + 1] = o[4 * i + 1] * sc + p * vv.y; o[4 * i + 2] = o[4 * i + 2] * sc + p * vv.z; o[4 * i + 3] = o[4 * i + 3] * sc + p * vv.w; }
}

typedef short bf16x8_t __attribute__((ext_vector_type(8)));
typedef float f32x16_t __attribute__((ext_vector_type(16)));
typedef unsigned u32x4_t __attribute__((ext_vector_type(4))); typedef unsigned u32x2_t __attribute__((ext_vector_type(2)));
typedef float f32x2_t __attribute__((ext_vector_type(2))); typedef __bf16 bf16x2_t __attribute__((ext_vector_type(2)));
__device__ __forceinline__ unsigned cvtpk(float lo, float hi) { f32x2_t v = {lo, hi}; bf16x2_t b = __builtin_convertvector(v, bf16x2_t); return __builtin_bit_cast(unsigned, b); }
#define MFMA32(a, b, c) __builtin_amdgcn_mfma_f32_32x32x16_bf16((a), (b), (c), 0, 0, 0)
__device__ __forceinline__ float xhalf(float v) { return __shfl_xor(v, 32); }

namespace pg8 {
#define PG8_LAS __attribute__((address_space(3)))
typedef unsigned short bf16_t;
typedef short bf16x8 __attribute__((ext_vector_type(8)));
typedef float f32x4 __attribute__((ext_vector_type(4)));
typedef unsigned u32x4 __attribute__((ext_vector_type(4)));
constexpr int BM = 256, BK = 64, HALF = 128, HTB = HALF * BK * 2  , STAGE_BYTES = 8 * HTB, NXCD = 8, WGM = 8;

__host__ __device__ __forceinline__ int lds_byte(int r, int c) { const int st = (r >> 4) * 2 + (c >> 5), rr = r & 15, cc = c & 31, ob = rr * 64 + cc * 2; return st * 1024 + (ob ^ (((ob >> 9) & 1) << 5)); }
__host__ __device__ __forceinline__ void stage_rc(int b, int& R, int& C) { const int st = b / 1024, sb = b % 1024, swz = sb ^ (((sb >> 9) & 1) << 5); R = (st >> 1) * 16 + swz / 64; C = (st & 1) * 32 + (swz % 64) / 2; }
__host__ __device__ __forceinline__ int perm32(int rho) { const int n = rho >> 4, i = rho & 15; return 8 * (i >> 2) + 4 * n + (i & 3); }

struct Unit { int pm, pn; };
struct Gemm { const bf16_t* A; const bf16_t* Bt; int M, N, K; };

struct StaticOrder {
    int nM, nN, nwg, G, c;
    __host__ __device__ void init(int M, int N, int G_, int c_) { nM = M / BM; nN = N / BM; nwg = nM * nN; G = G_; c = c_; }
    __host__ __device__ bool next(int i, Unit& u) const {
        const long L = (long)i * G + c; if (L >= nwg) return false;
        int wgid = (int)L; { const int q = nwg / NXCD, r = nwg % NXCD, xcd = wgid % NXCD, off = wgid / NXCD; wgid = (xcd < r ? xcd * (q + 1) : r * (q + 1) + (xcd - r) * q) + off; }
        const int nig = WGM * nN, gid = wgid / nig, fm = gid * WGM, gsz = (nM - fm) < WGM ? (nM - fm) : WGM;
        u.pm = fm + ((wgid % nig) % gsz); u.pn = (wgid % nig) / gsz; return true;
    }
    __device__ __forceinline__ void a_ready(const Unit&) const {}
    __device__ __forceinline__ void done(const Unit&) const {}
};

__device__ __forceinline__ unsigned cvt_pk_bf16(float lo, float hi) { unsigned r; asm volatile("v_cvt_pk_bf16_f32 %0, %1, %2" : "=v"(r) : "v"(lo), "v"(hi)); return r; }
typedef float f32x2 __attribute__((ext_vector_type(2)));

template <int MODE> struct Epi {
    static constexpr bool PERM = true, AFTER_DRAIN = false;
    bf16_t* O; int ldc; bf16_t* O2; float* F; const bf16_t* SG; int mi;
    __device__ __forceinline__ void operator()(const f32x4 (&acc)[2][2][4][2], const Unit& u, int wr, int wc, int fr, int fq) const {
        const int row0 = u.pm * BM + wr * 64 + fr, col0 = u.pn * BM + wc * 32 + 8 * fq;
#pragma unroll
        for (int ai = 0; ai < 2; ++ai)
#pragma unroll
            for (int m = 0; m < 4; ++m) { const size_t row = (size_t)(row0 + ai * HALF + m * 16);
#pragma unroll
                for (int bj = 0; bj < 2; ++bj) { f32x4 v0 = acc[ai][bj][m][0], v1 = acc[ai][bj][m][1]; const int col = col0 + bj * HALF;
                    if (MODE == 3) { float* p = F + row * ldc + col; *(f32x4*)p = v0; *(f32x4*)(p + 4) = v1; }
                    else {
                        bf16_t* dst = O + row * ldc + col;
                        if (MODE == 1) { if (u.pn >= ZLD / BM) { dst = O2 + row * (4 * DM) + (col - ZLD);
#pragma unroll
                            for (int e = 0; e < 4; ++e) { v0[e] = sigmoidf_(v0[e]); v1[e] = sigmoidf_(v1[e]); } } }
                        if (MODE == 2) {
#pragma unroll
                            for (int e = 0; e < 4; ++e) { const float a = fmaxf(v0[e], 0.f), b = fmaxf(v1[e], 0.f); v0[e] = a * a; v1[e] = b * b; } }
                        if (MODE == 4) { const u32x4 g = *(const u32x4*)(SG + row * (4 * DM) + mi * DM + col);
                            v0[0] *= bflo(g.x); v0[1] *= bfhi(g.x); v0[2] *= bflo(g.y); v0[3] *= bfhi(g.y); v1[0] *= bflo(g.z); v1[1] *= bfhi(g.z); v1[2] *= bflo(g.w); v1[3] *= bfhi(g.w);
                            float* p = F + row * DM + col;
                            if (mi > 0) { v0 += *(const f32x4*)p; v1 += *(const f32x4*)(p + 4); }
                            if (mi < 3) { *(f32x4*)p = v0; *(f32x4*)(p + 4) = v1; continue; } }
                        u32x4 w; w.x = cvt_pk_bf16(v0[0], v0[1]); w.y = cvt_pk_bf16(v0[2], v0[3]); w.z = cvt_pk_bf16(v1[0], v1[1]); w.w = cvt_pk_bf16(v1[2], v1[3]);
                        *(u32x4*)dst = w; } } }
    }
};
template <class Epi, class Sched, bool ALIGN_EPI = false, bool SP2 = false>
__device__ __forceinline__ void gemm_phase(PG8_LAS unsigned char* lds, const Gemm g, const Sched& S, const Epi& E, int wv) {
    const int tid = tid_now(wv), wid = __builtin_amdgcn_readfirstlane(tid >> 6), lane = tid & 63, wr = wid >> 2, wc = wid & 3, fr = lane & 15, fq = lane >> 4;
    const int K = g.K, nt = K / BK;
    unsigned voffA[2], voffB[2];
#pragma unroll
    for (int i = 0; i < 2; ++i) { int R, C; stage_rc(tid * 16 + i * 8192, R, C); const int Rb = Epi::PERM ? ((R & ~31) + perm32(R & 31)) : R;
        voffA[i] = (unsigned)(R * K + C) * 2u; voffB[i] = (unsigned)(Rb * K + C) * 2u; }
    const size_t kstep = (size_t)(BK * 2);
    const size_t hstep = (size_t)HALF * K * 2;
    const size_t tstep = 2 * hstep;
    const unsigned ldsw = (unsigned)wid * 1024u;
    const int aoff = lds_byte(wr * 64 + fr, fq * 8), boff = lds_byte(wc * 32 + fr, fq * 8);
#define PG8_SA(b, h) (((b) * 2 + (h)) * HTB)
#define PG8_SB(b, h) ((4 + (b) * 2 + (h)) * HTB)
#define PG8_STAGE(bufoff, gbase, voff) do { _Pragma("unroll") for (int _i = 0; _i < 2; ++_i) \
        __builtin_amdgcn_global_load_lds((const unsigned*)((const char*)(gbase) + (voff)[_i]), (PG8_LAS unsigned*)(lds + (bufoff) + ldsw + _i * 8192), 16, 0, 0); } while (0)
#define PG8_LDA(dst, b, h) do { _Pragma("unroll") for (int m = 0; m < 4; ++m) _Pragma("unroll") for (int k = 0; k < 2; ++k) dst[m][k] = *(const PG8_LAS bf16x8*)(lds + PG8_SA(b, h) + aoff + m * 2048 + k * 1024); } while (0)
#define PG8_LDB(dst, b, h) do { _Pragma("unroll") for (int n = 0; n < 2; ++n) _Pragma("unroll") for (int k = 0; k < 2; ++k) dst[n][k] = *(const PG8_LAS bf16x8*)(lds + PG8_SB(b, h) + boff + n * 2048 + k * 1024); } while (0)
#define PG8_MMA(ai, bj, At, Bt) do { __builtin_amdgcn_s_setprio(1); _Pragma("unroll") for (int m = 0; m < 4; ++m) _Pragma("unroll") for (int n = 0; n < 2; ++n) _Pragma("unroll") for (int k = 0; k < 2; ++k) \
        acc[ai][bj][m][n] = __builtin_amdgcn_mfma_f32_16x16x32_bf16(Bt[n][k], At[m][k], acc[ai][bj][m][n], 0, 0, 0); __builtin_amdgcn_s_setprio(0); } while (0)
#define PG8_WAIT_V(n) asm volatile("s_waitcnt vmcnt(" #n ")" ::: "memory")
#define PG8_WAIT_L(n) asm volatile("s_waitcnt lgkmcnt(" #n ")" ::: "memory")
#define PG8_BAR __builtin_amdgcn_s_barrier()
#define PG8_SCHED __builtin_amdgcn_sched_barrier(0)
    Unit cur, nxt; int ui = 0;
    if (!S.next(0, cur)) return;
    f32x4 acc[2][2][4][2];
#pragma unroll
    for (int a = 0; a < 2; ++a)
#pragma unroll
        for (int b = 0; b < 2; ++b)
#pragma unroll
            for (int m = 0; m < 4; ++m)
#pragma unroll
                for (int n = 0; n < 2; ++n) acc[a][b][m][n] = (f32x4){0.f, 0.f, 0.f, 0.f};
    bf16x8 At[4][2], B0[2][2], B1[2][2];
    const char* cA = (const char*)g.A + (size_t)cur.pm * tstep; const char* cB = (const char*)g.Bt + (size_t)cur.pn * tstep;
    S.a_ready(cur);
    if constexpr (SP2) {
        PG8_STAGE(PG8_SB(0, 0), cB, voffB); PG8_STAGE(PG8_SB(0, 1), cB + hstep, voffB); PG8_STAGE(PG8_SA(0, 0), cA, voffA); PG8_STAGE(PG8_SA(0, 1), cA + hstep, voffA);
        if (wr == 1) PG8_BAR;
        PG8_WAIT_V(2); PG8_BAR;
        PG8_STAGE(PG8_SB(1, 0), cB + kstep, voffB); PG8_STAGE(PG8_SA(1, 0), cA + kstep, voffA); PG8_STAGE(PG8_SB(1, 1), cB + hstep + kstep, voffB);
        PG8_WAIT_V(6); PG8_BAR;
    } else {
        PG8_STAGE(PG8_SB(0, 0), cB, voffB); PG8_STAGE(PG8_SA(0, 0), cA, voffA); PG8_STAGE(PG8_SB(0, 1), cB + hstep, voffB); PG8_STAGE(PG8_SA(0, 1), cA + hstep, voffA);
        if (wr == 1) PG8_BAR;
        PG8_WAIT_V(4); PG8_BAR;
        PG8_STAGE(PG8_SB(1, 0), cB + kstep, voffB); PG8_STAGE(PG8_SA(1, 0), cA + kstep, voffA); PG8_STAGE(PG8_SB(1, 1), cB + hstep + kstep, voffB);
        PG8_WAIT_V(6); PG8_BAR;
    }
    for (;;) {
        const bool has_next = S.next(ui + 1, nxt);
        const char* nA = has_next ? (const char*)g.A + (size_t)nxt.pm * tstep : cA; const char* nB = has_next ? (const char*)g.Bt + (size_t)nxt.pn * tstep : cB;
        for (int t = 0; t < nt; t += 2) {
            const bool last = (t == nt - 2);
            const char* a1 = cA + (size_t)(t + 1) * kstep;
            const char* a2 = last ? nA : cA + (size_t)(t + 2) * kstep; const char* b2 = last ? nB : cB + (size_t)(t + 2) * kstep;
            const char* a3 = a2 + kstep; const char* b3 = b2 + kstep;
            if (last && has_next) S.a_ready(nxt);
            if constexpr (SP2) {
            PG8_LDB(B0, 0, 0); PG8_LDB(B1, 0, 1); PG8_SCHED; PG8_LDA(At, 0, 0); PG8_STAGE(PG8_SA(1, 1), a1 + hstep, voffA);
            PG8_WAIT_V(8); PG8_WAIT_L(0); PG8_BAR; PG8_MMA(0, 0, At, B0); PG8_MMA(0, 1, At, B1); PG8_BAR; PG8_SCHED;
            PG8_LDA(At, 0, 1); PG8_STAGE(PG8_SB(0, 0), b2, voffB); PG8_STAGE(PG8_SB(0, 1), b2 + hstep, voffB); PG8_STAGE(PG8_SA(0, 0), a2, voffA);
            PG8_WAIT_V(8); PG8_WAIT_L(0); PG8_BAR; PG8_MMA(1, 0, At, B0); PG8_MMA(1, 1, At, B1); PG8_BAR; PG8_SCHED;
            PG8_LDB(B0, 1, 0); PG8_LDB(B1, 1, 1); PG8_SCHED; PG8_LDA(At, 1, 0); PG8_STAGE(PG8_SA(0, 1), a2 + hstep, voffA);
            PG8_WAIT_V(8); PG8_WAIT_L(0); PG8_BAR; PG8_MMA(0, 0, At, B0); PG8_MMA(0, 1, At, B1); PG8_BAR; PG8_SCHED;
            PG8_LDA(At, 1, 1); PG8_STAGE(PG8_SB(1, 0), b3, voffB); PG8_STAGE(PG8_SB(1, 1), b3 + hstep, voffB); PG8_STAGE(PG8_SA(1, 0), a3, voffA);
            PG8_WAIT_V(8); PG8_WAIT_L(0); PG8_BAR; PG8_MMA(1, 0, At, B0); PG8_MMA(1, 1, At, B1); PG8_BAR; PG8_SCHED;
            } else {
            PG8_LDB(B0, 0, 0); PG8_SCHED; PG8_LDA(At, 0, 0); PG8_STAGE(PG8_SA(1, 1), a1 + hstep, voffA);
            PG8_WAIT_L(8); PG8_BAR; PG8_WAIT_L(0); PG8_MMA(0, 0, At, B0); PG8_BAR; PG8_SCHED;
            PG8_LDB(B1, 0, 1); PG8_STAGE(PG8_SB(0, 0), b2, voffB);
            PG8_BAR; PG8_WAIT_L(0); PG8_MMA(0, 1, At, B1); PG8_BAR;
            PG8_LDA(At, 0, 1); PG8_STAGE(PG8_SA(0, 0), a2, voffA);
            PG8_BAR; PG8_WAIT_L(0); PG8_MMA(1, 0, At, B0); PG8_BAR; PG8_SCHED;
            PG8_STAGE(PG8_SB(0, 1), b2 + hstep, voffB);
            PG8_WAIT_V(6); PG8_BAR; PG8_MMA(1, 1, At, B1); PG8_BAR;
            PG8_LDB(B0, 1, 0); PG8_SCHED; PG8_LDA(At, 1, 0); PG8_STAGE(PG8_SA(0, 1), a2 + hstep, voffA);
            PG8_WAIT_L(8); PG8_BAR; PG8_WAIT_L(0); PG8_MMA(0, 0, At, B0); PG8_BAR; PG8_SCHED;
            PG8_LDB(B1, 1, 1); PG8_STAGE(PG8_SB(1, 0), b3, voffB);
            PG8_BAR; PG8_WAIT_L(0); PG8_MMA(0, 1, At, B1); PG8_BAR;
            PG8_LDA(At, 1, 1); PG8_STAGE(PG8_SA(1, 0), a3, voffA);
            PG8_BAR; PG8_WAIT_L(0); PG8_MMA(1, 0, At, B0); PG8_BAR; PG8_SCHED;
            PG8_STAGE(PG8_SB(1, 1), b3 + hstep, voffB);
            PG8_WAIT_V(6); PG8_BAR; PG8_MMA(1, 1, At, B1); PG8_BAR;
            }
        }
        if constexpr (ALIGN_EPI) { if (wr == 0) PG8_BAR; }
        if constexpr (!Epi::AFTER_DRAIN) { E(acc, cur, wr, wc, fr, fq); S.done(cur); }
        if (!has_next) break;
#pragma unroll
        for (int a = 0; a < 2; ++a)
#pragma unroll
            for (int b = 0; b < 2; ++b)
#pragma unroll
                for (int m = 0; m < 4; ++m)
#pragma unroll
                    for (int n = 0; n < 2; ++n) acc[a][b][m][n] = (f32x4){0.f, 0.f, 0.f, 0.f};
        cur = nxt; cA = nA; cB = nB; ++ui;
        if constexpr (ALIGN_EPI) { if (wr == 1) PG8_BAR; }
    }
    PG8_WAIT_V(0);
    if constexpr (!ALIGN_EPI) { if (wr == 0) PG8_BAR; }
    PG8_BAR;
    if constexpr (Epi::AFTER_DRAIN) { E.fused(acc, cur, wr, wc, fr, fq, lds, wid, lane); S.done(cur); }
#undef PG8_SA
#undef PG8_SB
#undef PG8_STAGE
#undef PG8_LDA
#undef PG8_LDB
#undef PG8_MMA
#undef PG8_WAIT_V
#undef PG8_WAIT_L
#undef PG8_BAR
#undef PG8_SCHED
}
}

template <int MODE>
__device__ __forceinline__ void gemm_run(LAS unsigned char* lds, const bf16_t* A, const bf16_t* Bt, int M, int N, int K, const pg8::Epi<MODE>& E, int wv, int G, int bid) {
    pg8::Gemm g{A, Bt, M, N, K}; pg8::StaticOrder S; S.init(M, N, G, bid);
    pg8::gemm_phase<pg8::Epi<MODE>, pg8::StaticOrder, true, true>(lds, g, S, E, wv);
}

__device__ __forceinline__ void transpose_item(const float* W, int ldw, int src_c0, bf16_t* WT, int K, int dst_r0, int k0, LAS float* scr, int lane) {
#pragma unroll 8
    for (int i = 0; i < 32; ++i) { const int kk = 2 * i + (lane >> 5); scr[kk * 33 + (lane & 31)] = W[(size_t)(k0 + kk) * ldw + src_c0 + (lane & 31)]; }
    asm volatile("s_waitcnt lgkmcnt(0)" ::: "memory");
    const int c = lane & 7;
#pragma unroll
    for (int j = 0; j < 4; ++j) { const int n = (lane >> 3) + 8 * j; const LAS float* s = scr + (8 * c) * 33 + n;
        uint4 o; o.x = pkbf(s[0 * 33], s[1 * 33]); o.y = pkbf(s[2 * 33], s[3 * 33]); o.z = pkbf(s[4 * 33], s[5 * 33]); o.w = pkbf(s[6 * 33], s[7 * 33]);
        *(uint4*)(WT + (size_t)(dst_r0 + n) * K + k0 + 8 * c) = o; }
    asm volatile("s_waitcnt lgkmcnt(0)" ::: "memory");
}
__device__ __forceinline__ void convert_layer(const float* const* P, int l, bf16_t* Wb, LAS unsigned char* lds, int wave, int lane, int gw, int NGW) {
    LAS float* scr = (LAS float*)(lds + wave * 16384);
    constexpr int I_IN = 16 * (NZ / 32), I_BR = 4 * 4 * 32, I_SQ = 16 * 32, I_KV = 16 * 64, I_1 = 16 * 128, I_2 = 64 * 32;
    constexpr int NIT = I_IN + I_BR + 3 * I_SQ + I_KV + I_1 + I_2;
    for (int it = gw; it < NIT; it += NGW) {
        int r = it;
        if (r < I_IN) { const int kb = r / (NZ / 32), nb = r % (NZ / 32), n0 = 32 * nb; transpose_item(P[3] + (size_t)l * DM * IN_COLS, IN_COLS, n0 + (n0 >= 640 ? 12 : 0), Wb + WO_IN, DM, n0, 64 * kb, scr, lane); continue; } r -= I_IN;
        if (r < I_BR) { const int m = r >> 7, kb = (r >> 5) & 3, nb = r & 31; transpose_item(P[20] + ((size_t)l * 4 + m) * MW * DM, DM, 32 * nb, Wb + WO_BR + (size_t)m * DM * MW, MW, 32 * nb, 64 * kb, scr, lane); continue; } r -= I_BR;
        if (r < I_SQ) { transpose_item(P[21] + (size_t)l * DM * DM, DM, 32 * (r & 31), Wb + WO_MO, DM, 32 * (r & 31), 64 * (r >> 5), scr, lane); continue; } r -= I_SQ;
        if (r < I_SQ) { transpose_item(P[25] + (size_t)l * DM * DM, DM, 32 * (r & 31), Wb + WO_Q, DM, 32 * (r & 31), 64 * (r >> 5), scr, lane); continue; } r -= I_SQ;
        if (r < I_KV) { transpose_item(P[26] + (size_t)l * DM * 2 * DM, 2 * DM, 32 * (r & 63), Wb + WO_KV, DM, 32 * (r & 63), 64 * (r >> 6), scr, lane); continue; } r -= I_KV;
        if (r < I_SQ) { transpose_item(P[27] + (size_t)l * DM * DM, DM, 32 * (r & 31), Wb + WO_O, DM, 32 * (r & 31), 64 * (r >> 5), scr, lane); continue; } r -= I_SQ;
        if (r < I_1) { transpose_item(P[30] + (size_t)l * DM * DFF, DFF, 32 * (r & 127), Wb + WO_1, DM, 32 * (r & 127), 64 * (r >> 7), scr, lane); continue; } r -= I_1;
        transpose_item(P[31] + (size_t)l * DFF * DM, DM, 32 * (r & 31), Wb + WO_2, DFF, 32 * (r & 31), 64 * (r >> 5), scr, lane);
    }
}

__device__ __forceinline__ void ng_row(const f4 (&v)[4], const LAS float* wng, float* ngo, int lane) {
    float acc[12];
#pragma unroll
    for (int j = 0; j < 12; ++j) { float a = 0.f;
#pragma unroll
        for (int jj = 0; jj < 4; ++jj) { const f4 w = *(const LAS f4*)(wng + j * DM + 4 * lane + 256 * jj); a += v[jj].x * w.x + v[jj].y * w.y + v[jj].z * w.z + v[jj].w * w.w; }
        acc[j] = wsum(a); }
    if (lane == 0) { *(f4*)ngo = (f4){acc[0], acc[1], acc[2], acc[3]}; *(f4*)(ngo + 4) = (f4){acc[4], acc[5], acc[6], acc[7]}; *(f4*)(ngo + 8) = (f4){acc[8], acc[9], acc[10], acc[11]}; }
}
__device__ __forceinline__ void stage_wng(LAS float* wng, const float* w_in_l, int tid) {
    for (int i = tid; i < 12 * DM; i += NT) { const int c = i / 12, j = i % 12; wng[j * DM + c] = w_in_l[(size_t)c * IN_COLS + 640 + j]; }
}
__device__ __forceinline__ void rms_rows(const float* x, const float* g, bf16_t* out, int nrows, const LAS float* wng, float* ng, int gw, int NGW, int lane) {
    for (int m = gw; m < nrows; m += NGW) {
        const f4* xr = (const f4*)(x + (size_t)m * DM) + lane; f4 v[4]; float s = 0.f;
#pragma unroll
        for (int j = 0; j < 4; ++j) { v[j] = xr[64 * j]; s += v[j].x * v[j].x + v[j].y * v[j].y + v[j].z * v[j].z + v[j].w * v[j].w; }
        const float r = 1.f / sqrtf(wsum(s) * (1.f / DM) + 1e-6f);
#pragma unroll
        for (int j = 0; j < 4; ++j) { const f4 gg = ((const f4*)g)[lane + 64 * j]; v[j] = v[j] * r * gg; st4bf(out + (size_t)m * DM + 4 * lane + 256 * j, v[j]); }
        if (ng) ng_row(v, wng, ng + (size_t)m * 12, lane);
    }
}
__device__ __forceinline__ void rowop(const float* xin, const float* y, const float* g1, const float* g2, float* xout, bf16_t* h, const LAS float* wng, float* ng, int gw, int NGW, int lane) {
    for (int m = gw; m < MTOK; m += NGW) {
        const f4* yr = (const f4*)(y + (size_t)m * DM) + lane; const f4* xr = (const f4*)(xin + (size_t)m * DM) + lane; f4 v[4]; float s = 0.f;
#pragma unroll
        for (int j = 0; j < 4; ++j) { v[j] = yr[64 * j]; s += v[j].x * v[j].x + v[j].y * v[j].y + v[j].z * v[j].z + v[j].w * v[j].w; }
        const float r = 1.f / sqrtf(wsum(s) * (1.f / DM) + 1e-6f);
        float s2 = 0.f; f4* xo = (f4*)(xout + (size_t)m * DM) + lane;
#pragma unroll
        for (int j = 0; j < 4; ++j) { const f4 gg = ((const f4*)g1)[lane + 64 * j]; v[j] = xr[64 * j] + v[j] * r * gg; xo[64 * j] = v[j];
            s2 += v[j].x * v[j].x + v[j].y * v[j].y + v[j].z * v[j].z + v[j].w * v[j].w; }
        if (g2) { const float r2 = 1.f / sqrtf(wsum(s2) * (1.f / DM) + 1e-6f);
#pragma unroll
            for (int j = 0; j < 4; ++j) { const f4 gg = ((const f4*)g2)[lane + 64 * j]; v[j] = v[j] * r2 * gg; st4bf(h + (size_t)m * DM + 4 * lane + 256 * j, v[j]); }
            if (ng) ng_row(v, wng, ng + (size_t)m * 12, lane); }
    }
}

__device__ __forceinline__ void nsa_compress_unit(const bf16_t* z, const float* cmp_w_l, const float* pe_l, bf16_t* kc, bf16_t* vct, int u, int lane) {
    const int which = u & 1, bn = u >> 1, b = bn >> 7, n = bn & 127;
    const float* W = cmp_w_l + (size_t)which * 32 * 64 * 64; const int col = which ? C_VC : C_KC;
    float acc = 0.f;
    if (n < NCMP) {
        for (int l = 0; l < 32; ++l) {
            const bf16_t* zr = z + (size_t)(b * SEQ + 16 * n + l) * ZLD + col;
#pragma unroll 8
            for (int d = 0; d < 64; ++d) acc += (bf2f(zr[d]) + pe_l[l * 64 + d]) * W[(l * 64 + d) * 64 + lane];
        }
    }
    const bf16_t r = (bf16_t)(pkbf(acc, 0.f) & 0xffffu);
    if (which) vct[(size_t)(b * 64 + lane) * 128 + n] = r; else kc[(size_t)(b * 128 + n) * 64 + lane] = r;
}
__device__ __forceinline__ void rwkv_prep_token(const bf16_t* zb, float* rw, const float* const* P, int l, int tok, int lane, LAS float* scr) {
    const float* mu = P[8] + l * RWKV_COLS; const float* w0 = P[9] + l * MW; const float* w2 = P[10] + (size_t)l * 32 * MW; const float* a0 = P[11] + l * MW;
    const float* a2 = P[12] + (size_t)l * 32 * MW; const float* g2 = P[13] + (size_t)l * 64 * MW; const float* k_k = P[14] + l * MW; const float* k_a = P[15] + l * MW;
    const int t = tok % SEQ; const bf16_t* z = zb + (size_t)tok * ZLD + C_RW; const bf16_t* zp = z - ZLD;
    f4 rkv[3];
#pragma unroll
    for (int j = 0; j < 3; ++j) { const f4 c = ld4bf(z + j * 256 + 4 * lane); const f4 p = t ? ld4bf(zp + j * 256 + 4 * lane) : (f4){0.f, 0.f, 0.f, 0.f};
        const f4 m = *(const f4*)(mu + j * 256 + 4 * lane); rkv[j] = c + (p - c) * m; }
    if (lane < 32) { const f4 c = ld4bf(z + 768 + 4 * lane); const f4 p = t ? ld4bf(zp + 768 + 4 * lane) : (f4){0.f, 0.f, 0.f, 0.f};
        const f4 m = *(const f4*)(mu + 768 + 4 * lane); f4 v = c + (p - c) * m;
        if (lane < 8) { v.x = tanhf(v.x); v.y = tanhf(v.y); v.z = tanhf(v.z); v.w = tanhf(v.w); }
        else if (lane >= 16) { v.x = sigmoidf_(v.x); v.y = sigmoidf_(v.y); v.z = sigmoidf_(v.z); v.w = sigmoidf_(v.w); }
        *(LAS f4*)(scr + 4 * lane) = v; }
    asm volatile("s_waitcnt lgkmcnt(0)" ::: "memory");
    f4 aw = (f4){0.f, 0.f, 0.f, 0.f}, aa = aw, ag = aw;
#pragma unroll 4
    for (int j = 0; j < 32; ++j) { aw += scr[j] * *(const f4*)(w2 + j * MW + 4 * lane); aa += scr[32 + j] * *(const f4*)(a2 + j * MW + 4 * lane); }
#pragma unroll 4
    for (int j = 0; j < 64; ++j) ag += scr[64 + j] * *(const f4*)(g2 + j * MW + 4 * lane);
    asm volatile("s_waitcnt lgkmcnt(0)" ::: "memory");
    const f4 w0v = *(const f4*)(w0 + 4 * lane), a0v = *(const f4*)(a0 + 4 * lane), kkv = *(const f4*)(k_k + 4 * lane), kav = *(const f4*)(k_a + 4 * lane);
    float dec[4], av[4], kk[4], k2[4]; float ss = 0.f;
#pragma unroll
    for (int i = 0; i < 4; ++i) { const float y = -(w0v[i] + aw[i]); const float sp = (y > 20.f) ? y : log1pf(expf(y)); const float wl = -sp - 0.5f; dec[i] = expf(-expf(wl));
        av[i] = 1.f / (1.f + expf(-(a0v[i] + aa[i]))); kk[i] = rkv[1][i] * kkv[i]; ss += kk[i] * kk[i]; k2[i] = rkv[1][i] * (1.f + (av[i] - 1.f) * kav[i]); }
    ss = gsum16(ss); const float inv = 1.f / fmaxf(sqrtf(ss), 1e-12f);
    float* o = rw + (size_t)tok * 7 * MW + 4 * lane;
    *(f4*)(o) = rkv[0]; *(f4*)(o + MW) = (f4){dec[0], dec[1], dec[2], dec[3]}; *(f4*)(o + 2 * MW) = (f4){k2[0], k2[1], k2[2], k2[3]}; *(f4*)(o + 3 * MW) = rkv[2];
    *(f4*)(o + 4 * MW) = (f4){kk[0] * inv, kk[1] * inv, kk[2] * inv, kk[3] * inv}; *(f4*)(o + 5 * MW) = (f4){kk[0] * inv * av[0], kk[1] * inv * av[1], kk[2] * inv * av[2], kk[3] * inv * av[3]};
    *(f4*)(o + 6 * MW) = ag;
}

constexpr int SC_T = 128, SC_NC = SEQ / SC_T, SC_SUB = 16;
__device__ __forceinline__ float dpp_add8(float v) {
    v += __builtin_bit_cast(float, __builtin_amdgcn_mov_dpp(__builtin_bit_cast(int, v), 0xB1, 0xf, 0xf, true));
    v += __builtin_bit_cast(float, __builtin_amdgcn_mov_dpp(__builtin_bit_cast(int, v), 0x4E, 0xf, 0xf, true));
    v += __builtin_bit_cast(float, __builtin_amdgcn_mov_dpp(__builtin_bit_cast(int, v), 0x141, 0xf, 0xf, true));
    return v;
}
template <int RPL, int MODE>
__device__ __forceinline__ void scan_chunk_pair(LAS unsigned char* lds, const float* rw, float* pq, const float* sinit, bf16_t* o_rwkv, const float* r_k, const float* ln_g, const float* ln_b,
                                                int u0, int nunits, int wv) {
    const int tid = tid_now(wv), tu = tid & 255, ui = tid >> 8, lane = tid & 63, cg = lane & 7, rbase = (((tid >> 6) & 3) * 8 + (lane >> 3)) * RPL;
    const int u = u0 + ui; const bool live = u < nunits; const int uu = live ? u : u0;
    const int bh = (MODE == 0) ? uu / (SC_NC - 1) : uu >> 4, c = (MODE == 0) ? uu % (SC_NC - 1) : uu & 15, b = bh >> 2, h = bh & 3;
    LAS f4* buf = (LAS f4*)(lds + ui * 57344);
    LAS float* yb = (LAS float*)(lds + ui * 57344 + 49152);
    const size_t tok0 = (size_t)b * SEQ + c * SC_T;
    float s[RPL][8];
#pragma unroll
    for (int i = 0; i < RPL; ++i) {
        if (MODE == 0) {
#pragma unroll
            for (int j = 0; j < 8; ++j) s[i][j] = (rbase + i == cg * 8 + j) ? 1.f : 0.f;
        } else { const float* sp = sinit + (((size_t)bh * SC_NC + c) * 64 + rbase + i) * 64 + cg * 8; const f4 a = *(const f4*)sp, bq = *(const f4*)(sp + 4);
            s[i][0] = a.x; s[i][1] = a.y; s[i][2] = a.z; s[i][3] = a.w; s[i][4] = bq.x; s[i][5] = bq.y; s[i][6] = bq.z; s[i][7] = bq.w; }
    }
    f4 pre[6];
#define GSRC(sc, k) ((const f4*)(rw + ((tok0 + (sc) * SC_SUB + (tu + 256 * (k)) / 96) * 7 + (((tu + 256 * (k)) % 96) >> 4)) * MW + h * 64 + (((tu + 256 * (k)) % 96) & 15) * 4))
#pragma unroll
    for (int k = 0; k < 6; ++k) pre[k] = *GSRC(0, k);
    __syncthreads();
#pragma unroll
    for (int k = 0; k < 6; ++k) buf[tu + 256 * k] = pre[k];
    __syncthreads();
    for (int sc = 0; sc < SC_T / SC_SUB; ++sc) {
        if (sc + 1 < SC_T / SC_SUB) {
#pragma unroll
            for (int k = 0; k < 6; ++k) pre[k] = *GSRC(sc + 1, k);
        }
        const LAS f4* cb = buf + (sc & 1) * 1536; LAS float* ybc = yb + (sc & 1) * 1024;
        for (int i16 = 0; i16 < SC_SUB; ++i16) {
            const LAS f4* S = cb + i16 * 96;
            const f4 kk0 = S[64 + cg * 2], kk1 = S[64 + cg * 2 + 1], w0 = S[16 + cg * 2], w1 = S[16 + cg * 2 + 1], q0 = S[80 + cg * 2], q1 = S[80 + cg * 2 + 1], k0 = S[32 + cg * 2], k1 = S[32 + cg * 2 + 1];
            f4 r0, r1; if (MODE == 1) { r0 = S[cg * 2]; r1 = S[cg * 2 + 1]; }
#pragma unroll
            for (int i = 0; i < RPL; ++i) {
                float d = s[i][0] * kk0.x + s[i][1] * kk0.y + s[i][2] * kk0.z + s[i][3] * kk0.w + s[i][4] * kk1.x + s[i][5] * kk1.y + s[i][6] * kk1.z + s[i][7] * kk1.w;
                d = dpp_add8(d);
                const int row = rbase + i;
                const float sa = -d, vv = (MODE == 0) ? ((row >= 64) ? ((const LAS float*)(S + 48))[row - 64] : 0.f) : ((const LAS float*)(S + 48))[row];
                s[i][0] = s[i][0] * w0.x + sa * q0.x + vv * k0.x; s[i][1] = s[i][1] * w0.y + sa * q0.y + vv * k0.y; s[i][2] = s[i][2] * w0.z + sa * q0.z + vv * k0.z; s[i][3] = s[i][3] * w0.w + sa * q0.w + vv * k0.w;
                s[i][4] = s[i][4] * w1.x + sa * q1.x + vv * k1.x; s[i][5] = s[i][5] * w1.y + sa * q1.y + vv * k1.y; s[i][6] = s[i][6] * w1.z + sa * q1.z + vv * k1.z; s[i][7] = s[i][7] * w1.w + sa * q1.w + vv * k1.w;
                if (MODE == 1) {
                    float y = s[i][0] * r0.x + s[i][1] * r0.y + s[i][2] * r0.z + s[i][3] * r0.w + s[i][4] * r1.x + s[i][5] * r1.y + s[i][6] * r1.z + s[i][7] * r1.w;
                    y = dpp_add8(y);
                    if (cg == 0) ybc[i16 * 64 + row] = y;
                }
            }
        }
        if (sc + 1 < SC_T / SC_SUB) {
#pragma unroll
            for (int k = 0; k < 6; ++k) buf[((sc + 1) & 1) * 1536 + tu + 256 * k] = pre[k];
        }
        __syncthreads();
        if (MODE == 1 && live) {
            const int i16 = tu >> 4, q = tu & 15; const size_t tok = tok0 + sc * SC_SUB + i16;
            const f4 y = *(const LAS f4*)(ybc + i16 * 64 + q * 4);
            const float* p = rw + tok * 7 * MW + h * 64 + 4 * q;
            const f4 r = *(const f4*)p, k2 = *(const f4*)(p + 2 * MW), v = *(const f4*)(p + 3 * MW), g = *(const f4*)(p + 6 * MW);
            const f4 rk = *(const f4*)(r_k + h * 64 + 4 * q), lg = *(const f4*)(ln_g + h * 64 + 4 * q), lb = *(const f4*)(ln_b + h * 64 + 4 * q);
            const float mu = gsum16(y.x + y.y + y.z + y.w) * (1.f / 64.f); const f4 yc = y - mu;
            const float var = gsum16(yc.x * yc.x + yc.y * yc.y + yc.z * yc.z + yc.w * yc.w) * (1.f / 64.f); const float rs = 1.f / sqrtf(var + 64e-5f);
            const float bonus = gsum16(r.x * k2.x * rk.x + r.y * k2.y * rk.y + r.z * k2.z * rk.z + r.w * k2.w * rk.w);
            st4bf(o_rwkv + tok * MW + h * 64 + 4 * q, (yc * rs * lg + lb + bonus * v) * g);
        }
    }
    if (MODE == 0 && live) {
#pragma unroll
        for (int i = 0; i < RPL; ++i) { const int row = rbase + i; float* dp = pq + ((((size_t)bh * (SC_NC - 1) + c) * 2 + (row >> 6)) * 64 + (row & 63)) * 64 + cg * 8;
            *(f4*)dp = (f4){s[i][0], s[i][1], s[i][2], s[i][3]}; *(f4*)(dp + 4) = (f4){s[i][4], s[i][5], s[i][6], s[i][7]}; }
    }
    __syncthreads();
#undef GSRC
}
__device__ __forceinline__ void scan_combine_unit(LAS unsigned char* lds, const float* pq, float* sinit, int bh, int wv) {
    const int tid = tid_now(wv), lane = tid & 63, c32 = lane & 31, hi = lane >> 5, br = (wv >> 1) & 1, bc = wv & 1;
    LAS float* SL = (LAS float*)lds;
    LAS float* PL = (LAS float*)(lds + 16640);
    __syncthreads();
    for (int i = tid; i < 64 * 65; i += NT) SL[i] = 0.f;
    { float* s0 = sinit + (size_t)bh * SC_NC * 4096; for (int i = tid; i < 1024; i += NT) ((f4*)s0)[i] = (f4){0.f, 0.f, 0.f, 0.f}; }
    { const f4* pg = (const f4*)(pq + ((size_t)bh * (SC_NC - 1) * 2) * 4096);
#pragma unroll
        for (int k = 0; k < 2; ++k) ((LAS f4*)PL)[tid + 512 * k] = pg[tid + 512 * k]; }
    __syncthreads();
    for (int c = 0; c < SC_NC - 1; ++c) {
        const float* Pn = pq + (((size_t)bh * (SC_NC - 1) + c + 1) * 2) * 4096; f4 pn[2];
        if (c + 1 < SC_NC - 1) {
#pragma unroll
            for (int k = 0; k < 2; ++k) pn[k] = ((const f4*)Pn)[tid + 512 * k]; }
        f32x16_t acc;
        if (wv < 4) {
            const float* Q = pq + (((size_t)bh * (SC_NC - 1) + c) * 2 + 1) * 4096; const LAS float* P = PL + (c & 1) * 4096;
#pragma unroll
            for (int i = 0; i < 16; ++i) acc[i] = Q[(32 * br + (i & 3) + 8 * (i >> 2) + 4 * hi) * 64 + 32 * bc + c32];
#pragma unroll 8
            for (int ks = 0; ks < 32; ++ks) acc = __builtin_amdgcn_mfma_f32_32x32x2f32(SL[(32 * br + c32) * 65 + 2 * ks + hi], P[(2 * ks + hi) * 64 + 32 * bc + c32], acc, 0, 0, 0);
        }
        __syncthreads();
        if (wv < 4) { float* so = sinit + ((size_t)bh * SC_NC + c + 1) * 4096;
#pragma unroll
            for (int i = 0; i < 16; ++i) { const int row = 32 * br + (i & 3) + 8 * (i >> 2) + 4 * hi; SL[row * 65 + 32 * bc + c32] = acc[i]; so[row * 64 + 32 * bc + c32] = acc[i]; } }
        if (c + 1 < SC_NC - 1) {
#pragma unroll
            for (int k = 0; k < 2; ++k) ((LAS f4*)(PL + ((c + 1) & 1) * 4096))[tid + 512 * k] = pn[k]; }
        __syncthreads();
    }
}

constexpr int T_LD = 144;
constexpr int T_BYTES = 64 * T_LD;
__device__ __forceinline__ void tile_load(u32x4_t& kr, u32x4_t& vr, const bf16_t* ksrc, const bf16_t* vsrc, int ld, int tid, int wv) {
    kr = *(const u32x4_t*)(ksrc + (size_t)(tid >> 3) * ld + (tid & 7) * 8);
    vr = *(const u32x4_t*)(vsrc + (size_t)(tid & 63) * ld + wv * 8);
}
__device__ __forceinline__ void tile_store(LAS unsigned char* KL, LAS unsigned char* VL, const u32x4_t& kr, const u32x4_t& vr, int tid, int wv) {
    *(LAS u32x4_t*)(KL + (tid >> 3) * T_LD + (tid & 7) * 16) = kr;
    LAS unsigned short* vp = (LAS unsigned short*)(VL + (wv * 8) * T_LD + (tid & 63) * 2);
#pragma unroll
    for (int e = 0; e < 4; ++e) { vp[(2 * e) * (T_LD / 2)] = (unsigned short)(vr[e] & 0xffffu); vp[(2 * e + 1) * (T_LD / 2)] = (unsigned short)(vr[e] >> 16); }
}
__device__ __forceinline__ void st_tile(f32x16_t& s0, f32x16_t& s1, const LAS unsigned char* KL, const bf16x8_t (&qf)[4], int c, int hi) {
#pragma unroll
    for (int i = 0; i < 16; ++i) { s0[i] = 0.f; s1[i] = 0.f; }
#pragma unroll
    for (int ks = 0; ks < 4; ++ks) { const bf16x8_t k0 = *(const LAS bf16x8_t*)(KL + c * T_LD + ks * 32 + hi * 16), k1 = *(const LAS bf16x8_t*)(KL + (32 + c) * T_LD + ks * 32 + hi * 16);
        s0 = MFMA32(k0, qf[ks], s0); s1 = MFMA32(k1, qf[ks], s1); }
}
__device__ __forceinline__ void pv_tile(f32x16_t& o0, f32x16_t& o1, const LAS unsigned char* VL, const f32x16_t& p0, const f32x16_t& p1, int c, int hi) {
#pragma unroll
    for (int j4 = 0; j4 < 4; ++j4) {
        u32x4_t pw;
        if (j4 < 2) { pw[0] = cvtpk(p0[8 * j4], p0[8 * j4 + 1]); pw[1] = cvtpk(p0[8 * j4 + 2], p0[8 * j4 + 3]); pw[2] = cvtpk(p0[8 * j4 + 4], p0[8 * j4 + 5]); pw[3] = cvtpk(p0[8 * j4 + 6], p0[8 * j4 + 7]); }
        else { const int jj = j4 - 2; pw[0] = cvtpk(p1[8 * jj], p1[8 * jj + 1]); pw[1] = cvtpk(p1[8 * jj + 2], p1[8 * jj + 3]); pw[2] = cvtpk(p1[8 * jj + 4], p1[8 * jj + 5]); pw[3] = cvtpk(p1[8 * jj + 6], p1[8 * jj + 7]); }
        const bf16x8_t pf = __builtin_bit_cast(bf16x8_t, pw);
        const LAS unsigned char* v0 = VL + c * T_LD + (16 * j4 + 4 * hi) * 2; const LAS unsigned char* v1 = VL + (32 + c) * T_LD + (16 * j4 + 4 * hi) * 2;
        u32x4_t a0, a1; { const u32x2_t x = *(const LAS u32x2_t*)v0, y = *(const LAS u32x2_t*)(v0 + 16); a0[0] = x[0]; a0[1] = x[1]; a0[2] = y[0]; a0[3] = y[1]; }
        { const u32x2_t x = *(const LAS u32x2_t*)v1, y = *(const LAS u32x2_t*)(v1 + 16); a1[0] = x[0]; a1[1] = x[1]; a1[2] = y[0]; a1[3] = y[1]; }
        o0 = MFMA32(__builtin_bit_cast(bf16x8_t, a0), pf, o0); o1 = MFMA32(__builtin_bit_cast(bf16x8_t, a1), pf, o1);
    }
}

constexpr int NSA_KT = 0, NSA_VT = 2 * T_BYTES, NSA_KC = 4 * T_BYTES, NSA_VCT = NSA_KC + 128 * T_LD, VC_LD = 272, NSA_BD = NSA_VCT + 64 * VC_LD, NSA_IMP = NSA_BD + 2048, NSA_UNI = NSA_IMP + 32768;
template <bool SPECIAL>
__device__ __forceinline__ void nsa_tile(const LAS unsigned char* KL, const LAS unsigned char* VL, const bf16x8_t (&qf)[4], const LAS float* bd, float cfar, int t, int key0, int wlim, bool on,
                                         float& mrun, float& lrun, f32x16_t& o0, f32x16_t& o1, int c, int hi) {
    constexpr float C2 = 0.125f * 1.4426950408889634f; const float NEG = -__builtin_inff();
    f32x16_t s0, s1; st_tile(s0, s1, KL, qf, c, hi);
    float tmax = NEG;
    if (SPECIAL) {
#pragma unroll
        for (int i = 0; i < 16; ++i) { const int d0 = t - (key0 + (i & 3) + 8 * (i >> 2) + 4 * hi), d1 = d0 - 32;
            const int i0 = d0 < 0 ? 0 : (d0 < 127 ? d0 : 127), i1 = d1 < 0 ? 0 : (d1 < 127 ? d1 : 127);
            s0[i] = (on && d0 >= 0 && d0 < wlim) ? s0[i] * C2 + bd[i0] : NEG; s1[i] = (on && d1 >= 0 && d1 < wlim) ? s1[i] * C2 + bd[i1] : NEG;
            tmax = fmaxf(tmax, fmaxf(s0[i], s1[i])); }
    } else {
#pragma unroll
        for (int i = 0; i < 16; ++i) { s0[i] = on ? s0[i] * C2 + cfar : NEG; s1[i] = on ? s1[i] * C2 + cfar : NEG; tmax = fmaxf(tmax, fmaxf(s0[i], s1[i])); }
    }
    tmax = fmaxf(tmax, xhalf(tmax));
    const float mn = fmaxf(mrun, tmax), alpha = __builtin_amdgcn_exp2f(mrun - mn); mrun = mn;
    float ps = 0.f;
#pragma unroll
    for (int i = 0; i < 16; ++i) { s0[i] = __builtin_amdgcn_exp2f(s0[i] - mn); s1[i] = __builtin_amdgcn_exp2f(s1[i] - mn); ps += s0[i] + s1[i]; }
    lrun = lrun * alpha + ps;
    o0 *= alpha; o1 *= alpha;
    pv_tile(o0, o1, VL, s0, s1, c, hi);
}
__device__ __forceinline__ void nsa_unit(LAS unsigned char* lds, const bf16_t* z, const float* ngl, const bf16_t* kcg, const bf16_t* vctg, const float* biasd_g, bf16_t* o_nsa, int b, int qt, int wv) {
    const int tid = tid_now(wv), lane = tid & 63, c = lane & 31, hi = lane >> 5, h = wv & 3, th = wv >> 2;
    const int t = 64 * qt + 32 * th + c; const size_t row = (size_t)b * SEQ + t;
    LAS unsigned char* KC = lds + NSA_KC; LAS unsigned char* VCT = lds + NSA_VCT; LAS float* BD = (LAS float*)(lds + NSA_BD); LAS float* IMPH = (LAS float*)(lds + NSA_IMP); LAS unsigned* UNI = (LAS unsigned*)(lds + NSA_UNI);
    constexpr float C2 = 0.125f * 1.4426950408889634f, L2E = 1.4426950408889634f; const float NEG = -__builtin_inff();
    __syncthreads();
#pragma unroll
    for (int k = 0; k < 2; ++k) { const int idx = tid + 512 * k; *(LAS u32x4_t*)(KC + (idx >> 3) * T_LD + (idx & 7) * 16) = *(const u32x4_t*)(kcg + (size_t)b * 128 * 64 + idx * 8);
        *(LAS u32x4_t*)(VCT + (idx >> 4) * VC_LD + (idx & 15) * 16) = *(const u32x4_t*)(vctg + (size_t)b * 64 * 128 + idx * 8); }
    BD[tid] = biasd_g[tid] * L2E;
    bf16x8_t qf[4];
    { const bf16_t* qr = z + row * ZLD + C_Q + h * 64 + 8 * hi;
#pragma unroll
        for (int ks = 0; ks < 4; ++ks) qf[ks] = *(const bf16x8_t*)(qr + 16 * ks); }
    const float* gp = ngl + row * 12 + h * 3; const float g0 = sigmoidf_(gp[0]), g1 = sigmoidf_(gp[1]), g2 = sigmoidf_(gp[2]);
    __syncthreads();
    const LAS float* bd = BD + h * 128; const float cfar = bd[127];
    f32x16_t out0, out1;
    {
        const int nv = (t >= 31) ? ((t - 31) >> 4) + 1 : 0;
        f32x16_t s[4];
#pragma unroll
        for (int kb = 0; kb < 4; ++kb) {
#pragma unroll
            for (int i = 0; i < 16; ++i) s[kb][i] = 0.f;
#pragma unroll
            for (int ks = 0; ks < 4; ++ks) s[kb] = MFMA32(*(const LAS bf16x8_t*)(KC + (32 * kb + c) * T_LD + ks * 32 + hi * 16), qf[ks], s[kb]); }
        float m = -1e30f;
#pragma unroll
        for (int kb = 0; kb < 4; ++kb)
#pragma unroll
            for (int i = 0; i < 16; ++i) { const int n = 32 * kb + (i & 3) + 8 * (i >> 2) + 4 * hi, dd = t - (16 * n + 31); const int di = dd < 0 ? 0 : (dd < 127 ? dd : 127);
                s[kb][i] = (n < nv) ? s[kb][i] * C2 + bd[di] : NEG; m = fmaxf(m, s[kb][i]); }
        m = fmaxf(m, xhalf(m));
        float l = 0.f;
#pragma unroll
        for (int kb = 0; kb < 4; ++kb)
#pragma unroll
            for (int i = 0; i < 16; ++i) { s[kb][i] = __builtin_amdgcn_exp2f(s[kb][i] - m); l += s[kb][i]; }
        l += xhalf(l); const float inv = (l > 0.f) ? 1.f / l : 0.f;
#pragma unroll
        for (int kb = 0; kb < 4; ++kb) s[kb] *= inv;
        float part[16], cr[16];
#pragma unroll
        for (int kb = 0; kb < 4; ++kb)
#pragma unroll
            for (int a = 0; a < 4; ++a) { part[kb * 4 + a] = s[kb][4 * a] + s[kb][4 * a + 1] + s[kb][4 * a + 2] + 0.5f * s[kb][4 * a + 3]; cr[kb * 4 + a] = 0.5f * s[kb][4 * a + 3]; }
        { float prev = 0.f;
#pragma unroll
            for (int sl = 0; sl < 16; ++sl) { const float xc = xhalf(cr[sl]); part[sl] += hi ? xc : prev; prev = xc; } }
        { LAS float* ip = IMPH + (h * 64 + 32 * th + c) * 32 + hi;
#pragma unroll
            for (int sl = 0; sl < 16; ++sl) ip[2 * sl] = part[sl]; }
#pragma unroll
        for (int i = 0; i < 16; ++i) { out0[i] = 0.f; out1[i] = 0.f; }
#pragma unroll
        for (int j8 = 0; j8 < 8; ++j8) { const f32x16_t& pp = s[j8 >> 1]; const int jj = j8 & 1; u32x4_t pw;
            pw[0] = cvtpk(pp[8 * jj], pp[8 * jj + 1]); pw[1] = cvtpk(pp[8 * jj + 2], pp[8 * jj + 3]); pw[2] = cvtpk(pp[8 * jj + 4], pp[8 * jj + 5]); pw[3] = cvtpk(pp[8 * jj + 6], pp[8 * jj + 7]);
            const bf16x8_t pf = __builtin_bit_cast(bf16x8_t, pw);
            const LAS unsigned char* v0 = VCT + c * VC_LD + (16 * j8 + 4 * hi) * 2; const LAS unsigned char* v1 = VCT + (32 + c) * VC_LD + (16 * j8 + 4 * hi) * 2;
            u32x4_t a0, a1; { const u32x2_t x = *(const LAS u32x2_t*)v0, y = *(const LAS u32x2_t*)(v0 + 16); a0[0] = x[0]; a0[1] = x[1]; a0[2] = y[0]; a0[3] = y[1]; }
            { const u32x2_t x = *(const LAS u32x2_t*)v1, y = *(const LAS u32x2_t*)(v1 + 16); a1[0] = x[0]; a1[1] = x[1]; a1[2] = y[0]; a1[3] = y[1]; }
            out0 = MFMA32(__builtin_bit_cast(bf16x8_t, a0), pf, out0); out1 = MFMA32(__builtin_bit_cast(bf16x8_t, a1), pf, out1); }
        out0 *= g0; out1 *= g0;
    }
    __syncthreads();
    unsigned sel = 0u;
    {
        float v[16];
        const LAS float* ip = IMPH + (32 * th + c) * 32 + 16 * hi;
#pragma unroll
        for (int j = 0; j < 16; ++j) { const int mb = 16 * hi + j; float x = ((ip[j] + ip[64 * 32 + j]) + ip[2 * 64 * 32 + j]) + ip[3 * 64 * 32 + j];
            if (mb == 0 || mb == qt || mb == qt - 1) x += 1e4f; v[j] = (mb <= qt) ? x : NEG; }
        for (int r = 0; r < 8; ++r) {
            float best = NEG; int bi = 0;
#pragma unroll
            for (int j = 0; j < 16; ++j) if (v[j] > best) { best = v[j]; bi = j; }
            const float ob = xhalf(best); const int oi = __shfl_xor(bi, 32);
            const float lowv = hi ? ob : best, highv = hi ? best : ob; const int lowi = hi ? oi : bi, highi = (hi ? bi : oi) + 16;
            const bool lowwin = lowv >= highv; const float wval = lowwin ? lowv : highv; const int widx = lowwin ? lowi : highi;
            if (wval > NEG) { sel |= 1u << widx;
#pragma unroll
                for (int j = 0; j < 16; ++j) if (16 * hi + j == widx) v[j] = NEG; }
        }
        unsigned uni = 0u;
        for (int mb = 0; mb <= qt; ++mb) if (__ballot((sel >> mb) & 1u) != 0ull) uni |= 1u << mb;
        if (h == 0 && lane == 0) UNI[th] = uni;
    }
    __syncthreads();
    const unsigned uni = UNI[0] | UNI[1];
    const bf16_t* zb = z + (size_t)b * SEQ * ZLD;
    u32x4_t kr, vr;
    {
        float mrun = -1e30f, lrun = 0.f; f32x16_t o0, o1;
#pragma unroll
        for (int i = 0; i < 16; ++i) { o0[i] = 0.f; o1[i] = 0.f; }
        unsigned rem = uni; int blk = __builtin_ctz(rem); rem &= rem - 1u;
        tile_load(kr, vr, zb + (size_t)blk * 64 * ZLD + C_KS, zb + (size_t)blk * 64 * ZLD + C_VS, ZLD, tid, wv);
        tile_store(lds + NSA_KT, lds + NSA_VT, kr, vr, tid, wv);
        __syncthreads();
        for (int it = 0;; ++it) {
            const bool nxt = rem != 0u; const int nb = nxt ? __builtin_ctz(rem) : 0; rem &= rem - 1u;
            if (nxt) tile_load(kr, vr, zb + (size_t)nb * 64 * ZLD + C_KS, zb + (size_t)nb * 64 * ZLD + C_VS, ZLD, tid, wv);
            const LAS unsigned char* KL = lds + NSA_KT + (it & 1) * T_BYTES; const LAS unsigned char* VL = lds + NSA_VT + (it & 1) * T_BYTES;
            const bool on = (sel >> blk) & 1u;
            if (qt - blk <= 2) nsa_tile<true>(KL, VL, qf, bd, cfar, t, 64 * blk, 1 << 30, on, mrun, lrun, o0, o1, c, hi);
            else nsa_tile<false>(KL, VL, qf, bd, cfar, t, 64 * blk, 1 << 30, on, mrun, lrun, o0, o1, c, hi);
            if (nxt) tile_store(lds + NSA_KT + ((it + 1) & 1) * T_BYTES, lds + NSA_VT + ((it + 1) & 1) * T_BYTES, kr, vr, tid, wv);
            __syncthreads();
            if (!nxt) break;
            blk = nb;
        }
        lrun += xhalf(lrun); const float sc = g1 / lrun;
        out0 += o0 * sc; out1 += o1 * sc;
    }
    {
        float mrun = -1e30f, lrun = 0.f; f32x16_t o0, o1;
#pragma unroll
        for (int i = 0; i < 16; ++i) { o0[i] = 0.f; o1[i] = 0.f; }
        const int tb0 = qt >= 8 ? qt - 8 : 0;
        tile_load(kr, vr, zb + (size_t)tb0 * 64 * ZLD + C_KW, zb + (size_t)tb0 * 64 * ZLD + C_VW, ZLD, tid, wv);
        tile_store(lds + NSA_KT, lds + NSA_VT, kr, vr, tid, wv);
        __syncthreads();
        for (int tb = tb0; tb <= qt; ++tb) {
            const int it = tb - tb0; const bool nxt = tb < qt;
            if (nxt) tile_load(kr, vr, zb + (size_t)(tb + 1) * 64 * ZLD + C_KW, zb + (size_t)(tb + 1) * 64 * ZLD + C_VW, ZLD, tid, wv);
            const LAS unsigned char* KL = lds + NSA_KT + (it & 1) * T_BYTES; const LAS unsigned char* VL = lds + NSA_VT + (it & 1) * T_BYTES;
            if (qt - tb <= 2 || qt - tb == 8) nsa_tile<true>(KL, VL, qf, bd, cfar, t, 64 * tb, 512, true, mrun, lrun, o0, o1, c, hi);
            else nsa_tile<false>(KL, VL, qf, bd, cfar, t, 64 * tb, 512, true, mrun, lrun, o0, o1, c, hi);
            if (nxt) tile_store(lds + NSA_KT + ((it + 1) & 1) * T_BYTES, lds + NSA_VT + ((it + 1) & 1) * T_BYTES, kr, vr, tid, wv);
            __syncthreads();
        }
        lrun += xhalf(lrun); const float sc = g2 / lrun;
        out0 += o0 * sc; out1 += o1 * sc;
    }
    bf16_t* op = o_nsa + row * MW + h * 64;
#pragma unroll
    for (int a = 0; a < 4; ++a) { u32x2_t u0, u1; u0[0] = cvtpk(out0[4 * a], out0[4 * a + 1]); u0[1] = cvtpk(out0[4 * a + 2], out0[4 * a + 3]); u1[0] = cvtpk(out1[4 * a], out1[4 * a + 1]); u1[1] = cvtpk(out1[4 * a + 2], out1[4 * a + 3]);
        *(u32x2_t*)(op + 8 * a + 4 * hi) = u0; *(u32x2_t*)(op + 32 + 8 * a + 4 * hi) = u1; }
}

__device__ __forceinline__ void ret_unit(LAS unsigned char* lds, const bf16_t* z, const float* norm_g, bf16_t* o_ret, int b, int h, int q8, int wv) {
    const int tid = tid_now(wv), lane = tid & 63, c = lane & 31, hi = lane >> 5, w = wv;
    const int t = 256 * q8 + 32 * w + c; const size_t row = (size_t)b * SEQ + t;
    const int ntiles = 4 * q8 + 4, ktd = 4 * q8 + (w >> 1);
    const float lg2 = log2f(1.f - exp2f(-5.f - (float)h));
    bf16x8_t qf[4];
    { const bf16_t* qr = z + row * ZLD + C_RQ + h * 64 + 8 * hi;
#pragma unroll
        for (int ks = 0; ks < 4; ++ks) qf[ks] = *(const bf16x8_t*)(qr + 16 * ks); }
    f32x16_t bc0, bc1, o0, o1;
#pragma unroll
    for (int i = 0; i < 16; ++i) { const int j = (i & 3) + 8 * (i >> 2) + 4 * hi; bc0[i] = exp2f((float)(63 - j) * lg2); bc1[i] = exp2f((float)(31 - j) * lg2); o0[i] = 0.f; o1[i] = 0.f; }
    const float g64 = exp2f(64.f * lg2);
    const bf16_t* kbase = z + (size_t)b * SEQ * ZLD + C_RK + h * 64; const bf16_t* vbase = z + (size_t)b * SEQ * ZLD + C_RV + h * 64;
    u32x4_t kr, vr;
    __syncthreads();
    tile_load(kr, vr, kbase, vbase, ZLD, tid, wv);
    tile_store(lds, lds + 2 * T_BYTES, kr, vr, tid, wv);
    __syncthreads();
    for (int kt = 0; kt < ntiles; ++kt) {
        const bool nxt = kt + 1 < ntiles;
        if (nxt) tile_load(kr, vr, kbase + (size_t)(kt + 1) * 64 * ZLD, vbase + (size_t)(kt + 1) * 64 * ZLD, ZLD, tid, wv);
        if (kt <= ktd) {
            const LAS unsigned char* KL = lds + (kt & 1) * T_BYTES; const LAS unsigned char* VL = lds + (2 + (kt & 1)) * T_BYTES;
            f32x16_t s0, s1; st_tile(s0, s1, KL, qf, c, hi);
            s0 *= bc0; s1 *= bc1;
            if (kt == ktd) {
#pragma unroll
                for (int i = 0; i < 16; ++i) { const int key = 64 * kt + (i & 3) + 8 * (i >> 2) + 4 * hi; if (key > t) s0[i] = 0.f; if (key + 32 > t) s1[i] = 0.f; } }
            o0 *= g64; o1 *= g64;
            pv_tile(o0, o1, VL, s0, s1, c, hi);
        }
        if (nxt) tile_store(lds + ((kt + 1) & 1) * T_BYTES, lds + (2 + ((kt + 1) & 1)) * T_BYTES, kr, vr, tid, wv);
        __syncthreads();
    }
    const float fin = exp2f((float)(t - 64 * ktd - 63) * lg2);
    o0 *= fin; o1 *= fin;
    float sm = 0.f;
#pragma unroll
    for (int i = 0; i < 16; ++i) sm += o0[i] + o1[i];
    sm += xhalf(sm); const float mu = sm * (1.f / 64.f);
    float var = 0.f;
#pragma unroll
    for (int i = 0; i < 16; ++i) { o0[i] -= mu; o1[i] -= mu; var += o0[i] * o0[i] + o1[i] * o1[i]; }
    var += xhalf(var); const float rs = 1.f / sqrtf(var * (1.f / 64.f) + 1e-5f);
    const bf16_t* gr = z + row * ZLD + C_RG + h * 64; bf16_t* op = o_ret + row * MW + h * 64;
#pragma unroll
    for (int db = 0; db < 2; ++db)
#pragma unroll
        for (int a = 0; a < 4; ++a) { const int d = 32 * db + 8 * a + 4 * hi; const f4 g = ld4bf(gr + d), ng = *(const f4*)(norm_g + h * 64 + d); f4 v;
            const f32x16_t& oo = db ? o1 : o0;
            v.x = g.x * sigmoidf_(g.x) * oo[4 * a] * rs * ng.x; v.y = g.y * sigmoidf_(g.y) * oo[4 * a + 1] * rs * ng.y; v.z = g.z * sigmoidf_(g.z) * oo[4 * a + 2] * rs * ng.z; v.w = g.w * sigmoidf_(g.w) * oo[4 * a + 3] * rs * ng.w;
            st4bf(op + d, v); }
}

constexpr int XA_LD = 528;
__device__ __forceinline__ void xattn_unit(LAS unsigned char* lds, const bf16_t* Q, const bf16_t* Kx, const bf16_t* VT, bf16_t* O, int b, int hh, int qt, int wv) {
    const int tid = tid_now(wv), lane = tid & 63, c = lane & 31, hi = lane >> 5, w = wv;
    LAS unsigned char* QL = lds; LAS unsigned char* PL = lds + 64 * XA_LD; LAS float* RMAX = (LAS float*)(lds + 2 * 64 * XA_LD); LAS float* RSUM = RMAX + 512;
    const size_t tok0 = (size_t)b * SEQ + qt * 64;
    __syncthreads();
#pragma unroll
    for (int k = 0; k < 4; ++k) { const int idx = tid + 512 * k, r = idx >> 5, ch = idx & 31; *(LAS u32x4_t*)(QL + r * XA_LD + ch * 16) = *(const u32x4_t*)(Q + (tok0 + r) * DM + hh * 256 + ch * 8); }
    bf16x8_t af[16];
    { const bf16_t* kr = Kx + (size_t)(b * MEMLEN + 32 * w + c) * DM + hh * 256 + 8 * hi;
#pragma unroll
        for (int ks = 0; ks < 16; ++ks) af[ks] = *(const bf16x8_t*)(kr + 16 * ks); }
    __syncthreads();
    f32x16_t s0, s1;
#pragma unroll
    for (int i = 0; i < 16; ++i) { s0[i] = 0.f; s1[i] = 0.f; }
#pragma unroll
    for (int ks = 0; ks < 16; ++ks) { const bf16x8_t q0 = *(const LAS bf16x8_t*)(QL + c * XA_LD + ks * 32 + hi * 16), q1 = *(const LAS bf16x8_t*)(QL + (32 + c) * XA_LD + ks * 32 + hi * 16);
        s0 = MFMA32(af[ks], q0, s0); s1 = MFMA32(af[ks], q1, s1); }
    constexpr float C2 = 0.0625f * 1.4426950408889634f;
    float m0 = s0[0], m1 = s1[0];
#pragma unroll
    for (int i = 1; i < 16; ++i) { m0 = fmaxf(m0, s0[i]); m1 = fmaxf(m1, s1[i]); }
    m0 = fmaxf(m0, xhalf(m0)); m1 = fmaxf(m1, xhalf(m1));
    if (hi == 0) { RMAX[w * 64 + c] = m0; RMAX[w * 64 + 32 + c] = m1; }
    __syncthreads();
    float g0 = RMAX[c], g1 = RMAX[32 + c];
#pragma unroll
    for (int ww = 1; ww < 8; ++ww) { g0 = fmaxf(g0, RMAX[ww * 64 + c]); g1 = fmaxf(g1, RMAX[ww * 64 + 32 + c]); }
    float l0 = 0.f, l1 = 0.f;
#pragma unroll
    for (int i = 0; i < 16; ++i) { s0[i] = __builtin_amdgcn_exp2f((s0[i] - g0) * C2); s1[i] = __builtin_amdgcn_exp2f((s1[i] - g1) * C2); l0 += s0[i]; l1 += s1[i]; }
    l0 += xhalf(l0); l1 += xhalf(l1);
    if (hi == 0) { RSUM[w * 64 + c] = l0; RSUM[w * 64 + 32 + c] = l1; }
#pragma unroll
    for (int a = 0; a < 4; ++a) { u32x2_t u0, u1; u0.x = cvtpk(s0[4 * a], s0[4 * a + 1]); u0.y = cvtpk(s0[4 * a + 2], s0[4 * a + 3]); u1.x = cvtpk(s1[4 * a], s1[4 * a + 1]); u1.y = cvtpk(s1[4 * a + 2], s1[4 * a + 3]);
        *(LAS u32x2_t*)(PL + c * XA_LD + (32 * w + 8 * a + 4 * hi) * 2) = u0; *(LAS u32x2_t*)(PL + (32 + c) * XA_LD + (32 * w + 8 * a + 4 * hi) * 2) = u1; }
    { const bf16_t* vr = VT + (size_t)(hh * 256 + 32 * w + c) * (BATCH * MEMLEN) + b * MEMLEN + 8 * hi;
#pragma unroll
        for (int j = 0; j < 16; ++j) af[j] = *(const bf16x8_t*)(vr + 16 * j); }
    __syncthreads();
    float t0 = RSUM[c], t1 = RSUM[32 + c];
#pragma unroll
    for (int ww = 1; ww < 8; ++ww) { t0 += RSUM[ww * 64 + c]; t1 += RSUM[ww * 64 + 32 + c]; }
#pragma unroll
    for (int i = 0; i < 16; ++i) { s0[i] = 0.f; s1[i] = 0.f; }
#pragma unroll
    for (int j = 0; j < 16; ++j) { const bf16x8_t p0 = *(const LAS bf16x8_t*)(PL + c * XA_LD + j * 32 + hi * 16), p1 = *(const LAS bf16x8_t*)(PL + (32 + c) * XA_LD + j * 32 + hi * 16);
        s0 = MFMA32(af[j], p0, s0); s1 = MFMA32(af[j], p1, s1); }
    const float i0 = 1.f / t0, i1 = 1.f / t1;
#pragma unroll
    for (int a = 0; a < 4; ++a) { u32x2_t u0, u1; u0.x = cvtpk(s0[4 * a] * i0, s0[4 * a + 1] * i0); u0.y = cvtpk(s0[4 * a + 2] * i0, s0[4 * a + 3] * i0); u1.x = cvtpk(s1[4 * a] * i1, s1[4 * a + 1] * i1); u1.y = cvtpk(s1[4 * a + 2] * i1, s1[4 * a + 3] * i1);
        *(u32x2_t*)(O + (tok0 + c) * DM + hh * 256 + 32 * w + 8 * a + 4 * hi) = u0; *(u32x2_t*)(O + (tok0 + 32 + c) * DM + hh * 256 + 32 * w + 8 * a + 4 * hi) = u1; }
}

constexpr int NPL = 15, NPHASES = 1 + DEPTH * NPL;
typedef const __attribute__((address_space(4))) unsigned char* kaptr_t;
#define PHASE_ENV \
    kaptr_t ka_ = (kaptr_t)__builtin_amdgcn_kernarg_segment_ptr(); asm volatile("" : "+s"(ka_)); \
    const float* const* P = (const float* const*)ka_; float* const OUT = (float*)P[33]; unsigned char* const ws = (unsigned char*)P[34]; (void)OUT; (void)ws; \
    int G = G0, bid = (int)blockIdx.x, wv = wv0; asm volatile("" : "+s"(G), "+s"(bid), "+s"(wv)); const int NGW = G * NWAVES, NGT = G * NT; (void)NGW; (void)NGT; \
    const int tid = tid_now(wv), lane = tid & 63, wave = wv, gw = bid * NWAVES + wave, gt = bid * NT + tid; (void)lane; (void)gw; (void)gt; \
    LAS unsigned char* lds = lds0; asm volatile("" : "+s"(lds));
#define WSF(off) ((float*)(ws + (off)))
#define WSB(off) ((bf16_t*)(ws + (off)))
#define IN(k) (lo <= (k) && (k) < hi)
#if MK_PER_PHASE
#define SEAM() do { } while (0)
#else
#define SEAM() do { XcdBarrier b_ = bar; asm volatile("" : "+s"(b_.bar), "+s"(b_.x), "+s"(b_.st), "+s"(b_.wv)); xcd_barrier(b_); } while (0)
#endif
template <int l>
__device__ __forceinline__ void layer_phases(LAS unsigned char* const lds0, const int G0, const int wv0, const int lo, const int hi, const XcdBarrier& bar) {
        const int pb = 1 + l * NPL;
        if (IN(pb + 0)) { PHASE_ENV pg8::Epi<1> E{WSB(WS_Z), ZLD, WSB(WS_ZG), nullptr, nullptr, 0}; gemm_run<1>(lds, WSB(WS_H), WSB(WS_W) + WO_IN, MTOK, NZ, DM, E, wv, G, bid); SEAM(); }
        if (IN(pb + 1)) {
            PHASE_ENV
            bf16_t* Z = WSB(WS_Z); float* TABC = WSF(WS_TAB); float* TABS = TABC + 65536;
            for (int u = gw; u < BATCH * 128 * 2; u += NGW) nsa_compress_unit(Z, P[4] + (size_t)l * 2 * 32 * 64 * 64, P[5] + (size_t)l * 32 * 64, WSB(WS_CMP), WSB(WS_CMP) + BATCH * 128 * 64, u, lane);
            { LAS float* scr = (LAS float*)lds + wave * 128; float* RW = WSF(WS_RW); for (int tok = gw; tok < MTOK; tok += NGW) rwkv_prep_token(Z, RW, P, l, tok, lane, scr); }
            { const float* cw = P[19] + (size_t)l * 3 * MW; bf16_t* oc = WSB(WS_BR) + (size_t)3 * MTOK * MW;
                for (int i = gt; i < MTOK * 64; i += NGT) { const int tok = i >> 6, c4 = (i & 63) * 4, t = tok % SEQ; const bf16_t* z = Z + (size_t)tok * ZLD;
                    const f4 bg = ld4bf(z + C_CB + c4); f4 u2 = ld4bf(z + C_CC + c4) * ld4bf(z + C_CX + c4);
                    f4 u1 = (f4){0.f, 0.f, 0.f, 0.f}, u0 = u1; if (t >= 1) u1 = ld4bf(z - ZLD + C_CC + c4) * ld4bf(z - ZLD + C_CX + c4); if (t >= 2) u0 = ld4bf(z - 2 * ZLD + C_CC + c4) * ld4bf(z - 2 * ZLD + C_CX + c4);
                    st4bf(oc + (size_t)tok * MW + c4, bg * (*(const f4*)(cw + c4) * u0 + *(const f4*)(cw + MW + c4) * u1 + *(const f4*)(cw + 2 * MW + c4) * u2)); } }
            for (int i = gt; i < MTOK * 2 * 4 * 32; i += NGT) { const int j = i & 31, h = (i >> 5) & 3, qk = (i >> 7) & 1, tok = i >> 8, t = tok % SEQ;
                bf16_t* p = Z + (size_t)tok * ZLD + (qk ? C_RK : C_RQ) + h * 64 + j; const float c = TABC[t * 32 + j], s = TABS[t * 32 + j], u1 = bf2f(p[0]), u2 = bf2f(p[32]), sc = qk ? 1.f : 0.125f;
                const unsigned a = pkbf((u1 * c - u2 * s) * sc, (u2 * c + u1 * s) * sc); p[0] = (bf16_t)(a & 0xffffu); p[32] = (bf16_t)(a >> 16); }
            SEAM();
        }
        if (IN(pb + 2)) {
            PHASE_ENV
            float* PQ = WSF(WS_H);
            for (int u = 2 * bid; u < 32 * (SC_NC - 1); u += 2 * G) scan_chunk_pair<4, 0>(lds, WSF(WS_RW), PQ, nullptr, nullptr, nullptr, nullptr, nullptr, u, 32 * (SC_NC - 1), wv);
            for (int u = bid; u < 256; u += G) nsa_unit(lds, WSB(WS_Z), WSF(WS_NG), WSB(WS_CMP), WSB(WS_CMP) + BATCH * 128 * 64, WSF(WS_TAB) + 131072, WSB(WS_BR), u >> 5, u & 31, wv);
            SEAM();
        }
        if (IN(pb + 3)) {
            PHASE_ENV
            if ((bid & 7) == 0 && (bid >> 3) < 32) scan_combine_unit(lds, WSF(WS_H), WSF(WS_H) + (size_t)4 * 1024 * 1024, bid >> 3, wv);
            for (int u = bid; u < 256; u += G) ret_unit(lds, WSB(WS_Z), P[7] + l * MW, WSB(WS_BR) + (size_t)MTOK * MW, u >> 5, (u >> 3) & 3, u & 7, wv);
            SEAM();
        }
        if (IN(pb + 4)) {
            PHASE_ENV
            for (int u = 2 * bid; u < 32 * SC_NC; u += 2 * G) scan_chunk_pair<2, 1>(lds, WSF(WS_RW), nullptr, WSF(WS_H) + (size_t)4 * 1024 * 1024, WSB(WS_BR) + (size_t)2 * MTOK * MW, P[16] + l * MW, P[17] + l * MW, P[18] + l * MW, u, 32 * SC_NC, wv);
            SEAM();
        }
        if (IN(pb + 5)) {
#pragma unroll 1
            for (int m = 0; m < 4; ++m) { PHASE_ENV pg8::Epi<4> E{WSB(WS_MERGED), DM, nullptr, WSF(WS_MACC), WSB(WS_ZG), m}; gemm_run<4>(lds, WSB(WS_BR) + (size_t)m * MTOK * MW, WSB(WS_W) + WO_BR + (size_t)m * DM * MW, MTOK, DM, MW, E, wv, G, bid); }
            SEAM(); }
        if (IN(pb + 6)) { PHASE_ENV pg8::Epi<3> E{nullptr, DM, nullptr, WSF(WS_Y), nullptr, 0}; gemm_run<3>(lds, WSB(WS_MERGED), WSB(WS_W) + WO_MO, MTOK, DM, DM, E, wv, G, bid); SEAM(); }
        if (IN(pb + 7)) { PHASE_ENV rowop((l == 0) ? P[0] : OUT, WSF(WS_Y), P[22] + l * DM, P[23] + l * DM, OUT, WSB(WS_H), nullptr, nullptr, gw, NGW, lane); rms_rows(P[1], P[24] + l * DM, WSB(WS_MN), BATCH * MEMLEN, nullptr, nullptr, gw, NGW, lane); SEAM(); }
        if (IN(pb + 8)) {
            { PHASE_ENV pg8::Epi<0> E{WSB(WS_Q), DM, nullptr, nullptr, nullptr, 0}; gemm_run<0>(lds, WSB(WS_H), WSB(WS_W) + WO_Q, MTOK, DM, DM, E, wv, G, bid); }
            { PHASE_ENV pg8::Epi<0> E{WSB(WS_KX), DM, nullptr, nullptr, nullptr, 0}; gemm_run<0>(lds, WSB(WS_MN), WSB(WS_W) + WO_KV, BATCH * MEMLEN, DM, DM, E, wv, G, (bid + 224) % G); }
            { PHASE_ENV pg8::Epi<0> E{WSB(WS_VT), BATCH * MEMLEN, nullptr, nullptr, nullptr, 0}; gemm_run<0>(lds, WSB(WS_W) + WO_KV + (size_t)DM * DM, WSB(WS_MN), DM, BATCH * MEMLEN, DM, E, wv, G, (bid + 192) % G); }
            SEAM(); }
        if (IN(pb + 9)) { PHASE_ENV for (int u = bid; u < BATCH * 4 * 32; u += G) xattn_unit(lds, WSB(WS_Q), WSB(WS_KX), WSB(WS_VT), WSB(WS_O), u >> 7, (u >> 5) & 3, u & 31, wv); SEAM(); }
        if (IN(pb + 10)) { PHASE_ENV pg8::Epi<3> E{nullptr, DM, nullptr, WSF(WS_Y), nullptr, 0}; gemm_run<3>(lds, WSB(WS_O), WSB(WS_W) + WO_O, MTOK, DM, DM, E, wv, G, bid); SEAM(); }
        if (IN(pb + 11)) { PHASE_ENV rowop(OUT, WSF(WS_Y), P[28] + l * DM, P[29] + l * DM, OUT, WSB(WS_H), nullptr, nullptr, gw, NGW, lane); SEAM(); }
        if (IN(pb + 12)) { PHASE_ENV pg8::Epi<2> E{WSB(WS_HID), DFF, nullptr, nullptr, nullptr, 0}; gemm_run<2>(lds, WSB(WS_H), WSB(WS_W) + WO_1, MTOK, DFF, DM, E, wv, G, bid); SEAM(); }
        if (IN(pb + 13)) { PHASE_ENV pg8::Epi<3> E{nullptr, DM, nullptr, WSF(WS_Y), nullptr, 0}; gemm_run<3>(lds, WSB(WS_HID), WSB(WS_W) + WO_2, MTOK, DM, DFF, E, wv, G, bid); SEAM(); }
        if (IN(pb + 14)) {
            PHASE_ENV
            if (l + 1 < DEPTH) { convert_layer(P, l + 1, WSB(WS_W), lds, wave, lane, gw, NGW); __syncthreads(); stage_wng((LAS float*)lds, P[3] + (size_t)(l + 1) * DM * IN_COLS, tid); __syncthreads();
                rowop(OUT, WSF(WS_Y), P[32] + l * DM, P[2] + (l + 1) * DM, OUT, WSB(WS_H), (const LAS float*)lds, WSF(WS_NG), gw, NGW, lane); }
            else rowop(OUT, WSF(WS_Y), P[32] + l * DM, nullptr, OUT, WSB(WS_H), nullptr, nullptr, gw, NGW, lane);
            SEAM(); }
    }

__global__ void __launch_bounds__(NT, 2) mk_fwd(Args args) {
    extern __shared__ __attribute__((aligned(16))) unsigned char lds_raw[];
    LAS unsigned char* const lds0 = (LAS unsigned char*)lds_raw;
    const int G0 = gridDim.x;
    const int wv0 = __builtin_amdgcn_readfirstlane((int)threadIdx.x >> 6);
    const int lo = args.ph_lo, hi = args.ph_hi;
#if MK_PER_PHASE
    XcdBarrier bar; bar.bar = nullptr; bar.x = 0; bar.wv = 0; bar.st = nullptr;
#else
    { const int t0 = tid_now(wv0); if (t0 < 4) ((LAS unsigned*)(lds0 + XB_LDS_OFF))[t0] = 0u; }
    __syncthreads();
    const XcdBarrier bar = xcd_barrier_post((unsigned*)(args.ws + WS_CTL) + CW_BAR, (volatile LAS unsigned*)(lds0 + XB_LDS_OFF), wv0);
#endif

    if (IN(0)) {
        PHASE_ENV
        float* TABC = WSF(WS_TAB); float* TABS = TABC + 65536; float* BIASD = TABC + 131072;
        for (int i = gt; i < SEQ * 32; i += NGT) { const int t = i >> 5, j = i & 31; const double rev = (double)t * INVF_REV[j]; const float fr = (float)(rev - floor(rev)); TABC[i] = __builtin_amdgcn_cosf(fr); TABS[i] = __builtin_amdgcn_sinf(fr); }
        for (int i = gt; i < 512; i += NGT) { const int h = i >> 7, d = i & 127; BIASD[i] = P[6][T5B[d] * MH + h]; }
        convert_layer(P, 0, WSB(WS_W), lds, wave, lane, gw, NGW);
        __syncthreads();
        stage_wng((LAS float*)lds, P[3], tid);
        __syncthreads();
        rms_rows(P[0], P[2], WSB(WS_H), MTOK, (const LAS float*)lds, WSF(WS_NG), gw, NGW, lane);
        SEAM();
    }
    layer_phases<0>(lds0, G0, wv0, lo, hi, bar); layer_phases<1>(lds0, G0, wv0, lo, hi, bar); layer_phases<2>(lds0, G0, wv0, lo, hi, bar); layer_phases<3>(lds0, G0, wv0, lo, hi, bar);
#undef IN
}

extern "C" void kernel_launch(void* const* d_in, const int* in_sizes, int n_in, void* d_out, int out_size, void* d_ws, size_t ws_size, hipStream_t stream) {
    static int grid = 0;
    if (grid == 0) {
        if (n_in != 33 || out_size != MTOK * DM || ws_size < WS_END) { fprintf(stderr, "kernel_launch: unexpected shapes (n_in %d out %d ws %zu)\n", n_in, out_size, ws_size); grid = -1; return; }
        int dev = 0, cus = 0;
        if (hipGetDevice(&dev) != hipSuccess || hipDeviceGetAttribute(&cus, hipDeviceAttributeMultiprocessorCount, dev) != hipSuccess) { grid = -1; return; }
        if (hipFuncSetAttribute((const void*)mk_fwd, hipFuncAttributeMaxDynamicSharedMemorySize, LDS_BYTES) != hipSuccess) { fprintf(stderr, "kernel_launch: hipFuncSetAttribute failed\n"); grid = -1; return; }
        grid = cus;
    }
    if (grid < 0) return;
    (void)hipMemsetAsync((char*)d_ws + WS_CTL, 0, 1 * MiB, stream);
    Args a{};
    for (int i = 0; i < 33; ++i) a.in[i] = (const float*)d_in[i];
    a.out = (float*)d_out; a.ws = (unsigned char*)d_ws;
#if MK_PER_PHASE
    for (int p = 0; p < NPHASES; ++p) { a.ph_lo = p; a.ph_hi = p + 1; hipLaunchKernelGGL(mk_fwd, dim3(grid), dim3(NT), LDS_BYTES, stream, a); }
#else
    a.ph_lo = 0; a.ph_hi = NPHASES; hipLaunchKernelGGL(mk_fwd, dim3(grid), dim3(NT), LDS_BYTES, stream, a);
#endif
}
```

```cpp
#include <hip/hip_runtime.h>
#include <cstdio>
#include <cstdint>

#ifndef MK_PER_PHASE
#define MK_PER_PHASE 0
#endif
#define LAS __attribute__((address_space(3)))
typedef float f4 __attribute__((ext_vector_type(4)));
typedef unsigned short bf16_t;

constexpr int NWAVES = 8, NT = 512;
constexpr int BATCH = 8, SEQ = 2048, DM = 1024, DEPTH = 4, MTOK = BATCH * SEQ;
constexpr int MEMLEN = 256, MW = 256, HD = 64, MH = 4, DFF = 4096;
constexpr int IN_COLS = 7436, GATE_OFF = 3340;
constexpr int ZLD = 3328, NZ = 7424;
constexpr int NCMP = 127;
constexpr int C_Q = 0, C_KC = 256, C_VC = 320, C_KS = 384, C_VS = 448, C_KW = 512, C_VW = 576;
constexpr int C_RQ = 640, C_RK = 896, C_RV = 1152, C_RG = 1408, C_RW = 1664, C_CB = 2560, C_CC = 2816, C_CX = 3072;
constexpr int RWKV_COLS = 896;

constexpr size_t MiB = 1u << 20;
constexpr size_t WS_CTL = 0, WS_TAB = 1 * MiB, WS_CMP = 2 * MiB, WS_NG = 3 * MiB;
constexpr size_t WS_W = 4 * MiB;
constexpr size_t WS_H = 47 * MiB;
constexpr size_t WS_Z = 79 * MiB;
constexpr size_t WS_ZG = 183 * MiB;
constexpr size_t WS_RW = 311 * MiB;
constexpr size_t WS_BR = 423 * MiB;
constexpr size_t WS_MACC = 79 * MiB, WS_MERGED = 143 * MiB;
constexpr size_t WS_Q = 183 * MiB, WS_O = 247 * MiB, WS_KX = 279 * MiB, WS_VT = 283 * MiB, WS_MN = 295 * MiB, WS_HID = 183 * MiB;
constexpr size_t WS_Y = 311 * MiB;
constexpr size_t WS_END = 455 * MiB;
constexpr size_t WO_IN = 0, WO_BR = WO_IN + (size_t)NZ * DM, WO_MO = WO_BR + (size_t)4 * DM * MW, WO_Q = WO_MO + (size_t)DM * DM, WO_KV = WO_Q + (size_t)DM * DM,
                 WO_O = WO_KV + (size_t)2 * DM * DM, WO_1 = WO_O + (size_t)DM * DM, WO_2 = WO_1 + (size_t)DFF * DM, WO_CMP = WO_2 + (size_t)DFF * DM, WO_END = WO_CMP + (size_t)2 * 64 * 2048;
static_assert(WS_W + WO_END * 2 <= WS_H, "weight copies fit");
constexpr int LDS_BYTES = 147456, XB_LDS_OFF = 147440;
constexpr int CW_BAR = 4096;

__device__ const unsigned char T5B[128] = {0, 1, 2, 3, 4, 5, 6, 7, 8, 9, 10, 11, 12, 13, 14, 15, 16, 16, 16, 17, 17, 18, 18, 18, 19, 19, 19, 20, 20, 20, 20, 21, 21, 21, 21, 22, 22, 22, 22, 22, 23, 23, 23, 23, 23, 23, 24, 24, 24, 24, 24, 24, 25, 25, 25, 25, 25, 25, 25, 26, 26, 26, 26, 26, 26, 26, 26, 27, 27, 27, 27, 27, 27, 27, 27, 27, 27, 28, 28, 28, 28, 28, 28, 28, 28, 28, 28, 29, 29, 29, 29, 29, 29, 29, 29, 29, 29, 29, 29, 30, 30, 30, 30, 30, 30, 30, 30, 30, 30, 30, 30, 30, 30, 31, 31, 31, 31, 31, 31, 31, 31, 31, 31, 31, 31, 31, 31, 31};

__device__ const double INVF_REV[32] = {0.15915494309189535, 0.11934937021124885, 0.08949940160889101, 0.06711508300522726, 0.05032921210448703, 0.037741584717419764, 0.028302195830623395, 0.02122365276477766, 0.01591549430918953, 0.011934937021124881, 0.008949940160889099, 0.0067115083005227245, 0.005032921210448702, 0.003774158471741975, 0.0028302195830623394, 0.0021223652764777645, 0.0015915494309189527, 0.0011934937021124885, 0.0008949940160889096, 0.0006711508300522724, 0.0005032921210448699, 0.00037741584717419747, 0.00028302195830623385, 0.00021223652764777642, 0.00015915494309189524, 0.00011934937021124881, 8.949940160889094e-05, 6.711508300522721e-05, 5.032921210448702e-05, 3.7741584717419736e-05, 2.830219583062336e-05, 2.1223652764777656e-05};


struct Args { const float* in[33]; float* out; unsigned char* ws; int ph_lo, ph_hi; };
__device__ __forceinline__ int tid_now(int wv);
#define XB_TMO      128
#define XB_XCNT(j)  (256  + 64 * (j))
#define XB_XSUB(j)  (1280 + 64 * (j))
#define XB_XGEN(j)  (2304 + 64 * (j))
#define XB_TOP      3328
#define XB_TOPGEN   3392
#define XCD_BAR_WORDS 3456
#define XB_SPIN_CAP (1u << 18)

__device__ __forceinline__ unsigned xb_ld(unsigned* p)              { return __hip_atomic_load(p, __ATOMIC_RELAXED, __HIP_MEMORY_SCOPE_AGENT); }
__device__ __forceinline__ unsigned xb_add(unsigned* p, unsigned v) { return __hip_atomic_fetch_add(p, v, __ATOMIC_RELAXED, __HIP_MEMORY_SCOPE_AGENT); }
__device__ __forceinline__ unsigned xb_xcc_id() { return (unsigned)__builtin_amdgcn_s_getreg((3 << 11) | 20) & 0xFu; }
#define XB_SPIN(cond, bar) do { unsigned _sp = 0; while (cond) { __builtin_amdgcn_s_sleep(1); \
    if ((++_sp & 255u) == 0u) { if (xb_ld(&(bar)[XB_TMO])) break; if (_sp > XB_SPIN_CAP) { atomicAdd(&(bar)[XB_TMO], 1u); break; } } } } while (0)

struct XcdBarrier {
    unsigned* bar; unsigned x; int wv;
    volatile LAS unsigned* st;
};

__device__ __forceinline__ XcdBarrier xcd_barrier_post(unsigned* bar, volatile LAS unsigned* st, int wv) {
    XcdBarrier b; b.bar = bar; b.x = xb_xcc_id(); b.st = st; b.wv = wv;
    if (tid_now(wv) == 0) (void)xb_add(&bar[XB_XCNT(b.x)], 1u);
    return b;
}
__device__ __forceinline__ void xcd_barrier_complete(unsigned* bar, unsigned x, unsigned& nloc, unsigned& nx) {
    const unsigned G = gridDim.x * gridDim.y * gridDim.z;
    unsigned sum, cnt, mine, sp = 0u;
    for (;;) {
        sum = 0u; cnt = 0u; mine = 0u;
#pragma unroll
        for (unsigned j = 0; j < 16; ++j) { const unsigned c = xb_ld(&bar[XB_XCNT(j)]); sum += c; cnt += (c > 0u) ? 1u : 0u; mine = (j == x) ? c : mine; }
        if (sum == G) break;
        __builtin_amdgcn_s_sleep(1);
        if ((++sp & 255u) == 0u) { if (xb_ld(&bar[XB_TMO])) break; if (sp > XB_SPIN_CAP) { atomicAdd(&bar[XB_TMO], 1u); break; } }
    }
    nloc = mine > 0u ? mine : 1u; nx = cnt > 0u ? cnt : 1u;
}

__device__ __forceinline__ void xcd_barrier(const XcdBarrier& b) {
    asm volatile("s_waitcnt vmcnt(0)" ::: "memory");
    __syncthreads();
    if (tid_now(b.wv) == 0) {
        unsigned* bar = b.bar;
        __builtin_amdgcn_s_waitcnt(0);
        unsigned nloc = b.st[0], nx = b.st[1];
        if (nloc == 0u) { xcd_barrier_complete(bar, b.x, nloc, nx); b.st[0] = nloc; b.st[1] = nx; }
        const unsigned old = xb_add(&bar[XB_XSUB(b.x)], 1u);
        const unsigned gen = old / nloc;
        if (old + 1u == (gen + 1u) * nloc) {
            __builtin_amdgcn_fence(__ATOMIC_RELEASE, "agent");
            asm volatile("s_waitcnt vmcnt(0)" ::: "memory");
            const unsigned og = xb_add(&bar[XB_TOP], 1u);
            const unsigned tg = og / nx;
            if (og + 1u == (tg + 1u) * nx) xb_add(&bar[XB_TOPGEN], 1u);
            else XB_SPIN(xb_ld(&bar[XB_TOPGEN]) == tg, bar);
            __builtin_amdgcn_fence(__ATOMIC_ACQUIRE, "agent");
            xb_add(&bar[XB_XGEN(b.x)], 1u);
            asm volatile("s_waitcnt vmcnt(0)" ::: "memory");
        } else {
            XB_SPIN(xb_ld(&bar[XB_XGEN(b.x)]) == gen, bar);
            __builtin_amdgcn_fence(__ATOMIC_ACQUIRE, "agent");
            asm volatile("s_waitcnt vmcnt(0)" ::: "memory");
        }
    }
    __syncthreads();
}


__device__ __forceinline__ int tid_now(int wv) { int l; asm volatile("v_mbcnt_lo_u32_b32 %0, -1, 0\n\tv_mbcnt_hi_u32_b32 %0, -1, %0" : "=v"(l)); return (wv << 6) | l; }
__device__ __forceinline__ float wsum(float v) {
#pragma unroll
    for (int o = 32; o >= 1; o >>= 1) v += __shfl_xor(v, o);
    return v;
}
__device__ __forceinline__ float gsum16(float v) {
#pragma unroll
    for (int o = 8; o >= 1; o >>= 1) v += __shfl_xor(v, o);
    return v;
}
__device__ __forceinline__ float sigmoidf_(float x) { return 1.f / (1.f + __expf(-x)); }
__device__ __forceinline__ float bflo(unsigned u) { return __uint_as_float(u << 16); }
__device__ __forceinline__ float bfhi(unsigned u) { return __uint_as_float(u & 0xffff0000u); }
__device__ __forceinline__ float bf2f(bf16_t b) { return __uint_as_float((unsigned)b << 16); }
__device__ __forceinline__ unsigned pkbf(float lo, float hi) { unsigned r; asm volatile("v_cvt_pk_bf16_f32 %0, %1, %2" : "=v"(r) : "v"(lo), "v"(hi)); return r; }
__device__ __forceinline__ f4 ld4bf(const bf16_t* p) { const uint2 u = *(const uint2*)p; return (f4){bflo(u.x), bfhi(u.x), bflo(u.y), bfhi(u.y)}; }
__device__ __forceinline__ void st4bf(bf16_t* p, f4 v) { uint2 u; u.x = pkbf(v.x, v.y); u.y = pkbf(v.z, v.w); *(uint2*)p = u; }
__device__ __forceinline__ float dot64(const float (&q)[64], const LAS f4* k) {
    float a0 = 0.f, a1 = 0.f, a2 = 0.f, a3 = 0.f;
#pragma unroll
    for (int i = 0; i < 16; ++i) { const f4 kv = k[i]; a0 += q[4 * i] * kv.x; a1 += q[4 * i + 1] * kv.y; a2 += q[4 * i + 2] * kv.z; a3 += q[4 * i + 3] * kv.w; }
    return (a0 + a1) + (a2 + a3);
}
__device__ __forceinline__ void osm_update(float s, const LAS f4* v, float& m, float& l, float (&o)[64]) {
    const float mn = fmaxf(m, s), sc = __expf(m - mn), p = __expf(s - mn);
    l = l * sc + p; m = mn;
#pragma unroll
    for (int i = 0; i < 16; ++i) { const f4 vv = v[i];
        o[4 * i] = o[4 * i] * sc + p * vv.x; o[4 * i + 1] = o[4 * i + 1] * sc + p * vv.y; o[4 * i + 2] = o[4 * i + 2] * sc + p * vv.z; o[4 * i + 3] = o[4 * i + 3] * sc + p * vv.w; }
}

typedef short bf16x8_t __attribute__((ext_vector_type(8)));
typedef float f32x16_t __attribute__((ext_vector_type(16)));
typedef unsigned u32x4_t __attribute__((ext_vector_type(4))); typedef unsigned u32x2_t __attribute__((ext_vector_type(2)));
typedef float f32x2_t __attribute__((ext_vector_type(2))); typedef __bf16 bf16x2_t __attribute__((ext_vector_type(2)));
__device__ __forceinline__ unsigned cvtpk(float lo, float hi) { f32x2_t v = {lo, hi}; bf16x2_t b = __builtin_convertvector(v, bf16x2_t); return __builtin_bit_cast(unsigned, b); }
#define MFMA32(a, b, c) __builtin_amdgcn_mfma_f32_32x32x16_bf16((a), (b), (c), 0, 0, 0)
__device__ __forceinline__ float xhalf(float v) { return __shfl_xor(v, 32); }

namespace pg8 {
#define PG8_LAS __attribute__((address_space(3)))
typedef unsigned short bf16_t;
typedef short bf16x8 __attribute__((ext_vector_type(8)));
typedef float f32x4 __attribute__((ext_vector_type(4)));
typedef unsigned u32x4 __attribute__((ext_vector_type(4)));
constexpr int BM = 256, BK = 64, HALF = 128, HTB = HALF * BK * 2  , STAGE_BYTES = 8 * HTB, NXCD = 8, WGM = 8;

__host__ __device__ __forceinline__ int lds_byte(int r, int c) { const int st = (r >> 4) * 2 + (c >> 5), rr = r & 15, cc = c & 31, ob = rr * 64 + cc * 2; return st * 1024 + (ob ^ (((ob >> 9) & 1) << 5)); }
__host__ __device__ __forceinline__ void stage_rc(int b, int& R, int& C) { const int st = b / 1024, sb = b % 1024, swz = sb ^ (((sb >> 9) & 1) << 5); R = (st >> 1) * 16 + swz / 64; C = (st & 1) * 32 + (swz % 64) / 2; }
__host__ __device__ __forceinline__ int perm32(int rho) { const int n = rho >> 4, i = rho & 15; return 8 * (i >> 2) + 4 * n + (i & 3); }

struct Unit { int pm, pn, sub; };
struct Gemm { const bf16_t* A; const bf16_t* Bt; int M, N, K; size_t sa, sb; };

struct StaticOrder {
    int nM, nN, nwg, G, c;
    __host__ __device__ void init(int M, int N, int G_, int c_) { nM = M / BM; nN = N / BM; nwg = nM * nN; G = G_; c = c_; }
    __host__ __device__ bool next(int i, Unit& u) const {
        const long L = (long)i * G + c; if (L >= nwg) return false;
        int wgid = (int)L; { const int q = nwg / NXCD, r = nwg % NXCD, xcd = wgid % NXCD, off = wgid / NXCD; wgid = (xcd < r ? xcd * (q + 1) : r * (q + 1) + (xcd - r) * q) + off; }
        const int nig = WGM * nN, gid = wgid / nig, fm = gid * WGM, gsz = (nM - fm) < WGM ? (nM - fm) : WGM;
        u.pm = fm + ((wgid % nig) % gsz); u.pn = (wgid % nig) / gsz; u.sub = 0; return true;
    }
    __device__ __forceinline__ void a_ready(const Unit&) const {}
    __device__ __forceinline__ void done(const Unit&) const {}
};
template <int NSUB> struct ChainOrder : StaticOrder {
    __host__ __device__ bool next(int i, Unit& u) const { if (!StaticOrder::next(i / NSUB, u)) return false; u.sub = i % NSUB; return true; }
};

__device__ __forceinline__ unsigned cvt_pk_bf16(float lo, float hi) { unsigned r; asm volatile("v_cvt_pk_bf16_f32 %0, %1, %2" : "=v"(r) : "v"(lo), "v"(hi)); return r; }
typedef float f32x2 __attribute__((ext_vector_type(2)));

template <int MODE> struct Epi {
    static constexpr bool PERM = true, AFTER_DRAIN = false, CHAIN = (MODE == 5);
    bf16_t* O; int ldc; bf16_t* O2; float* F; const bf16_t* SG; int mi;
    template <class ACC> __device__ __forceinline__ void operator()(ACC& acc, const Unit& u, int wr, int wc, int fr, int fq) const {
        const int row0 = u.pm * BM + wr * 64 + fr, col0 = u.pn * BM + wc * 32 + 8 * fq;
#pragma unroll
        for (int ai = 0; ai < 2; ++ai)
#pragma unroll
            for (int m = 0; m < 4; ++m) { const size_t row = (size_t)(row0 + ai * HALF + m * 16);
#pragma unroll
                for (int bj = 0; bj < 2; ++bj) { f32x4 v0 = acc[ai][bj][m][0], v1 = acc[ai][bj][m][1]; const int col = col0 + bj * HALF;
                    if (MODE == 5) { const bf16_t* gp = SG + row * (4 * DM) + u.sub * DM + col; const u32x4 ga = *(const u32x4*)gp;
                        float gs[8] = {bflo(ga.x), bfhi(ga.x), bflo(ga.y), bfhi(ga.y), bflo(ga.z), bfhi(ga.z), bflo(ga.w), bfhi(ga.w)};
                        if (u.sub < 3) { const u32x4 gb = *(const u32x4*)(gp + DM); const float gd[8] = {bflo(gb.x), bfhi(gb.x), bflo(gb.y), bfhi(gb.y), bflo(gb.z), bfhi(gb.z), bflo(gb.w), bfhi(gb.w)};
#pragma unroll
                            for (int e = 0; e < 4; ++e) { acc[ai][bj][m][0][e] = v0[e] * (gs[e] * __builtin_amdgcn_rcpf(gd[e])); acc[ai][bj][m][1][e] = v1[e] * (gs[4 + e] * __builtin_amdgcn_rcpf(gd[4 + e])); }
                            continue; }
#pragma unroll
                        for (int e = 0; e < 4; ++e) { v0[e] *= gs[e]; v1[e] *= gs[4 + e]; } }
                    if (MODE == 3) { float* p = F + row * ldc + col; *(f32x4*)p = v0; *(f32x4*)(p + 4) = v1; }
                    else {
                        bf16_t* dst = O + row * ldc + col;
                        if (MODE == 1) { if (u.pn >= ZLD / BM) { dst = O2 + row * (4 * DM) + (col - ZLD);
#pragma unroll
                            for (int e = 0; e < 4; ++e) { v0[e] = fmaxf(sigmoidf_(v0[e]), 1e-6f); v1[e] = fmaxf(sigmoidf_(v1[e]), 1e-6f); } } }
                        if (MODE == 2) {
#pragma unroll
                            for (int e = 0; e < 4; ++e) { const float a = fmaxf(v0[e], 0.f), b = fmaxf(v1[e], 0.f); v0[e] = a * a; v1[e] = b * b; } }
                        if (MODE == 4) { const u32x4 g = *(const u32x4*)(SG + row * (4 * DM) + mi * DM + col);
                            v0[0] *= bflo(g.x); v0[1] *= bfhi(g.x); v0[2] *= bflo(g.y); v0[3] *= bfhi(g.y); v1[0] *= bflo(g.z); v1[1] *= bfhi(g.z); v1[2] *= bflo(g.w); v1[3] *= bfhi(g.w);
                            float* p = F + row * DM + col;
                            if (mi > 0) { v0 += *(const f32x4*)p; v1 += *(const f32x4*)(p + 4); }
                            if (mi < 3) { *(f32x4*)p = v0; *(f32x4*)(p + 4) = v1; continue; } }
                        u32x4 w; w.x = cvt_pk_bf16(v0[0], v0[1]); w.y = cvt_pk_bf16(v0[2], v0[3]); w.z = cvt_pk_bf16(v1[0], v1[1]); w.w = cvt_pk_bf16(v1[2], v1[3]);
                        *(u32x4*)dst = w; } } }
    }
};
template <class Epi, class Sched, bool ALIGN_EPI = false, bool SP2 = false>
__device__ __forceinline__ void gemm_phase(PG8_LAS unsigned char* lds, const Gemm g, const Sched& S, const Epi& E, int wv) {
    const int tid = tid_now(wv), wid = __builtin_amdgcn_readfirstlane(tid >> 6), lane = tid & 63, wr = wid >> 2, wc = wid & 3, fr = lane & 15, fq = lane >> 4;
    const int K = g.K, nt = K / BK;
    unsigned voffA[2], voffB[2];
#pragma unroll
    for (int i = 0; i < 2; ++i) { int R, C; stage_rc(tid * 16 + i * 8192, R, C); const int Rb = Epi::PERM ? ((R & ~31) + perm32(R & 31)) : R;
        voffA[i] = (unsigned)(R * K + C) * 2u; voffB[i] = (unsigned)(Rb * K + C) * 2u; }
    const size_t kstep = (size_t)(BK * 2);
    const size_t hstep = (size_t)HALF * K * 2;
    const size_t tstep = 2 * hstep;
    const unsigned ldsw = (unsigned)wid * 1024u;
    const int aoff = lds_byte(wr * 64 + fr, fq * 8), boff = lds_byte(wc * 32 + fr, fq * 8);
#define PG8_SA(b, h) (((b) * 2 + (h)) * HTB)
#define PG8_SB(b, h) ((4 + (b) * 2 + (h)) * HTB)
#define PG8_STAGE(bufoff, gbase, voff) do { _Pragma("unroll") for (int _i = 0; _i < 2; ++_i) \
        __builtin_amdgcn_global_load_lds((const unsigned*)((const char*)(gbase) + (voff)[_i]), (PG8_LAS unsigned*)(lds + (bufoff) + ldsw + _i * 8192), 16, 0, 0); } while (0)
#define PG8_LDA(dst, b, h) do { _Pragma("unroll") for (int m = 0; m < 4; ++m) _Pragma("unroll") for (int k = 0; k < 2; ++k) dst[m][k] = *(const PG8_LAS bf16x8*)(lds + PG8_SA(b, h) + aoff + m * 2048 + k * 1024); } while (0)
#define PG8_LDB(dst, b, h) do { _Pragma("unroll") for (int n = 0; n < 2; ++n) _Pragma("unroll") for (int k = 0; k < 2; ++k) dst[n][k] = *(const PG8_LAS bf16x8*)(lds + PG8_SB(b, h) + boff + n * 2048 + k * 1024); } while (0)
#define PG8_MMA(ai, bj, At, Bt) do { __builtin_amdgcn_s_setprio(1); _Pragma("unroll") for (int m = 0; m < 4; ++m) _Pragma("unroll") for (int n = 0; n < 2; ++n) _Pragma("unroll") for (int k = 0; k < 2; ++k) \
        acc[ai][bj][m][n] = __builtin_amdgcn_mfma_f32_16x16x32_bf16(Bt[n][k], At[m][k], acc[ai][bj][m][n], 0, 0, 0); __builtin_amdgcn_s_setprio(0); } while (0)
#define PG8_WAIT_V(n) asm volatile("s_waitcnt vmcnt(" #n ")" ::: "memory")
#define PG8_WAIT_L(n) asm volatile("s_waitcnt lgkmcnt(" #n ")" ::: "memory")
#define PG8_BAR __builtin_amdgcn_s_barrier()
#define PG8_SCHED __builtin_amdgcn_sched_barrier(0)
    Unit cur, nxt; int ui = 0;
    if (!S.next(0, cur)) return;
    f32x4 acc[2][2][4][2];
#pragma unroll
    for (int a = 0; a < 2; ++a)
#pragma unroll
        for (int b = 0; b < 2; ++b)
#pragma unroll
            for (int m = 0; m < 4; ++m)
#pragma unroll
                for (int n = 0; n < 2; ++n) acc[a][b][m][n] = (f32x4){0.f, 0.f, 0.f, 0.f};
    bf16x8 At[4][2], B0[2][2], B1[2][2];
    const char* cA = (const char*)(g.A + cur.sub * g.sa) + (size_t)cur.pm * tstep; const char* cB = (const char*)(g.Bt + cur.sub * g.sb) + (size_t)cur.pn * tstep;
    S.a_ready(cur);
    if constexpr (SP2) {
        PG8_STAGE(PG8_SB(0, 0), cB, voffB); PG8_STAGE(PG8_SB(0, 1), cB + hstep, voffB); PG8_STAGE(PG8_SA(0, 0), cA, voffA); PG8_STAGE(PG8_SA(0, 1), cA + hstep, voffA);
        if (wr == 1) PG8_BAR;
        PG8_WAIT_V(2); PG8_BAR;
        PG8_STAGE(PG8_SB(1, 0), cB + kstep, voffB); PG8_STAGE(PG8_SA(1, 0), cA + kstep, voffA); PG8_STAGE(PG8_SB(1, 1), cB + hstep + kstep, voffB);
        PG8_WAIT_V(6); PG8_BAR;
    } else {
        PG8_STAGE(PG8_SB(0, 0), cB, voffB); PG8_STAGE(PG8_SA(0, 0), cA, voffA); PG8_STAGE(PG8_SB(0, 1), cB + hstep, voffB); PG8_STAGE(PG8_SA(0, 1), cA + hstep, voffA);
        if (wr == 1) PG8_BAR;
        PG8_WAIT_V(4); PG8_BAR;
        PG8_STAGE(PG8_SB(1, 0), cB + kstep, voffB); PG8_STAGE(PG8_SA(1, 0), cA + kstep, voffA); PG8_STAGE(PG8_SB(1, 1), cB + hstep + kstep, voffB);
        PG8_WAIT_V(6); PG8_BAR;
    }
    for (;;) {
        const bool has_next = S.next(ui + 1, nxt);
        const char* nA = has_next ? (const char*)(g.A + nxt.sub * g.sa) + (size_t)nxt.pm * tstep : cA; const char* nB = has_next ? (const char*)(g.Bt + nxt.sub * g.sb) + (size_t)nxt.pn * tstep : cB;
        for (int t = 0; t < nt; t += 2) {
            const bool last = (t == nt - 2);
            const char* a1 = cA + (size_t)(t + 1) * kstep;
            const char* a2 = last ? nA : cA + (size_t)(t + 2) * kstep; const char* b2 = last ? nB : cB + (size_t)(t + 2) * kstep;
            const char* a3 = a2 + kstep; const char* b3 = b2 + kstep;
            if (last && has_next) S.a_ready(nxt);
            if constexpr (SP2) {
            PG8_LDB(B0, 0, 0); PG8_LDB(B1, 0, 1); PG8_SCHED; PG8_LDA(At, 0, 0); PG8_STAGE(PG8_SA(1, 1), a1 + hstep, voffA);
            PG8_WAIT_V(8); PG8_WAIT_L(0); PG8_BAR; PG8_MMA(0, 0, At, B0); PG8_MMA(0, 1, At, B1); PG8_BAR; PG8_SCHED;
            PG8_LDA(At, 0, 1); PG8_STAGE(PG8_SB(0, 0), b2, voffB); PG8_STAGE(PG8_SB(0, 1), b2 + hstep, voffB); PG8_STAGE(PG8_SA(0, 0), a2, voffA);
            PG8_WAIT_V(8); PG8_WAIT_L(0); PG8_BAR; PG8_MMA(1, 0, At, B0); PG8_MMA(1, 1, At, B1); PG8_BAR; PG8_SCHED;
            PG8_LDB(B0, 1, 0); PG8_LDB(B1, 1, 1); PG8_SCHED; PG8_LDA(At, 1, 0); PG8_STAGE(PG8_SA(0, 1), a2 + hstep, voffA);
            PG8_WAIT_V(8); PG8_WAIT_L(0); PG8_BAR; PG8_MMA(0, 0, At, B0); PG8_MMA(0, 1, At, B1); PG8_BAR; PG8_SCHED;
            PG8_LDA(At, 1, 1); PG8_STAGE(PG8_SB(1, 0), b3, voffB); PG8_STAGE(PG8_SB(1, 1), b3 + hstep, voffB); PG8_STAGE(PG8_SA(1, 0), a3, voffA);
            PG8_WAIT_V(8); PG8_WAIT_L(0); PG8_BAR; PG8_MMA(1, 0, At, B0); PG8_MMA(1, 1, At, B1); PG8_BAR; PG8_SCHED;
            } else {
            PG8_LDB(B0, 0, 0); PG8_SCHED; PG8_LDA(At, 0, 0); PG8_STAGE(PG8_SA(1, 1), a1 + hstep, voffA);
            PG8_WAIT_L(8); PG8_BAR; PG8_WAIT_L(0); PG8_MMA(0, 0, At, B0); PG8_BAR; PG8_SCHED;
            PG8_LDB(B1, 0, 1); PG8_STAGE(PG8_SB(0, 0), b2, voffB);
            PG8_BAR; PG8_WAIT_L(0); PG8_MMA(0, 1, At, B1); PG8_BAR;
            PG8_LDA(At, 0, 1); PG8_STAGE(PG8_SA(0, 0), a2, voffA);
            PG8_BAR; PG8_WAIT_L(0); PG8_MMA(1, 0, At, B0); PG8_BAR; PG8_SCHED;
            PG8_STAGE(PG8_SB(0, 1), b2 + hstep, voffB);
            PG8_WAIT_V(6); PG8_BAR; PG8_MMA(1, 1, At, B1); PG8_BAR;
            PG8_LDB(B0, 1, 0); PG8_SCHED; PG8_LDA(At, 1, 0); PG8_STAGE(PG8_SA(0, 1), a2 + hstep, voffA);
            PG8_WAIT_L(8); PG8_BAR; PG8_WAIT_L(0); PG8_MMA(0, 0, At, B0); PG8_BAR; PG8_SCHED;
            PG8_LDB(B1, 1, 1); PG8_STAGE(PG8_SB(1, 0), b3, voffB);
            PG8_BAR; PG8_WAIT_L(0); PG8_MMA(0, 1, At, B1); PG8_BAR;
            PG8_LDA(At, 1, 1); PG8_STAGE(PG8_SA(1, 0), a3, voffA);
            PG8_BAR; PG8_WAIT_L(0); PG8_MMA(1, 0, At, B0); PG8_BAR; PG8_SCHED;
            PG8_STAGE(PG8_SB(1, 1), b3 + hstep, voffB);
            PG8_WAIT_V(6); PG8_BAR; PG8_MMA(1, 1, At, B1); PG8_BAR;
            }
        }
        if constexpr (ALIGN_EPI) { if (wr == 0) PG8_BAR; }
        if constexpr (!Epi::AFTER_DRAIN) { E(acc, cur, wr, wc, fr, fq); S.done(cur); }
        if (!has_next) break;
        if (!(Epi::CHAIN && nxt.sub != 0)) {
#pragma unroll
        for (int a = 0; a < 2; ++a)
#pragma unroll
            for (int b = 0; b < 2; ++b)
#pragma unroll
                for (int m = 0; m < 4; ++m)
#pragma unroll
                    for (int n = 0; n < 2; ++n) acc[a][b][m][n] = (f32x4){0.f, 0.f, 0.f, 0.f};
        }
        cur = nxt; cA = nA; cB = nB; ++ui;
        if constexpr (ALIGN_EPI) { if (wr == 1) PG8_BAR; }
    }
    PG8_WAIT_V(0);
    if constexpr (!ALIGN_EPI) { if (wr == 0) PG8_BAR; }
    PG8_BAR;
    if constexpr (Epi::AFTER_DRAIN) { E.fused(acc, cur, wr, wc, fr, fq, lds, wid, lane); S.done(cur); }
#undef PG8_SA
#undef PG8_SB
#undef PG8_STAGE
#undef PG8_LDA
#undef PG8_LDB
#undef PG8_MMA
#undef PG8_WAIT_V
#undef PG8_WAIT_L
#undef PG8_BAR
#undef PG8_SCHED
}
}

template <int MODE>
__device__ __forceinline__ void gemm_run(LAS unsigned char* lds, const bf16_t* A, const bf16_t* Bt, int M, int N, int K, const pg8::Epi<MODE>& E, int wv, int G, int bid) {
    pg8::Gemm g{A, Bt, M, N, K}; pg8::StaticOrder S; S.init(M, N, G, bid);
    pg8::gemm_phase<pg8::Epi<MODE>, pg8::StaticOrder, true, true>(lds, g, S, E, wv);
}

template <int MODE, int NSUB>
__device__ __forceinline__ void gemm_run_chain(LAS unsigned char* lds, const bf16_t* A, size_t sa, const bf16_t* Bt, size_t sb, int M, int N, int K, const pg8::Epi<MODE>& E, int wv, int G, int bid) {
    pg8::Gemm g{A, Bt, M, N, K, sa, sb}; pg8::ChainOrder<NSUB> S; S.init(M, N, G, bid);
    pg8::gemm_phase<pg8::Epi<MODE>, pg8::ChainOrder<NSUB>, true, true>(lds, g, S, E, wv);
}

__device__ __forceinline__ void transpose_item(const float* W, int ldw, int src_c0, bf16_t* WT, int K, int dst_r0, int k0, LAS float* scr, int lane) {
#pragma unroll 8
    for (int i = 0; i < 32; ++i) { const int kk = 2 * i + (lane >> 5); scr[kk * 33 + (lane & 31)] = W[(size_t)(k0 + kk) * ldw + src_c0 + (lane & 31)]; }
    asm volatile("s_waitcnt lgkmcnt(0)" ::: "memory");
    const int c = lane & 7;
#pragma unroll
    for (int j = 0; j < 4; ++j) { const int n = (lane >> 3) + 8 * j; const LAS float* s = scr + (8 * c) * 33 + n;
        uint4 o; o.x = pkbf(s[0 * 33], s[1 * 33]); o.y = pkbf(s[2 * 33], s[3 * 33]); o.z = pkbf(s[4 * 33], s[5 * 33]); o.w = pkbf(s[6 * 33], s[7 * 33]);
        *(uint4*)(WT + (size_t)(dst_r0 + n) * K + k0 + 8 * c) = o; }
    asm volatile("s_waitcnt lgkmcnt(0)" ::: "memory");
}
__device__ __forceinline__ void convert_layer(const float* const* P, int l, bf16_t* Wb, LAS unsigned char* lds, int wave, int lane, int gw, int NGW) {
    LAS float* scr = (LAS float*)(lds + wave * 16384);
    constexpr int I_IN = 16 * (NZ / 32), I_BR = 4 * 4 * 32, I_SQ = 16 * 32, I_KV = 16 * 64, I_1 = 16 * 128, I_2 = 64 * 32, I_C = 2 * 32 * 2;
    constexpr int NIT = I_IN + I_BR + 3 * I_SQ + I_KV + I_1 + I_2 + I_C;
    for (int it = gw; it < NIT; it += NGW) {
        int r = it;
        if (r < I_IN) { const int kb = r / (NZ / 32), nb = r % (NZ / 32), n0 = 32 * nb; transpose_item(P[3] + (size_t)l * DM * IN_COLS, IN_COLS, n0 + (n0 >= 640 ? 12 : 0), Wb + WO_IN, DM, n0, 64 * kb, scr, lane); continue; } r -= I_IN;
        if (r < I_BR) { const int m = r >> 7, kb = (r >> 5) & 3, nb = r & 31; transpose_item(P[20] + ((size_t)l * 4 + m) * MW * DM, DM, 32 * nb, Wb + WO_BR + (size_t)m * DM * MW, MW, 32 * nb, 64 * kb, scr, lane); continue; } r -= I_BR;
        if (r < I_SQ) { transpose_item(P[21] + (size_t)l * DM * DM, DM, 32 * (r & 31), Wb + WO_MO, DM, 32 * (r & 31), 64 * (r >> 5), scr, lane); continue; } r -= I_SQ;
        if (r < I_SQ) { transpose_item(P[25] + (size_t)l * DM * DM, DM, 32 * (r & 31), Wb + WO_Q, DM, 32 * (r & 31), 64 * (r >> 5), scr, lane); continue; } r -= I_SQ;
        if (r < I_KV) { transpose_item(P[26] + (size_t)l * DM * 2 * DM, 2 * DM, 32 * (r & 63), Wb + WO_KV, DM, 32 * (r & 63), 64 * (r >> 6), scr, lane); continue; } r -= I_KV;
        if (r < I_SQ) { transpose_item(P[27] + (size_t)l * DM * DM, DM, 32 * (r & 31), Wb + WO_O, DM, 32 * (r & 31), 64 * (r >> 5), scr, lane); continue; } r -= I_SQ;
        if (r < I_1) { transpose_item(P[30] + (size_t)l * DM * DFF, DFF, 32 * (r & 127), Wb + WO_1, DM, 32 * (r & 127), 64 * (r >> 7), scr, lane); continue; } r -= I_1;
        if (r < I_2) { transpose_item(P[31] + (size_t)l * DFF * DM, DM, 32 * (r & 31), Wb + WO_2, DFF, 32 * (r & 31), 64 * (r >> 5), scr, lane); continue; } r -= I_2;
        { const int which = r >> 6, kb = (r >> 1) & 31, nb = r & 1;
          transpose_item(P[4] + ((size_t)l * 2 + which) * 2048 * 64, 64, 32 * nb, Wb + WO_CMP + (size_t)which * 64 * 2048, 2048, 32 * nb, 64 * kb, scr, lane); }
    }
}

__device__ __forceinline__ void ng_row(const f4 (&v)[4], const LAS float* wng, float* ngo, int lane) {
    float acc[12];
#pragma unroll
    for (int j = 0; j < 12; ++j) { float a = 0.f;
#pragma unroll
        for (int jj = 0; jj < 4; ++jj) { const f4 w = *(const LAS f4*)(wng + j * DM + 4 * lane + 256 * jj); a += v[jj].x * w.x + v[jj].y * w.y + v[jj].z * w.z + v[jj].w * w.w; }
        acc[j] = wsum(a); }
    if (lane == 0) { *(f4*)ngo = (f4){acc[0], acc[1], acc[2], acc[3]}; *(f4*)(ngo + 4) = (f4){acc[4], acc[5], acc[6], acc[7]}; *(f4*)(ngo + 8) = (f4){acc[8], acc[9], acc[10], acc[11]}; }
}
__device__ __forceinline__ void stage_wng(LAS float* wng, const float* w_in_l, int tid) {
    for (int i = tid; i < 12 * DM; i += NT) { const int c = i / 12, j = i % 12; wng[j * DM + c] = w_in_l[(size_t)c * IN_COLS + 640 + j]; }
}
__device__ __forceinline__ void rms_rows(const float* x, const float* g, bf16_t* out, int nrows, const LAS float* wng, float* ng, int gw, int NGW, int lane) {
    for (int m = gw; m < nrows; m += NGW) {
        const f4* xr = (const f4*)(x + (size_t)m * DM) + lane; f4 v[4]; float s = 0.f;
#pragma unroll
        for (int j = 0; j < 4; ++j) { v[j] = xr[64 * j]; s += v[j].x * v[j].x + v[j].y * v[j].y + v[j].z * v[j].z + v[j].w * v[j].w; }
        const float r = 1.f / sqrtf(wsum(s) * (1.f / DM) + 1e-6f);
#pragma unroll
        for (int j = 0; j < 4; ++j) { const f4 gg = ((const f4*)g)[lane + 64 * j]; v[j] = v[j] * r * gg; st4bf(out + (size_t)m * DM + 4 * lane + 256 * j, v[j]); }
        if (ng) ng_row(v, wng, ng + (size_t)m * 12, lane);
    }
}
__device__ __forceinline__ void rowop(const float* xin, const bf16_t* y, const float* g1, const float* g2, float* xout, bf16_t* h, const LAS float* wng, float* ng, int gw, int NGW, int lane) {
    for (int m = gw; m < MTOK; m += NGW) {
        const bf16_t* yr = y + (size_t)m * DM + 4 * lane; const f4* xr = (const f4*)(xin + (size_t)m * DM) + lane; f4 v[4]; float s = 0.f;
#pragma unroll
        for (int j = 0; j < 4; ++j) { v[j] = ld4bf(yr + 256 * j); s += v[j].x * v[j].x + v[j].y * v[j].y + v[j].z * v[j].z + v[j].w * v[j].w; }
        const float r = 1.f / sqrtf(wsum(s) * (1.f / DM) + 1e-6f);
        float s2 = 0.f; f4* xo = (f4*)(xout + (size_t)m * DM) + lane;
#pragma unroll
        for (int j = 0; j < 4; ++j) { const f4 gg = ((const f4*)g1)[lane + 64 * j]; v[j] = xr[64 * j] + v[j] * r * gg; xo[64 * j] = v[j];
            s2 += v[j].x * v[j].x + v[j].y * v[j].y + v[j].z * v[j].z + v[j].w * v[j].w; }
        if (g2) { const float r2 = 1.f / sqrtf(wsum(s2) * (1.f / DM) + 1e-6f);
#pragma unroll
            for (int j = 0; j < 4; ++j) { const f4 gg = ((const f4*)g2)[lane + 64 * j]; v[j] = v[j] * r2 * gg; st4bf(h + (size_t)m * DM + 4 * lane + 256 * j, v[j]); }
            if (ng) ng_row(v, wng, ng + (size_t)m * 12, lane); }
    }
}

__device__ __forceinline__ void nsa_compress_task(const bf16_t* z, const bf16_t* wt, const float* pe_l, bf16_t* kc, bf16_t* vct, int task, int lane) {
    const int rb = task & 3, which = (task >> 2) & 1, b = task >> 3, c = lane & 31, hi = lane >> 5, n = 32 * rb + c; const bool valid = n < NCMP;
    const bf16_t* arow = z + (size_t)(b * SEQ + 16 * (valid ? n : 0)) * ZLD + (which ? C_VC : C_KC);
    const bf16_t* b0p = wt + (size_t)(which * 64 + c) * 2048 + 8 * hi; const bf16_t* b1p = b0p + (size_t)32 * 2048;
    f32x16_t acc0, acc1;
#pragma unroll
    for (int i = 0; i < 16; ++i) { acc0[i] = 0.f; acc1[i] = 0.f; }
#pragma unroll 4
    for (int ks = 0; ks < 128; ++ks) { const int kidx = 16 * ks + 8 * hi, l = kidx >> 6, d = kidx & 63;
        const u32x4_t zr = *(const u32x4_t*)(arow + (size_t)l * ZLD + d); const f4 p0 = *(const f4*)(pe_l + l * 64 + d), p1 = *(const f4*)(pe_l + l * 64 + d + 4);
        u32x4_t aw; aw[0] = cvtpk(bflo(zr[0]) + p0.x, bfhi(zr[0]) + p0.y); aw[1] = cvtpk(bflo(zr[1]) + p0.z, bfhi(zr[1]) + p0.w); aw[2] = cvtpk(bflo(zr[2]) + p1.x, bfhi(zr[2]) + p1.y); aw[3] = cvtpk(bflo(zr[3]) + p1.z, bfhi(zr[3]) + p1.w);
        if (!valid) aw = (u32x4_t){0u, 0u, 0u, 0u};
        const bf16x8_t a = __builtin_bit_cast(bf16x8_t, aw);
        acc0 = MFMA32(a, *(const bf16x8_t*)(b0p + 16 * ks), acc0); acc1 = MFMA32(a, *(const bf16x8_t*)(b1p + 16 * ks), acc1); }
    if (which) {
#pragma unroll
        for (int a = 0; a < 4; ++a) { const int n0 = 32 * rb + 8 * a + 4 * hi; u32x2_t u0, u1; u0[0] = cvtpk(acc0[4 * a], acc0[4 * a + 1]); u0[1] = cvtpk(acc0[4 * a + 2], acc0[4 * a + 3]); u1[0] = cvtpk(acc1[4 * a], acc1[4 * a + 1]); u1[1] = cvtpk(acc1[4 * a + 2], acc1[4 * a + 3]);
            *(u32x2_t*)(vct + (size_t)(b * 64 + c) * 128 + n0) = u0; *(u32x2_t*)(vct + (size_t)(b * 64 + 32 + c) * 128 + n0) = u1; }
    } else {
#pragma unroll
        for (int i = 0; i < 16; ++i) { const int ni = 32 * rb + (i & 3) + 8 * (i >> 2) + 4 * hi; kc[(size_t)(b * 128 + ni) * 64 + c] = (bf16_t)(cvtpk(acc0[i], 0.f) & 0xffffu); kc[(size_t)(b * 128 + ni) * 64 + 32 + c] = (bf16_t)(cvtpk(acc1[i], 0.f) & 0xffffu); }
    }
}
__device__ __forceinline__ float tanh_fast(float x) { return 1.f - 2.f / (1.f + __expf(2.f * x)); }
__device__ __forceinline__ void rwkv_prep_quad(const bf16_t* zb, float* rw, const float* const* P, int l, int tok0, int lane, LAS float* scr) {
    const float* mu = P[8] + l * RWKV_COLS; const float* w0 = P[9] + l * MW; const float* w2 = P[10] + (size_t)l * 32 * MW; const float* a0 = P[11] + l * MW;
    const float* a2 = P[12] + (size_t)l * 32 * MW; const float* g2 = P[13] + (size_t)l * 64 * MW; const float* k_k = P[14] + l * MW; const float* k_a = P[15] + l * MW;
    const int t0 = tok0 % SEQ; const bf16_t* z = zb + (size_t)tok0 * ZLD + C_RW;
    const f4 zero4 = (f4){0.f, 0.f, 0.f, 0.f};
    f4 rkv[4][3];
#pragma unroll
    for (int j = 0; j < 3; ++j) { const f4 m = *(const f4*)(mu + j * 256 + 4 * lane); f4 p = t0 ? ld4bf(z - ZLD + j * 256 + 4 * lane) : zero4;
#pragma unroll
        for (int i = 0; i < 4; ++i) { const f4 cur = ld4bf(z + (size_t)i * ZLD + j * 256 + 4 * lane); rkv[i][j] = cur + (p - cur) * m; p = cur; } }
    if (lane < 32) { const f4 m = *(const f4*)(mu + 768 + 4 * lane); f4 p = t0 ? ld4bf(z - ZLD + 768 + 4 * lane) : zero4;
#pragma unroll
        for (int i = 0; i < 4; ++i) { const f4 cur = ld4bf(z + (size_t)i * ZLD + 768 + 4 * lane); f4 v = cur + (p - cur) * m; p = cur;
            if (lane < 8) { v.x = tanh_fast(v.x); v.y = tanh_fast(v.y); v.z = tanh_fast(v.z); v.w = tanh_fast(v.w); }
            else if (lane >= 16) { v.x = sigmoidf_(v.x); v.y = sigmoidf_(v.y); v.z = sigmoidf_(v.z); v.w = sigmoidf_(v.w); }
            *(LAS f4*)(scr + i * 128 + 4 * lane) = v; } }
    asm volatile("s_waitcnt lgkmcnt(0)" ::: "memory");
    f4 aw[4], aa[4], ag[4];
#pragma unroll
    for (int i = 0; i < 4; ++i) { aw[i] = zero4; aa[i] = zero4; ag[i] = zero4; }
#pragma unroll 2
    for (int j = 0; j < 32; ++j) { const f4 wr = *(const f4*)(w2 + j * MW + 4 * lane), ar = *(const f4*)(a2 + j * MW + 4 * lane);
#pragma unroll
        for (int i = 0; i < 4; ++i) { aw[i] += scr[i * 128 + j] * wr; aa[i] += scr[i * 128 + 32 + j] * ar; } }
#pragma unroll 2
    for (int j = 0; j < 64; ++j) { const f4 gr = *(const f4*)(g2 + j * MW + 4 * lane);
#pragma unroll
        for (int i = 0; i < 4; ++i) ag[i] += scr[i * 128 + 64 + j] * gr; }
    asm volatile("s_waitcnt lgkmcnt(0)" ::: "memory");
    const f4 w0v = *(const f4*)(w0 + 4 * lane), a0v = *(const f4*)(a0 + 4 * lane), kkv = *(const f4*)(k_k + 4 * lane), kav = *(const f4*)(k_a + 4 * lane);
#pragma unroll
    for (int i = 0; i < 4; ++i) {
        f4 dec, av, kk, k2; float ss = 0.f;
#pragma unroll
        for (int e = 0; e < 4; ++e) { const float y = -(w0v[e] + aw[i][e]); const float sp = (y > 20.f) ? y : __logf(1.f + __expf(y)); dec[e] = __expf(-__expf(-sp - 0.5f));
            av[e] = sigmoidf_(a0v[e] + aa[i][e]); kk[e] = rkv[i][1][e] * kkv[e]; ss += kk[e] * kk[e]; k2[e] = rkv[i][1][e] * (1.f + (av[e] - 1.f) * kav[e]); }
        ss = gsum16(ss); const float inv = 1.f / fmaxf(sqrtf(ss), 1e-12f); kk = kk * inv;
        float* o = rw + (size_t)(tok0 + i) * 7 * MW + 4 * lane;
        *(f4*)(o) = rkv[i][0]; *(f4*)(o + MW) = dec; *(f4*)(o + 2 * MW) = k2; *(f4*)(o + 3 * MW) = rkv[i][2]; *(f4*)(o + 4 * MW) = kk; *(f4*)(o + 5 * MW) = kk * av; *(f4*)(o + 6 * MW) = ag[i];
    }
}

constexpr int SC_T = 128, SC_NC = SEQ / SC_T, SC_SUB = 16;
__device__ __forceinline__ float dpp_add8(float v) {
    v += __builtin_bit_cast(float, __builtin_amdgcn_mov_dpp(__builtin_bit_cast(int, v), 0xB1, 0xf, 0xf, true));
    v += __builtin_bit_cast(float, __builtin_amdgcn_mov_dpp(__builtin_bit_cast(int, v), 0x4E, 0xf, 0xf, true));
    v += __builtin_bit_cast(float, __builtin_amdgcn_mov_dpp(__builtin_bit_cast(int, v), 0x141, 0xf, 0xf, true));
    return v;
}
template <int RPL, int MODE>
__device__ __forceinline__ void scan_chunk_pair(LAS unsigned char* lds, const float* rw, float* pq, const float* sinit, bf16_t* o_rwkv, const float* r_k, const float* ln_g, const float* ln_b,
                                                int u0, int nunits, int wv) {
    const int tid = tid_now(wv), tu = tid & 255, ui = tid >> 8, lane = tid & 63, cg = lane & 7, rbase = (((tid >> 6) & 3) * 8 + (lane >> 3)) * RPL;
    const int u = u0 + ui; const bool live = u < nunits; const int uu = live ? u : u0;
    const int bh = (MODE == 0) ? uu / (SC_NC - 1) : uu >> 4, c = (MODE == 0) ? uu % (SC_NC - 1) : uu & 15, b = bh >> 2, h = bh & 3;
    LAS f4* buf = (LAS f4*)(lds + ui * 57344);
    LAS float* yb = (LAS float*)(lds + ui * 57344 + 49152);
    const size_t tok0 = (size_t)b * SEQ + c * SC_T;
    float s[RPL][8];
#pragma unroll
    for (int i = 0; i < RPL; ++i) {
        if (MODE == 0) {
#pragma unroll
            for (int j = 0; j < 8; ++j) s[i][j] = (rbase + i == cg * 8 + j) ? 1.f : 0.f;
        } else { const float* sp = sinit + (((size_t)bh * SC_NC + c) * 64 + rbase + i) * 64 + cg * 8; const f4 a = *(const f4*)sp, bq = *(const f4*)(sp + 4);
            s[i][0] = a.x; s[i][1] = a.y; s[i][2] = a.z; s[i][3] = a.w; s[i][4] = bq.x; s[i][5] = bq.y; s[i][6] = bq.z; s[i][7] = bq.w; }
    }
    f4 pre[6];
#define GSRC(sc, k) ((const f4*)(rw + ((tok0 + (sc) * SC_SUB + (tu + 256 * (k)) / 96) * 7 + (((tu + 256 * (k)) % 96) >> 4)) * MW + h * 64 + (((tu + 256 * (k)) % 96) & 15) * 4))
#pragma unroll
    for (int k = 0; k < 6; ++k) pre[k] = *GSRC(0, k);
    __syncthreads();
#pragma unroll
    for (int k = 0; k < 6; ++k) buf[tu + 256 * k] = pre[k];
    __syncthreads();
    for (int sc = 0; sc < SC_T / SC_SUB; ++sc) {
        if (sc + 1 < SC_T / SC_SUB) {
#pragma unroll
            for (int k = 0; k < 6; ++k) pre[k] = *GSRC(sc + 1, k);
        }
        const LAS f4* cb = buf + (sc & 1) * 1536; LAS float* ybc = yb + (sc & 1) * 1024;
        for (int i16 = 0; i16 < SC_SUB; ++i16) {
            const LAS f4* S = cb + i16 * 96;
            const f4 kk0 = S[64 + cg * 2], kk1 = S[64 + cg * 2 + 1], w0 = S[16 + cg * 2], w1 = S[16 + cg * 2 + 1], q0 = S[80 + cg * 2], q1 = S[80 + cg * 2 + 1], k0 = S[32 + cg * 2], k1 = S[32 + cg * 2 + 1];
            f4 r0, r1; if (MODE == 1) { r0 = S[cg * 2]; r1 = S[cg * 2 + 1]; }
#pragma unroll
            for (int i = 0; i < RPL; ++i) {
                float d = s[i][0] * kk0.x + s[i][1] * kk0.y + s[i][2] * kk0.z + s[i][3] * kk0.w + s[i][4] * kk1.x + s[i][5] * kk1.y + s[i][6] * kk1.z + s[i][7] * kk1.w;
                d = dpp_add8(d);
                const int row = rbase + i;
                const float sa = -d, vv = (MODE == 0) ? ((row >= 64) ? ((const LAS float*)(S + 48))[row - 64] : 0.f) : ((const LAS float*)(S + 48))[row];
                s[i][0] = s[i][0] * w0.x + sa * q0.x + vv * k0.x; s[i][1] = s[i][1] * w0.y + sa * q0.y + vv * k0.y; s[i][2] = s[i][2] * w0.z + sa * q0.z + vv * k0.z; s[i][3] = s[i][3] * w0.w + sa * q0.w + vv * k0.w;
                s[i][4] = s[i][4] * w1.x + sa * q1.x + vv * k1.x; s[i][5] = s[i][5] * w1.y + sa * q1.y + vv * k1.y; s[i][6] = s[i][6] * w1.z + sa * q1.z + vv * k1.z; s[i][7] = s[i][7] * w1.w + sa * q1.w + vv * k1.w;
                if (MODE == 1) {
                    float y = s[i][0] * r0.x + s[i][1] * r0.y + s[i][2] * r0.z + s[i][3] * r0.w + s[i][4] * r1.x + s[i][5] * r1.y + s[i][6] * r1.z + s[i][7] * r1.w;
                    y = dpp_add8(y);
                    if (cg == 0) ybc[i16 * 64 + row] = y;
                }
            }
        }
        if (sc + 1 < SC_T / SC_SUB) {
#pragma unroll
            for (int k = 0; k < 6; ++k) buf[((sc + 1) & 1) * 1536 + tu + 256 * k] = pre[k];
        }
        __syncthreads();
        if (MODE == 1 && live) {
            const int i16 = tu >> 4, q = tu & 15; const size_t tok = tok0 + sc * SC_SUB + i16;
            const f4 y = *(const LAS f4*)(ybc + i16 * 64 + q * 4);
            const float* p = rw + tok * 7 * MW + h * 64 + 4 * q;
            const f4 r = *(const f4*)p, k2 = *(const f4*)(p + 2 * MW), v = *(const f4*)(p + 3 * MW), g = *(const f4*)(p + 6 * MW);
            const f4 rk = *(const f4*)(r_k + h * 64 + 4 * q), lg = *(const f4*)(ln_g + h * 64 + 4 * q), lb = *(const f4*)(ln_b + h * 64 + 4 * q);
            const float mu = gsum16(y.x + y.y + y.z + y.w) * (1.f / 64.f); const f4 yc = y - mu;
            const float var = gsum16(yc.x * yc.x + yc.y * yc.y + yc.z * yc.z + yc.w * yc.w) * (1.f / 64.f); const float rs = 1.f / sqrtf(var + 64e-5f);
            const float bonus = gsum16(r.x * k2.x * rk.x + r.y * k2.y * rk.y + r.z * k2.z * rk.z + r.w * k2.w * rk.w);
            st4bf(o_rwkv + tok * MW + h * 64 + 4 * q, (yc * rs * lg + lb + bonus * v) * g);
        }
    }
    if (MODE == 0 && live) {
#pragma unroll
        for (int i = 0; i < RPL; ++i) { const int row = rbase + i; float* dp = pq + ((((size_t)bh * (SC_NC - 1) + c) * 2 + (row >> 6)) * 64 + (row & 63)) * 64 + cg * 8;
            *(f4*)dp = (f4){s[i][0], s[i][1], s[i][2], s[i][3]}; *(f4*)(dp + 4) = (f4){s[i][4], s[i][5], s[i][6], s[i][7]}; }
    }
    __syncthreads();
#undef GSRC
}
__device__ __forceinline__ void scan_combine_unit(LAS unsigned char* lds, const float* pq, float* sinit, int bh, int wv) {
    const int tid = tid_now(wv), lane = tid & 63, c32 = lane & 31, hi = lane >> 5, br = (wv >> 1) & 1, bc = wv & 1;
    LAS float* SL = (LAS float*)lds;
    LAS float* PL = (LAS float*)(lds + 16640);
    __syncthreads();
    for (int i = tid; i < 64 * 65; i += NT) SL[i] = 0.f;
    { float* s0 = sinit + (size_t)bh * SC_NC * 4096; for (int i = tid; i < 1024; i += NT) ((f4*)s0)[i] = (f4){0.f, 0.f, 0.f, 0.f}; }
    { const f4* pg = (const f4*)(pq + ((size_t)bh * (SC_NC - 1) * 2) * 4096);
#pragma unroll
        for (int k = 0; k < 2; ++k) ((LAS f4*)PL)[tid + 512 * k] = pg[tid + 512 * k]; }
    __syncthreads();
    for (int c = 0; c < SC_NC - 1; ++c) {
        const float* Pn = pq + (((size_t)bh * (SC_NC - 1) + c + 1) * 2) * 4096; f4 pn[2];
        if (c + 1 < SC_NC - 1) {
#pragma unroll
            for (int k = 0; k < 2; ++k) pn[k] = ((const f4*)Pn)[tid + 512 * k]; }
        f32x16_t acc;
        if (wv < 4) {
            const float* Q = pq + (((size_t)bh * (SC_NC - 1) + c) * 2 + 1) * 4096; const LAS float* P = PL + (c & 1) * 4096;
#pragma unroll
            for (int i = 0; i < 16; ++i) acc[i] = Q[(32 * br + (i & 3) + 8 * (i >> 2) + 4 * hi) * 64 + 32 * bc + c32];
#pragma unroll 8
            for (int ks = 0; ks < 32; ++ks) acc = __builtin_amdgcn_mfma_f32_32x32x2f32(SL[(32 * br + c32) * 65 + 2 * ks + hi], P[(2 * ks + hi) * 64 + 32 * bc + c32], acc, 0, 0, 0);
        }
        __syncthreads();
        if (wv < 4) { float* so = sinit + ((size_t)bh * SC_NC + c + 1) * 4096;
#pragma unroll
            for (int i = 0; i < 16; ++i) { const int row = 32 * br + (i & 3) + 8 * (i >> 2) + 4 * hi; SL[row * 65 + 32 * bc + c32] = acc[i]; so[row * 64 + 32 * bc + c32] = acc[i]; } }
        if (c + 1 < SC_NC - 1) {
#pragma unroll
            for (int k = 0; k < 2; ++k) ((LAS f4*)(PL + ((c + 1) & 1) * 4096))[tid + 512 * k] = pn[k]; }
        __syncthreads();
    }
}

constexpr int T_LD = 144;
constexpr int T_BYTES = 64 * T_LD;
__device__ __forceinline__ void tile_load(u32x4_t& kr, u32x4_t& vr, const bf16_t* ksrc, const bf16_t* vsrc, int ld, int tid, int wv) {
    kr = *(const u32x4_t*)(ksrc + (size_t)(tid >> 3) * ld + (tid & 7) * 8);
    vr = *(const u32x4_t*)(vsrc + (size_t)(tid & 63) * ld + wv * 8);
}
__device__ __forceinline__ void tile_store(LAS unsigned char* KL, LAS unsigned char* VL, const u32x4_t& kr, const u32x4_t& vr, int tid, int wv) {
    *(LAS u32x4_t*)(KL + (tid >> 3) * T_LD + (tid & 7) * 16) = kr;
    LAS unsigned short* vp = (LAS unsigned short*)(VL + (wv * 8) * T_LD + (tid & 63) * 2);
#pragma unroll
    for (int e = 0; e < 4; ++e) { vp[(2 * e) * (T_LD / 2)] = (unsigned short)(vr[e] & 0xffffu); vp[(2 * e + 1) * (T_LD / 2)] = (unsigned short)(vr[e] >> 16); }
}
__device__ __forceinline__ void st_tile(f32x16_t& s0, f32x16_t& s1, const LAS unsigned char* KL, const bf16x8_t (&qf)[4], int c, int hi) {
#pragma unroll
    for (int i = 0; i < 16; ++i) { s0[i] = 0.f; s1[i] = 0.f; }
#pragma unroll
    for (int ks = 0; ks < 4; ++ks) { const bf16x8_t k0 = *(const LAS bf16x8_t*)(KL + c * T_LD + ks * 32 + hi * 16), k1 = *(const LAS bf16x8_t*)(KL + (32 + c) * T_LD + ks * 32 + hi * 16);
        s0 = MFMA32(k0, qf[ks], s0); s1 = MFMA32(k1, qf[ks], s1); }
}
__device__ __forceinline__ void pv_tile(f32x16_t& o0, f32x16_t& o1, const LAS unsigned char* VL, const f32x16_t& p0, const f32x16_t& p1, int c, int hi) {
#pragma unroll
    for (int j4 = 0; j4 < 4; ++j4) {
        u32x4_t pw;
        if (j4 < 2) { pw[0] = cvtpk(p0[8 * j4], p0[8 * j4 + 1]); pw[1] = cvtpk(p0[8 * j4 + 2], p0[8 * j4 + 3]); pw[2] = cvtpk(p0[8 * j4 + 4], p0[8 * j4 + 5]); pw[3] = cvtpk(p0[8 * j4 + 6], p0[8 * j4 + 7]); }
        else { const int jj = j4 - 2; pw[0] = cvtpk(p1[8 * jj], p1[8 * jj + 1]); pw[1] = cvtpk(p1[8 * jj + 2], p1[8 * jj + 3]); pw[2] = cvtpk(p1[8 * jj + 4], p1[8 * jj + 5]); pw[3] = cvtpk(p1[8 * jj + 6], p1[8 * jj + 7]); }
        const bf16x8_t pf = __builtin_bit_cast(bf16x8_t, pw);
        const LAS unsigned char* v0 = VL + c * T_LD + (16 * j4 + 4 * hi) * 2; const LAS unsigned char* v1 = VL + (32 + c) * T_LD + (16 * j4 + 4 * hi) * 2;
        u32x4_t a0, a1; { const u32x2_t x = *(const LAS u32x2_t*)v0, y = *(const LAS u32x2_t*)(v0 + 16); a0[0] = x[0]; a0[1] = x[1]; a0[2] = y[0]; a0[3] = y[1]; }
        { const u32x2_t x = *(const LAS u32x2_t*)v1, y = *(const LAS u32x2_t*)(v1 + 16); a1[0] = x[0]; a1[1] = x[1]; a1[2] = y[0]; a1[3] = y[1]; }
        o0 = MFMA32(__builtin_bit_cast(bf16x8_t, a0), pf, o0); o1 = MFMA32(__builtin_bit_cast(bf16x8_t, a1), pf, o1);
    }
}

constexpr int NSA_KT = 0, NSA_VT = 2 * T_BYTES, NSA_KC = 4 * T_BYTES, NSA_VCT = NSA_KC + 128 * T_LD, VC_LD = 272, NSA_BD = NSA_VCT + 64 * VC_LD, NSA_IMP = NSA_BD + 2048, NSA_UNI = NSA_IMP + 32768;
template <bool SPECIAL>
__device__ __forceinline__ void nsa_tile(const LAS unsigned char* KL, const LAS unsigned char* VL, const bf16x8_t (&qf)[4], const LAS float* bd, float cfar, int t, int key0, int wlim, bool on,
                                         float& mrun, float& lrun, f32x16_t& o0, f32x16_t& o1, int c, int hi) {
    constexpr float C2 = 0.125f * 1.4426950408889634f; const float NEG = -__builtin_inff();
    f32x16_t s0, s1; st_tile(s0, s1, KL, qf, c, hi);
    float tmax = NEG;
    if (SPECIAL) {
#pragma unroll
        for (int i = 0; i < 16; ++i) { const int d0 = t - (key0 + (i & 3) + 8 * (i >> 2) + 4 * hi), d1 = d0 - 32;
            const int i0 = d0 < 0 ? 0 : (d0 < 127 ? d0 : 127), i1 = d1 < 0 ? 0 : (d1 < 127 ? d1 : 127);
            s0[i] = (on && d0 >= 0 && d0 < wlim) ? s0[i] * C2 + bd[i0] : NEG; s1[i] = (on && d1 >= 0 && d1 < wlim) ? s1[i] * C2 + bd[i1] : NEG;
            tmax = fmaxf(tmax, fmaxf(s0[i], s1[i])); }
    } else {
#pragma unroll
        for (int i = 0; i < 16; ++i) { s0[i] = on ? s0[i] * C2 + cfar : NEG; s1[i] = on ? s1[i] * C2 + cfar : NEG; tmax = fmaxf(tmax, fmaxf(s0[i], s1[i])); }
    }
    tmax = fmaxf(tmax, xhalf(tmax));
    const float mn = fmaxf(mrun, tmax), alpha = __builtin_amdgcn_exp2f(mrun - mn); mrun = mn;
    float ps = 0.f;
#pragma unroll
    for (int i = 0; i < 16; ++i) { s0[i] = __builtin_amdgcn_exp2f(s0[i] - mn); s1[i] = __builtin_amdgcn_exp2f(s1[i] - mn); ps += s0[i] + s1[i]; }
    lrun = lrun * alpha + ps;
    o0 *= alpha; o1 *= alpha;
    pv_tile(o0, o1, VL, s0, s1, c, hi);
}
__device__ __forceinline__ void nsa_unit(LAS unsigned char* lds, const bf16_t* z, const float* ngl, const bf16_t* kcg, const bf16_t* vctg, const float* biasd_g, bf16_t* o_nsa, int b, int qt, int wv) {
    const int tid = tid_now(wv), lane = tid & 63, c = lane & 31, hi = lane >> 5, h = wv & 3, th = wv >> 2;
    const int t = 64 * qt + 32 * th + c; const size_t row = (size_t)b * SEQ + t;
    LAS unsigned char* KC = lds + NSA_KC; LAS unsigned char* VCT = lds + NSA_VCT; LAS float* BD = (LAS float*)(lds + NSA_BD); LAS float* IMPH = (LAS float*)(lds + NSA_IMP); LAS unsigned* UNI = (LAS unsigned*)(lds + NSA_UNI);
    constexpr float C2 = 0.125f * 1.4426950408889634f, L2E = 1.4426950408889634f; const float NEG = -__builtin_inff();
    __syncthreads();
#pragma unroll
    for (int k = 0; k < 2; ++k) { const int idx = tid + 512 * k; *(LAS u32x4_t*)(KC + (idx >> 3) * T_LD + (idx & 7) * 16) = *(const u32x4_t*)(kcg + (size_t)b * 128 * 64 + idx * 8);
        *(LAS u32x4_t*)(VCT + (idx >> 4) * VC_LD + (idx & 15) * 16) = *(const u32x4_t*)(vctg + (size_t)b * 64 * 128 + idx * 8); }
    BD[tid] = biasd_g[tid] * L2E;
    bf16x8_t qf[4];
    { const bf16_t* qr = z + row * ZLD + C_Q + h * 64 + 8 * hi;
#pragma unroll
        for (int ks = 0; ks < 4; ++ks) qf[ks] = *(const bf16x8_t*)(qr + 16 * ks); }
    const float* gp = ngl + row * 12 + h * 3; const float g0 = sigmoidf_(gp[0]), g1 = sigmoidf_(gp[1]), g2 = sigmoidf_(gp[2]);
    __syncthreads();
    const LAS float* bd = BD + h * 128; const float cfar = bd[127];
    f32x16_t out0, out1;
    {
        const int nv = (t >= 31) ? ((t - 31) >> 4) + 1 : 0;
        f32x16_t s[4];
#pragma unroll
        for (int kb = 0; kb < 4; ++kb) {
#pragma unroll
            for (int i = 0; i < 16; ++i) s[kb][i] = 0.f;
#pragma unroll
            for (int ks = 0; ks < 4; ++ks) s[kb] = MFMA32(*(const LAS bf16x8_t*)(KC + (32 * kb + c) * T_LD + ks * 32 + hi * 16), qf[ks], s[kb]); }
        float m = -1e30f;
#pragma unroll
        for (int kb = 0; kb < 4; ++kb)
#pragma unroll
            for (int i = 0; i < 16; ++i) { const int n = 32 * kb + (i & 3) + 8 * (i >> 2) + 4 * hi, dd = t - (16 * n + 31); const int di = dd < 0 ? 0 : (dd < 127 ? dd : 127);
                s[kb][i] = (n < nv) ? s[kb][i] * C2 + bd[di] : NEG; m = fmaxf(m, s[kb][i]); }
        m = fmaxf(m, xhalf(m));
        float l = 0.f;
#pragma unroll
        for (int kb = 0; kb < 4; ++kb)
#pragma unroll
            for (int i = 0; i < 16; ++i) { s[kb][i] = __builtin_amdgcn_exp2f(s[kb][i] - m); l += s[kb][i]; }
        l += xhalf(l); const float inv = (l > 0.f) ? 1.f / l : 0.f;
#pragma unroll
        for (int kb = 0; kb < 4; ++kb) s[kb] *= inv;
        float part[16], cr[16];
#pragma unroll
        for (int kb = 0; kb < 4; ++kb)
#pragma unroll
            for (int a = 0; a < 4; ++a) { part[kb * 4 + a] = s[kb][4 * a] + s[kb][4 * a + 1] + s[kb][4 * a + 2] + 0.5f * s[kb][4 * a + 3]; cr[kb * 4 + a] = 0.5f * s[kb][4 * a + 3]; }
        { float prev = 0.f;
#pragma unroll
            for (int sl = 0; sl < 16; ++sl) { const float xc = xhalf(cr[sl]); part[sl] += hi ? xc : prev; prev = xc; } }
        { LAS float* ip = IMPH + (h * 64 + 32 * th + c) * 32 + hi;
#pragma unroll
            for (int sl = 0; sl < 16; ++sl) ip[2 * sl] = part[sl]; }
#pragma unroll
        for (int i = 0; i < 16; ++i) { out0[i] = 0.f; out1[i] = 0.f; }
#pragma unroll
        for (int j8 = 0; j8 < 8; ++j8) { const f32x16_t& pp = s[j8 >> 1]; const int jj = j8 & 1; u32x4_t pw;
            pw[0] = cvtpk(pp[8 * jj], pp[8 * jj + 1]); pw[1] = cvtpk(pp[8 * jj + 2], pp[8 * jj + 3]); pw[2] = cvtpk(pp[8 * jj + 4], pp[8 * jj + 5]); pw[3] = cvtpk(pp[8 * jj + 6], pp[8 * jj + 7]);
            const bf16x8_t pf = __builtin_bit_cast(bf16x8_t, pw);
            const LAS unsigned char* v0 = VCT + c * VC_LD + (16 * j8 + 4 * hi) * 2; const LAS unsigned char* v1 = VCT + (32 + c) * VC_LD + (16 * j8 + 4 * hi) * 2;
            u32x4_t a0, a1; { const u32x2_t x = *(const LAS u32x2_t*)v0, y = *(const LAS u32x2_t*)(v0 + 16); a0[0] = x[0]; a0[1] = x[1]; a0[2] = y[0]; a0[3] = y[1]; }
            { const u32x2_t x = *(const LAS u32x2_t*)v1, y = *(const LAS u32x2_t*)(v1 + 16); a1[0] = x[0]; a1[1] = x[1]; a1[2] = y[0]; a1[3] = y[1]; }
            out0 = MFMA32(__builtin_bit_cast(bf16x8_t, a0), pf, out0); out1 = MFMA32(__builtin_bit_cast(bf16x8_t, a1), pf, out1); }
        out0 *= g0; out1 *= g0;
    }
    __syncthreads();
    unsigned sel = 0u;
    {
        float v[16];
        const LAS float* ip = IMPH + (32 * th + c) * 32 + 16 * hi;
#pragma unroll
        for (int j = 0; j < 16; ++j) { const int mb = 16 * hi + j; float x = ((ip[j] + ip[64 * 32 + j]) + ip[2 * 64 * 32 + j]) + ip[3 * 64 * 32 + j];
            if (mb == 0 || mb == qt || mb == qt - 1) x += 1e4f; v[j] = (mb <= qt) ? x : NEG; }
        for (int r = 0; r < 8; ++r) {
            float best = NEG; int bi = 0;
#pragma unroll
            for (int j = 0; j < 16; ++j) if (v[j] > best) { best = v[j]; bi = j; }
            const float ob = xhalf(best); const int oi = __shfl_xor(bi, 32);
            const float lowv = hi ? ob : best, highv = hi ? best : ob; const int lowi = hi ? oi : bi, highi = (hi ? bi : oi) + 16;
            const bool lowwin = lowv >= highv; const float wval = lowwin ? lowv : highv; const int widx = lowwin ? lowi : highi;
            if (wval > NEG) { sel |= 1u << widx;
#pragma unroll
                for (int j = 0; j < 16; ++j) if (16 * hi + j == widx) v[j] = NEG; }
        }
        unsigned uni = 0u;
        for (int mb = 0; mb <= qt; ++mb) if (__ballot((sel >> mb) & 1u) != 0ull) uni |= 1u << mb;
        if (h == 0 && lane == 0) UNI[th] = uni;
    }
    __syncthreads();
    const unsigned uni = UNI[0] | UNI[1];
    const bf16_t* zb = z + (size_t)b * SEQ * ZLD;
    u32x4_t kr, vr;
    {
        float mrun = -1e30f, lrun = 0.f; f32x16_t o0, o1;
#pragma unroll
        for (int i = 0; i < 16; ++i) { o0[i] = 0.f; o1[i] = 0.f; }
        unsigned rem = uni; int blk = __builtin_ctz(rem); rem &= rem - 1u;
        tile_load(kr, vr, zb + (size_t)blk * 64 * ZLD + C_KS, zb + (size_t)blk * 64 * ZLD + C_VS, ZLD, tid, wv);
        tile_store(lds + NSA_KT, lds + NSA_VT, kr, vr, tid, wv);
        __syncthreads();
        for (int it = 0;; ++it) {
            const bool nxt = rem != 0u; const int nb = nxt ? __builtin_ctz(rem) : 0; rem &= rem - 1u;
            if (nxt) tile_load(kr, vr, zb + (size_t)nb * 64 * ZLD + C_KS, zb + (size_t)nb * 64 * ZLD + C_VS, ZLD, tid, wv);
            const LAS unsigned char* KL = lds + NSA_KT + (it & 1) * T_BYTES; const LAS unsigned char* VL = lds + NSA_VT + (it & 1) * T_BYTES;
            const bool on = (sel >> blk) & 1u;
            if (qt - blk <= 2) nsa_tile<true>(KL, VL, qf, bd, cfar, t, 64 * blk, 1 << 30, on, mrun, lrun, o0, o1, c, hi);
            else nsa_tile<false>(KL, VL, qf, bd, cfar, t, 64 * blk, 1 << 30, on, mrun, lrun, o0, o1, c, hi);
            if (nxt) tile_store(lds + NSA_KT + ((it + 1) & 1) * T_BYTES, lds + NSA_VT + ((it + 1) & 1) * T_BYTES, kr, vr, tid, wv);
            __syncthreads();
            if (!nxt) break;
            blk = nb;
        }
        lrun += xhalf(lrun); const float sc = g1 / lrun;
        out0 += o0 * sc; out1 += o1 * sc;
    }
    {
        float mrun = -1e30f, lrun = 0.f; f32x16_t o0, o1;
#pragma unroll
        for (int i = 0; i < 16; ++i) { o0[i] = 0.f; o1[i] = 0.f; }
        const int tb0 = qt >= 8 ? qt - 8 : 0;
        tile_load(kr, vr, zb + (size_t)tb0 * 64 * ZLD + C_KW, zb + (size_t)tb0 * 64 * ZLD + C_VW, ZLD, tid, wv);
        tile_store(lds + NSA_KT, lds + NSA_VT, kr, vr, tid, wv);
        __syncthreads();
        for (int tb = tb0; tb <= qt; ++tb) {
            const int it = tb - tb0; const bool nxt = tb < qt;
            if (nxt) tile_load(kr, vr, zb + (size_t)(tb + 1) * 64 * ZLD + C_KW, zb + (size_t)(tb + 1) * 64 * ZLD + C_VW, ZLD, tid, wv);
            const LAS unsigned char* KL = lds + NSA_KT + (it & 1) * T_BYTES; const LAS unsigned char* VL = lds + NSA_VT + (it & 1) * T_BYTES;
            if (qt - tb <= 2 || qt - tb == 8) nsa_tile<true>(KL, VL, qf, bd, cfar, t, 64 * tb, 512, true, mrun, lrun, o0, o1, c, hi);
            else nsa_tile<false>(KL, VL, qf, bd, cfar, t, 64 * tb, 512, true, mrun, lrun, o0, o1, c, hi);
            if (nxt) tile_store(lds + NSA_KT + ((it + 1) & 1) * T_BYTES, lds + NSA_VT + ((it + 1) & 1) * T_BYTES, kr, vr, tid, wv);
            __syncthreads();
        }
        lrun += xhalf(lrun); const float sc = g2 / lrun;
        out0 += o0 * sc; out1 += o1 * sc;
    }
    bf16_t* op = o_nsa + row * MW + h * 64;
#pragma unroll
    for (int a = 0; a < 4; ++a) { u32x2_t u0, u1; u0[0] = cvtpk(out0[4 * a], out0[4 * a + 1]); u0[1] = cvtpk(out0[4 * a + 2], out0[4 * a + 3]); u1[0] = cvtpk(out1[4 * a], out1[4 * a + 1]); u1[1] = cvtpk(out1[4 * a + 2], out1[4 * a + 3]);
        *(u32x2_t*)(op + 8 * a + 4 * hi) = u0; *(u32x2_t*)(op + 32 + 8 * a + 4 * hi) = u1; }
}

__device__ __forceinline__ void ret_unit(LAS unsigned char* lds, const bf16_t* z, const float* norm_g, bf16_t* o_ret, int b, int h, int q8, int wv) {
    const int tid = tid_now(wv), lane = tid & 63, c = lane & 31, hi = lane >> 5, w = wv;
    const int t = 256 * q8 + 32 * w + c; const size_t row = (size_t)b * SEQ + t;
    const int ntiles = 4 * q8 + 4, ktd = 4 * q8 + (w >> 1);
    const float lg2 = log2f(1.f - exp2f(-5.f - (float)h));
    bf16x8_t qf[4];
    { const bf16_t* qr = z + row * ZLD + C_RQ + h * 64 + 8 * hi;
#pragma unroll
        for (int ks = 0; ks < 4; ++ks) qf[ks] = *(const bf16x8_t*)(qr + 16 * ks); }
    f32x16_t bc0, bc1, o0, o1;
#pragma unroll
    for (int i = 0; i < 16; ++i) { const int j = (i & 3) + 8 * (i >> 2) + 4 * hi; bc0[i] = exp2f((float)(63 - j) * lg2); bc1[i] = exp2f((float)(31 - j) * lg2); o0[i] = 0.f; o1[i] = 0.f; }
    const float g64 = exp2f(64.f * lg2);
    const bf16_t* kbase = z + (size_t)b * SEQ * ZLD + C_RK + h * 64; const bf16_t* vbase = z + (size_t)b * SEQ * ZLD + C_RV + h * 64;
    u32x4_t kr, vr;
    __syncthreads();
    tile_load(kr, vr, kbase, vbase, ZLD, tid, wv);
    tile_store(lds, lds + 2 * T_BYTES, kr, vr, tid, wv);
    __syncthreads();
    for (int kt = 0; kt < ntiles; ++kt) {
        const bool nxt = kt + 1 < ntiles;
        if (nxt) tile_load(kr, vr, kbase + (size_t)(kt + 1) * 64 * ZLD, vbase + (size_t)(kt + 1) * 64 * ZLD, ZLD, tid, wv);
        if (kt <= ktd) {
            const LAS unsigned char* KL = lds + (kt & 1) * T_BYTES; const LAS unsigned char* VL = lds + (2 + (kt & 1)) * T_BYTES;
            f32x16_t s0, s1; st_tile(s0, s1, KL, qf, c, hi);
            s0 *= bc0; s1 *= bc1;
            if (kt == ktd) {
#pragma unroll
                for (int i = 0; i < 16; ++i) { const int key = 64 * kt + (i & 3) + 8 * (i >> 2) + 4 * hi; if (key > t) s0[i] = 0.f; if (key + 32 > t) s1[i] = 0.f; } }
            o0 *= g64; o1 *= g64;
            pv_tile(o0, o1, VL, s0, s1, c, hi);
        }
        if (nxt) tile_store(lds + ((kt + 1) & 1) * T_BYTES, lds + (2 + ((kt + 1) & 1)) * T_BYTES, kr, vr, tid, wv);
        __syncthreads();
    }
    const float fin = exp2f((float)(t - 64 * ktd - 63) * lg2);
    o0 *= fin; o1 *= fin;
    float sm = 0.f;
#pragma unroll
    for (int i = 0; i < 16; ++i) sm += o0[i] + o1[i];
    sm += xhalf(sm); const float mu = sm * (1.f / 64.f);
    float var = 0.f;
#pragma unroll
    for (int i = 0; i < 16; ++i) { o0[i] -= mu; o1[i] -= mu; var += o0[i] * o0[i] + o1[i] * o1[i]; }
    var += xhalf(var); const float rs = 1.f / sqrtf(var * (1.f / 64.f) + 1e-5f);
    const bf16_t* gr = z + row * ZLD + C_RG + h * 64; bf16_t* op = o_ret + row * MW + h * 64;
#pragma unroll
    for (int db = 0; db < 2; ++db)
#pragma unroll
        for (int a = 0; a < 4; ++a) { const int d = 32 * db + 8 * a + 4 * hi; const f4 g = ld4bf(gr + d), ng = *(const f4*)(norm_g + h * 64 + d); f4 v;
            const f32x16_t& oo = db ? o1 : o0;
            v.x = g.x * sigmoidf_(g.x) * oo[4 * a] * rs * ng.x; v.y = g.y * sigmoidf_(g.y) * oo[4 * a + 1] * rs * ng.y; v.z = g.z * sigmoidf_(g.z) * oo[4 * a + 2] * rs * ng.z; v.w = g.w * sigmoidf_(g.w) * oo[4 * a + 3] * rs * ng.w;
            st4bf(op + d, v); }
}

constexpr int XA_LD = 528;
__device__ __forceinline__ void xattn_unit(LAS unsigned char* lds, const bf16_t* Q, const bf16_t* Kx, const bf16_t* VT, bf16_t* O, int b, int hh, int qt, int wv) {
    const int tid = tid_now(wv), lane = tid & 63, c = lane & 31, hi = lane >> 5, w = wv;
    LAS unsigned char* QL = lds; LAS unsigned char* PL = lds + 64 * XA_LD; LAS float* RMAX = (LAS float*)(lds + 2 * 64 * XA_LD); LAS float* RSUM = RMAX + 512;
    const size_t tok0 = (size_t)b * SEQ + qt * 64;
    __syncthreads();
#pragma unroll
    for (int k = 0; k < 4; ++k) { const int idx = tid + 512 * k, r = idx >> 5, ch = idx & 31; *(LAS u32x4_t*)(QL + r * XA_LD + ch * 16) = *(const u32x4_t*)(Q + (tok0 + r) * DM + hh * 256 + ch * 8); }
    bf16x8_t af[16];
    { const bf16_t* kr = Kx + (size_t)(b * MEMLEN + 32 * w + c) * DM + hh * 256 + 8 * hi;
#pragma unroll
        for (int ks = 0; ks < 16; ++ks) af[ks] = *(const bf16x8_t*)(kr + 16 * ks); }
    __syncthreads();
    f32x16_t s0, s1;
#pragma unroll
    for (int i = 0; i < 16; ++i) { s0[i] = 0.f; s1[i] = 0.f; }
#pragma unroll
    for (int ks = 0; ks < 16; ++ks) { const bf16x8_t q0 = *(const LAS bf16x8_t*)(QL + c * XA_LD + ks * 32 + hi * 16), q1 = *(const LAS bf16x8_t*)(QL + (32 + c) * XA_LD + ks * 32 + hi * 16);
        s0 = MFMA32(af[ks], q0, s0); s1 = MFMA32(af[ks], q1, s1); }
    constexpr float C2 = 0.0625f * 1.4426950408889634f;
    float m0 = s0[0], m1 = s1[0];
#pragma unroll
    for (int i = 1; i < 16; ++i) { m0 = fmaxf(m0, s0[i]); m1 = fmaxf(m1, s1[i]); }
    m0 = fmaxf(m0, xhalf(m0)); m1 = fmaxf(m1, xhalf(m1));
    if (hi == 0) { RMAX[w * 64 + c] = m0; RMAX[w * 64 + 32 + c] = m1; }
    __syncthreads();
    float g0 = RMAX[c], g1 = RMAX[32 + c];
#pragma unroll
    for (int ww = 1; ww < 8; ++ww) { g0 = fmaxf(g0, RMAX[ww * 64 + c]); g1 = fmaxf(g1, RMAX[ww * 64 + 32 + c]); }
    float l0 = 0.f, l1 = 0.f;
#pragma unroll
    for (int i = 0; i < 16; ++i) { s0[i] = __builtin_amdgcn_exp2f((s0[i] - g0) * C2); s1[i] = __builtin_amdgcn_exp2f((s1[i] - g1) * C2); l0 += s0[i]; l1 += s1[i]; }
    l0 += xhalf(l0); l1 += xhalf(l1);
    if (hi == 0) { RSUM[w * 64 + c] = l0; RSUM[w * 64 + 32 + c] = l1; }
#pragma unroll
    for (int a = 0; a < 4; ++a) { u32x2_t u0, u1; u0.x = cvtpk(s0[4 * a], s0[4 * a + 1]); u0.y = cvtpk(s0[4 * a + 2], s0[4 * a + 3]); u1.x = cvtpk(s1[4 * a], s1[4 * a + 1]); u1.y = cvtpk(s1[4 * a + 2], s1[4 * a + 3]);
        *(LAS u32x2_t*)(PL + c * XA_LD + (32 * w + 8 * a + 4 * hi) * 2) = u0; *(LAS u32x2_t*)(PL + (32 + c) * XA_LD + (32 * w + 8 * a + 4 * hi) * 2) = u1; }
    { const bf16_t* vr = VT + (size_t)(hh * 256 + 32 * w + c) * (BATCH * MEMLEN) + b * MEMLEN + 8 * hi;
#pragma unroll
        for (int j = 0; j < 16; ++j) af[j] = *(const bf16x8_t*)(vr + 16 * j); }
    __syncthreads();
    float t0 = RSUM[c], t1 = RSUM[32 + c];
#pragma unroll
    for (int ww = 1; ww < 8; ++ww) { t0 += RSUM[ww * 64 + c]; t1 += RSUM[ww * 64 + 32 + c]; }
#pragma unroll
    for (int i = 0; i < 16; ++i) { s0[i] = 0.f; s1[i] = 0.f; }
#pragma unroll
    for (int j = 0; j < 16; ++j) { const bf16x8_t p0 = *(const LAS bf16x8_t*)(PL + c * XA_LD + j * 32 + hi * 16), p1 = *(const LAS bf16x8_t*)(PL + (32 + c) * XA_LD + j * 32 + hi * 16);
        s0 = MFMA32(af[j], p0, s0); s1 = MFMA32(af[j], p1, s1); }
    const float i0 = 1.f / t0, i1 = 1.f / t1;
#pragma unroll
    for (int a = 0; a < 4; ++a) { u32x2_t u0, u1; u0.x = cvtpk(s0[4 * a] * i0, s0[4 * a + 1] * i0); u0.y = cvtpk(s0[4 * a + 2] * i0, s0[4 * a + 3] * i0); u1.x = cvtpk(s1[4 * a] * i1, s1[4 * a + 1] * i1); u1.y = cvtpk(s1[4 * a + 2] * i1, s1[4 * a + 3] * i1);
        *(u32x2_t*)(O + (tok0 + c) * DM + hh * 256 + 32 * w + 8 * a + 4 * hi) = u0; *(u32x2_t*)(O + (tok0 + 32 + c) * DM + hh * 256 + 32 * w + 8 * a + 4 * hi) = u1; }
}

constexpr int NPL = 15, NPHASES = 1 + DEPTH * NPL;
typedef const __attribute__((address_space(4))) unsigned char* kaptr_t;
#define PHASE_ENV \
    kaptr_t ka_ = (kaptr_t)__builtin_amdgcn_kernarg_segment_ptr(); asm volatile("" : "+s"(ka_)); \
    const float* const* P = (const float* const*)ka_; float* const OUT = (float*)P[33]; unsigned char* const ws = (unsigned char*)P[34]; (void)OUT; (void)ws; \
    int G = G0, bid = (int)blockIdx.x, wv = wv0; asm volatile("" : "+s"(G), "+s"(bid), "+s"(wv)); const int NGW = G * NWAVES, NGT = G * NT; (void)NGW; (void)NGT; \
    const int tid = tid_now(wv), lane = tid & 63, wave = wv, gw = bid * NWAVES + wave, gt = bid * NT + tid; (void)lane; (void)gw; (void)gt; \
    LAS unsigned char* lds = lds0; asm volatile("" : "+s"(lds));
#define WSF(off) ((float*)(ws + (off)))
#define WSB(off) ((bf16_t*)(ws + (off)))
#define IN(k) (lo <= (k) && (k) < hi)
#if MK_PER_PHASE
#define SEAM() do { } while (0)
#else
#define SEAM() do { XcdBarrier b_ = bar; asm volatile("" : "+s"(b_.bar), "+s"(b_.x), "+s"(b_.st), "+s"(b_.wv)); xcd_barrier(b_); } while (0)
#endif
template <int l>
__device__ __forceinline__ void layer_phases(LAS unsigned char* const lds0, const int G0, const int wv0, const int lo, const int hi, const XcdBarrier& bar) {
        const int pb = 1 + l * NPL;
        if (IN(pb + 0)) { PHASE_ENV pg8::Epi<1> E{WSB(WS_Z), ZLD, WSB(WS_ZG), nullptr, nullptr, 0}; gemm_run<1>(lds, WSB(WS_H), WSB(WS_W) + WO_IN, MTOK, NZ, DM, E, wv, G, bid); SEAM(); }
        if (IN(pb + 1)) {
            PHASE_ENV
            bf16_t* Z = WSB(WS_Z);
            if (gw < BATCH * 2 * 4) nsa_compress_task(Z, WSB(WS_W) + WO_CMP, P[5] + (size_t)l * 32 * 64, WSB(WS_CMP), WSB(WS_CMP) + BATCH * 128 * 64, gw, lane);
            { LAS float* scr = (LAS float*)lds + wave * 512; float* RW = WSF(WS_RW); for (int q = gw; q < MTOK / 4; q += NGW) rwkv_prep_quad(Z, RW, P, l, 4 * q, lane, scr); }
            { const float* cw = P[19] + (size_t)l * 3 * MW; bf16_t* oc = WSB(WS_BR) + (size_t)3 * MTOK * MW;
                for (int i = gt; i < MTOK * 32; i += NGT) { const int tok = i >> 5, c8 = (i & 31) * 8, t = tok % SEQ; const bf16_t* z = Z + (size_t)tok * ZLD;
                    f4 acc0 = (f4){0.f, 0.f, 0.f, 0.f}, acc1 = acc0;
#pragma unroll
                    for (int j = 0; j < 3; ++j) { if (t >= 2 - j) { const bf16_t* zz = z - (size_t)(2 - j) * ZLD; const f4 w0 = *(const f4*)(cw + j * MW + c8), w1 = *(const f4*)(cw + j * MW + c8 + 4);
                        acc0 += w0 * (ld4bf(zz + C_CC + c8) * ld4bf(zz + C_CX + c8)); acc1 += w1 * (ld4bf(zz + C_CC + c8 + 4) * ld4bf(zz + C_CX + c8 + 4)); } }
                    st4bf(oc + (size_t)tok * MW + c8, ld4bf(z + C_CB + c8) * acc0); st4bf(oc + (size_t)tok * MW + c8 + 4, ld4bf(z + C_CB + c8 + 4) * acc1); } }
            { const float* TABC = WSF(WS_TAB); const float* TABS = TABC + 65536;
                for (int i = gt; i < MTOK * 32; i += NGT) { const int j8 = (i & 3) * 8, h = (i >> 2) & 3, qk = (i >> 4) & 1, tok = i >> 5, t = tok % SEQ;
                    bf16_t* p = Z + (size_t)tok * ZLD + (qk ? C_RK : C_RQ) + h * 64 + j8; const float sc = qk ? 1.f : 0.125f;
                    const f4 a0 = ld4bf(p), a1 = ld4bf(p + 4), b0 = ld4bf(p + 32), b1 = ld4bf(p + 36);
                    const f4 c0 = *(const f4*)(TABC + t * 32 + j8), c1 = *(const f4*)(TABC + t * 32 + j8 + 4), s0 = *(const f4*)(TABS + t * 32 + j8), s1 = *(const f4*)(TABS + t * 32 + j8 + 4);
                    st4bf(p, (a0 * c0 - b0 * s0) * sc); st4bf(p + 4, (a1 * c1 - b1 * s1) * sc); st4bf(p + 32, (b0 * c0 + a0 * s0) * sc); st4bf(p + 36, (b1 * c1 + a1 * s1) * sc); } }
            SEAM();
        }
        if (IN(pb + 2)) {
            PHASE_ENV
            float* PQ = WSF(WS_H);
            for (int u = 2 * bid; u < 32 * (SC_NC - 1); u += 2 * G) scan_chunk_pair<4, 0>(lds, WSF(WS_RW), PQ, nullptr, nullptr, nullptr, nullptr, nullptr, u, 32 * (SC_NC - 1), wv);
            for (int u = bid; u < 256; u += G) nsa_unit(lds, WSB(WS_Z), WSF(WS_NG), WSB(WS_CMP), WSB(WS_CMP) + BATCH * 128 * 64, WSF(WS_TAB) + 131072, WSB(WS_BR), u >> 5, u & 31, wv);
            SEAM();
        }
        if (IN(pb + 3)) {
            PHASE_ENV
            if ((bid & 7) == 0 && (bid >> 3) < 32) scan_combine_unit(lds, WSF(WS_H), WSF(WS_H) + (size_t)4 * 1024 * 1024, bid >> 3, wv);
            for (int u = bid; u < 256; u += G) ret_unit(lds, WSB(WS_Z), P[7] + l * MW, WSB(WS_BR) + (size_t)MTOK * MW, u >> 5, (u >> 3) & 3, u & 7, wv);
            SEAM();
        }
        if (IN(pb + 4)) {
            PHASE_ENV
            for (int u = 2 * bid; u < 32 * SC_NC; u += 2 * G) scan_chunk_pair<2, 1>(lds, WSF(WS_RW), nullptr, WSF(WS_H) + (size_t)4 * 1024 * 1024, WSB(WS_BR) + (size_t)2 * MTOK * MW, P[16] + l * MW, P[17] + l * MW, P[18] + l * MW, u, 32 * SC_NC, wv);
            SEAM();
        }
        if (IN(pb + 5)) {
            PHASE_ENV pg8::Epi<5> E{WSB(WS_MERGED), DM, nullptr, nullptr, WSB(WS_ZG), 0};
            gemm_run_chain<5, 4>(lds, WSB(WS_BR), (size_t)MTOK * MW, WSB(WS_W) + WO_BR, (size_t)DM * MW, MTOK, DM, MW, E, wv, G, bid);
            SEAM(); }
        if (IN(pb + 6)) { PHASE_ENV pg8::Epi<0> E{WSB(WS_Y), DM, nullptr, nullptr, nullptr, 0}; gemm_run<0>(lds, WSB(WS_MERGED), WSB(WS_W) + WO_MO, MTOK, DM, DM, E, wv, G, bid); SEAM(); }
        if (IN(pb + 7)) { PHASE_ENV rowop((l == 0) ? P[0] : OUT, WSB(WS_Y), P[22] + l * DM, P[23] + l * DM, OUT, WSB(WS_H), nullptr, nullptr, gw, NGW, lane); rms_rows(P[1], P[24] + l * DM, WSB(WS_MN), BATCH * MEMLEN, nullptr, nullptr, gw, NGW, lane); SEAM(); }
        if (IN(pb + 8)) {
            { PHASE_ENV pg8::Epi<0> E{WSB(WS_Q), DM, nullptr, nullptr, nullptr, 0}; gemm_run<0>(lds, WSB(WS_H), WSB(WS_W) + WO_Q, MTOK, DM, DM, E, wv, G, bid); }
            { PHASE_ENV pg8::Epi<0> E{WSB(WS_KX), DM, nullptr, nullptr, nullptr, 0}; gemm_run<0>(lds, WSB(WS_MN), WSB(WS_W) + WO_KV, BATCH * MEMLEN, DM, DM, E, wv, G, (bid + 224) % G); }
            { PHASE_ENV pg8::Epi<0> E{WSB(WS_VT), BATCH * MEMLEN, nullptr, nullptr, nullptr, 0}; gemm_run<0>(lds, WSB(WS_W) + WO_KV + (size_t)DM * DM, WSB(WS_MN), DM, BATCH * MEMLEN, DM, E, wv, G, (bid + 192) % G); }
            SEAM(); }
        if (IN(pb + 9)) { PHASE_ENV for (int u = bid; u < BATCH * 4 * 32; u += G) xattn_unit(lds, WSB(WS_Q), WSB(WS_KX), WSB(WS_VT), WSB(WS_O), u >> 7, (u >> 5) & 3, u & 31, wv); SEAM(); }
        if (IN(pb + 10)) { PHASE_ENV pg8::Epi<0> E{WSB(WS_Y), DM, nullptr, nullptr, nullptr, 0}; gemm_run<0>(lds, WSB(WS_O), WSB(WS_W) + WO_O, MTOK, DM, DM, E, wv, G, bid); SEAM(); }
        if (IN(pb + 11)) { PHASE_ENV rowop(OUT, WSB(WS_Y), P[28] + l * DM, P[29] + l * DM, OUT, WSB(WS_H), nullptr, nullptr, gw, NGW, lane); SEAM(); }
        if (IN(pb + 12)) { PHASE_ENV pg8::Epi<2> E{WSB(WS_HID), DFF, nullptr, nullptr, nullptr, 0}; gemm_run<2>(lds, WSB(WS_H), WSB(WS_W) + WO_1, MTOK, DFF, DM, E, wv, G, bid); SEAM(); }
        if (IN(pb + 13)) { PHASE_ENV pg8::Epi<0> E{WSB(WS_Y), DM, nullptr, nullptr, nullptr, 0}; gemm_run<0>(lds, WSB(WS_HID), WSB(WS_W) + WO_2, MTOK, DM, DFF, E, wv, G, bid); SEAM(); }
        if (IN(pb + 14)) {
            PHASE_ENV
            if (l + 1 < DEPTH) { convert_layer(P, l + 1, WSB(WS_W), lds, wave, lane, gw, NGW); __syncthreads(); stage_wng((LAS float*)lds, P[3] + (size_t)(l + 1) * DM * IN_COLS, tid); __syncthreads();
                rowop(OUT, WSB(WS_Y), P[32] + l * DM, P[2] + (l + 1) * DM, OUT, WSB(WS_H), (const LAS float*)lds, WSF(WS_NG), gw, NGW, lane); }
            else rowop(OUT, WSB(WS_Y), P[32] + l * DM, nullptr, OUT, WSB(WS_H), nullptr, nullptr, gw, NGW, lane);
            SEAM(); }
    }

__global__ void __launch_bounds__(NT, 2) mk_fwd(Args args) {
    extern __shared__ __attribute__((aligned(16))) unsigned char lds_raw[];
    LAS unsigned char* const lds0 = (LAS unsigned char*)lds_raw;
    const int G0 = gridDim.x;
    const int wv0 = __builtin_amdgcn_readfirstlane((int)threadIdx.x >> 6);
    const int lo = args.ph_lo, hi = args.ph_hi;
#if MK_PER_PHASE
    XcdBarrier bar; bar.bar = nullptr; bar.x = 0; bar.wv = 0; bar.st = nullptr;
#else
    { const int t0 = tid_now(wv0); if (t0 < 4) ((LAS unsigned*)(lds0 + XB_LDS_OFF))[t0] = 0u; }
    __syncthreads();
    const XcdBarrier bar = xcd_barrier_post((unsigned*)(args.ws + WS_CTL) + CW_BAR, (volatile LAS unsigned*)(lds0 + XB_LDS_OFF), wv0);
#endif

    if (IN(0)) {
        PHASE_ENV
        float* TABC = WSF(WS_TAB); float* TABS = TABC + 65536; float* BIASD = TABC + 131072;
        for (int i = gt; i < SEQ * 32; i += NGT) { const int t = i >> 5, j = i & 31; const double rev = (double)t * INVF_REV[j]; const float fr = (float)(rev - floor(rev)); TABC[i] = __builtin_amdgcn_cosf(fr); TABS[i] = __builtin_amdgcn_sinf(fr); }
        for (int i = gt; i < 512; i += NGT) { const int h = i >> 7, d = i & 127; BIASD[i] = P[6][T5B[d] * MH + h]; }
        convert_layer(P, 0, WSB(WS_W), lds, wave, lane, gw, NGW);
        __syncthreads();
        stage_wng((LAS float*)lds, P[3], tid);
        __syncthreads();
        rms_rows(P[0], P[2], WSB(WS_H), MTOK, (const LAS float*)lds, WSF(WS_NG), gw, NGW, lane);
        SEAM();
    }
    layer_phases<0>(lds0, G0, wv0, lo, hi, bar); layer_phases<1>(lds0, G0, wv0, lo, hi, bar); layer_phases<2>(lds0, G0, wv0, lo, hi, bar); layer_phases<3>(lds0, G0, wv0, lo, hi, bar);
#undef IN
}

extern "C" void kernel_launch(void* const* d_in, const int* in_sizes, int n_in, void* d_out, int out_size, void* d_ws, size_t ws_size, hipStream_t stream) {
    static int grid = 0;
    if (grid == 0) {
        if (n_in != 33 || out_size != MTOK * DM || ws_size < WS_END) { fprintf(stderr, "kernel_launch: unexpected shapes (n_in %d out %d ws %zu)\n", n_in, out_size, ws_size); grid = -1; return; }
        int dev = 0, cus = 0;
        if (hipGetDevice(&dev) != hipSuccess || hipDeviceGetAttribute(&cus, hipDeviceAttributeMultiprocessorCount, dev) != hipSuccess) { grid = -1; return; }
        if (hipFuncSetAttribute((const void*)mk_fwd, hipFuncAttributeMaxDynamicSharedMemorySize, LDS_BYTES) != hipSuccess) { fprintf(stderr, "kernel_launch: hipFuncSetAttribute failed\n"); grid = -1; return; }
        grid = cus;
    }
    if (grid < 0) return;
    (void)hipMemsetAsync((char*)d_ws + WS_CTL, 0, 1 * MiB, stream);
    Args a{};
    for (int i = 0; i < 33; ++i) a.in[i] = (const float*)d_in[i];
    a.out = (float*)d_out; a.ws = (unsigned char*)d_ws;
#if MK_PER_PHASE
    for (int p = 0; p < NPHASES; ++p) { a.ph_lo = p; a.ph_hi = p + 1; hipLaunchKernelGGL(mk_fwd, dim3(grid), dim3(NT), LDS_BYTES, stream, a); }
#else
    a.ph_lo = 0; a.ph_hi = NPHASES; hipLaunchKernelGGL(mk_fwd, dim3(grid), dim3(NT), LDS_BYTES, stream, a);
#endif
}
```
